# Optimizing an MI355X kernel written in HIP

```python
import math
import numpy as np
import jax
import jax.numpy as jnp
from jax import lax

D_MODEL = 1024
BATCH = 16
SEQ = 2048
DEPTH = 2

MIX_WIDTH = D_MODEL
SSM_WIDTH = D_MODEL // 4
NSA_WIDTH = D_MODEL // 2
LRU_WIDTH = D_MODEL // 4

S5_GROUP = 16
S5_GROUPS = SSM_WIDTH // S5_GROUP
S5_STATE = 64

HEAD_DIM = 64
NSA_Q_HEADS = NSA_WIDTH // HEAD_DIM
NSA_KV_HEADS = 2
NSA_GQA = NSA_Q_HEADS // NSA_KV_HEADS
NSA_KV_WIDTH = NSA_KV_HEADS * HEAD_DIM
CMP_LEN = 32
CMP_STRIDE = 16
SEL_LEN = 64
SEL_TOPK = 8
WINDOW = 256
Q_BLOCK = 64

LRU_HEADS = 4
LRU_HEAD_DIM = LRU_WIDTH // LRU_HEADS
CONV_WIDTH = 4
LRU_C = 8.0

REL_BUCKETS = 32
REL_MAX_DIST = 128

D_FF = ((8 * D_MODEL // 3 + 255) // 256) * 256

IN_WIDTH = SSM_WIDTH + NSA_WIDTH + 6 * NSA_KV_WIDTH + 3 * NSA_Q_HEADS + 2 * LRU_WIDTH

NEG_INF = -1e9
FORCE_BONUS = 1e4
RMS_EPS = 1e-6

kernel_name = 'hymba_s5_nsa_rglru_trunk'


def in_proj_splits():
    o1 = SSM_WIDTH
    o2 = o1 + NSA_WIDTH
    o3 = o2 + 6 * NSA_KV_WIDTH
    o4 = o3 + 3 * NSA_Q_HEADS
    o5 = o4 + LRU_WIDTH
    return [o1, o2, o3, o4, o5]


def rmsnorm(x, g):
    xf = x.astype(jnp.float32)
    y = xf * lax.rsqrt(jnp.mean(xf * xf, axis=-1, keepdims=True) + RMS_EPS)
    return (y * g.astype(jnp.float32)).astype(x.dtype)


def masked_softmax(s, mask):
    p = jax.nn.softmax(jnp.where(mask, s, NEG_INF), axis=-1)
    return jnp.where(mask, p, 0.0)


def t5_bucket(dist):
    n = jnp.maximum(dist, 0)
    max_exact = REL_BUCKETS // 2
    nf = jnp.maximum(n, 1).astype(jnp.float32)
    large = max_exact + (jnp.log(nf / max_exact) / math.log(REL_MAX_DIST / max_exact)
                         * (REL_BUCKETS - max_exact)).astype(jnp.int32)
    large = jnp.minimum(large, REL_BUCKETS - 1)
    return jnp.where(n < max_exact, n, large)


def rel_bias_dense(table, dist):
    b = table.astype(jnp.float32)[t5_bucket(dist)]
    b = jnp.moveaxis(b, -1, 0)
    return b.reshape(NSA_KV_HEADS, NSA_GQA, *dist.shape)


def rel_bias_selected(table, dist):
    tbl = table.astype(jnp.float32).reshape(REL_BUCKETS, NSA_KV_HEADS, NSA_GQA).transpose(1, 0, 2)
    b = jax.vmap(lambda tb, bk: tb[bk], in_axes=(0, 1), out_axes=1)(tbl, t5_bucket(dist))
    return jnp.moveaxis(b, -1, 2)


def s5_mixer(u, lam_re, lam_im, log_dt, b_re, b_im, c_re, c_im, d_skip, w_glu):
    bsz, seq, _ = u.shape
    uf = u.astype(jnp.float32).reshape(bsz, seq, S5_GROUPS, S5_GROUP)
    dt = jnp.exp(log_dt.astype(jnp.float32))[:, None]
    lr = lam_re.astype(jnp.float32)
    li = lam_im.astype(jnp.float32)
    mag = jnp.exp(lr * dt)
    ang = li * dt
    ab_re = mag * jnp.cos(ang)
    ab_im = mag * jnp.sin(ang)
    den = lr * lr + li * li
    f_re = ((ab_re - 1.0) * lr + ab_im * li) / den
    f_im = (ab_im * lr - (ab_re - 1.0) * li) / den
    br = b_re.astype(jnp.float32)
    bi = b_im.astype(jnp.float32)
    bb_re = f_re[..., None] * br - f_im[..., None] * bi
    bb_im = f_re[..., None] * bi + f_im[..., None] * br
    bu_re = jnp.einsum('bsgc,gpc->bsgp', uf, bb_re)
    bu_im = jnp.einsum('bsgc,gpc->bsgp', uf, bb_im)
    a_re = jnp.broadcast_to(ab_re, bu_re.shape)
    a_im = jnp.broadcast_to(ab_im, bu_im.shape)

    def combine(e1, e2):
        a1r, a1i, b1r, b1i = e1
        a2r, a2i, b2r, b2i = e2
        return (a1r * a2r - a1i * a2i,
                a1r * a2i + a1i * a2r,
                a2r * b1r - a2i * b1i + b2r,
                a2r * b1i + a2i * b1r + b2i)

    _, _, h_re, h_im = lax.associative_scan(combine, (a_re, a_im, bu_re, bu_im), axis=1)
    y = (jnp.einsum('bsgp,gcp->bsgc', h_re, c_re.astype(jnp.float32))
         - jnp.einsum('bsgp,gcp->bsgc', h_im, c_im.astype(jnp.float32)))
    y = y.reshape(bsz, seq, SSM_WIDTH) + d_skip.astype(jnp.float32) * u.astype(jnp.float32)
    y = jax.nn.gelu(y)
    gl = y @ w_glu.astype(jnp.float32)
    out = gl[..., :SSM_WIDTH] * jax.nn.sigmoid(gl[..., SSM_WIDTH:])
    return out.astype(u.dtype)


def nsa_compress(kv, pe, w1, w2):
    bsz, seq = kv.shape[:2]
    n_cmp = (seq - CMP_LEN) // CMP_STRIDE + 1
    idx = np.arange(n_cmp)[:, None] * CMP_STRIDE + np.arange(CMP_LEN)[None, :]
    blk = kv[:, idx] + pe.astype(jnp.float32)[:, None, :]
    flat = blk.transpose(0, 1, 3, 2, 4).reshape(bsz, n_cmp, NSA_KV_HEADS, CMP_LEN * HEAD_DIM)
    return jax.nn.gelu(flat @ w1.astype(jnp.float32)) @ w2.astype(jnp.float32)


def nsa_mixer(q, kv, gate_logits, rel_table, pe_k, w1_k, w2_k, pe_v, w1_v, w2_v):
    bsz, seq = q.shape[:2]
    n_cmp = (seq - CMP_LEN) // CMP_STRIDE + 1
    n_sel = seq // SEL_LEN
    n_top = min(SEL_TOPK, n_sel)
    n_qb = seq // Q_BLOCK
    scale = HEAD_DIM ** -0.5
    kv = kv.astype(jnp.float32).reshape(bsz, seq, 6, NSA_KV_HEADS, HEAD_DIM)
    k_c, v_c, k_s, v_s, k_w, v_w = (kv[:, :, i] for i in range(6))

    kc = nsa_compress(k_c, pe_k, w1_k, w2_k)
    vc = nsa_compress(v_c, pe_v, w1_v, w2_v)
    cmp_end = jnp.arange(n_cmp) * CMP_STRIDE + CMP_LEN - 1
    cs = np.arange(n_cmp) * CMP_STRIDE
    ss = np.arange(n_sel) * SEL_LEN
    overlap = jnp.asarray(((cs[:, None] < ss[None, :] + SEL_LEN)
                           & (ss[None, :] < cs[:, None] + CMP_LEN)).astype(np.float32))

    ks_blk = k_s.reshape(bsz, n_sel, SEL_LEN, NSA_KV_HEADS, HEAD_DIM).transpose(0, 3, 1, 2, 4)
    vs_blk = v_s.reshape(bsz, n_sel, SEL_LEN, NSA_KV_HEADS, HEAD_DIM).transpose(0, 3, 1, 2, 4)

    pad = ((0, 0), (WINDOW, 0), (0, 0), (0, 0))
    kw_pad = jnp.pad(k_w, pad)
    vw_pad = jnp.pad(v_w, pad)

    q_blocks = (q.astype(jnp.float32) * scale).reshape(
        bsz, n_qb, Q_BLOCK, NSA_KV_HEADS, NSA_GQA, HEAD_DIM).transpose(1, 0, 2, 3, 4, 5)
    g_blocks = jax.nn.sigmoid(gate_logits.astype(jnp.float32)).reshape(
        bsz, n_qb, Q_BLOCK, NSA_KV_HEADS, NSA_GQA, 3).transpose(1, 0, 2, 3, 4, 5)
    sel_off = jnp.arange(SEL_LEN)
    sel_ids = jnp.arange(n_sel)
    win_off = jnp.arange(WINDOW + Q_BLOCK)
    gather = jax.vmap(jax.vmap(lambda tbl, ix: tbl[ix]))

    def block(args):
        qi, qb, gb = args
        t = qi * Q_BLOCK + jnp.arange(Q_BLOCK)
        dist_c = t[:, None] - cmp_end[None, :]
        s_c = jnp.einsum('bqhgd,bnhd->bhgqn', qb, kc) + rel_bias_dense(rel_table, dist_c)
        p_c = masked_softmax(s_c, dist_c >= 0)
        o_c = jnp.einsum('bhgqn,bnhd->bqhgd', p_c, vc)
        imp = jnp.einsum('bhgqn,nj->bhqj', p_c, overlap)
        cur = (t // SEL_LEN)[:, None]
        forced = (sel_ids == 0) | (sel_ids == cur) | (sel_ids == cur - 1)
        avail = sel_ids * SEL_LEN <= t[:, None]
        score = jnp.where(avail, imp + FORCE_BONUS * forced, NEG_INF)
        top_val, top_idx = lax.top_k(score, n_top)
        top_ok = top_val > 0.5 * NEG_INF
        ksel = gather(ks_blk, top_idx).reshape(bsz, NSA_KV_HEADS, Q_BLOCK, n_top * SEL_LEN, HEAD_DIM)
        vsel = gather(vs_blk, top_idx).reshape(bsz, NSA_KV_HEADS, Q_BLOCK, n_top * SEL_LEN, HEAD_DIM)
        pos = top_idx[..., None] * SEL_LEN + sel_off
        dist_s = t[:, None, None] - pos
        mask_s = ((dist_s >= 0) & top_ok[..., None]).reshape(bsz, NSA_KV_HEADS, 1, Q_BLOCK, -1)
        bias_s = rel_bias_selected(rel_table, dist_s).reshape(
            bsz, NSA_KV_HEADS, NSA_GQA, Q_BLOCK, n_top * SEL_LEN)
        s_s = jnp.einsum('bqhgd,bhqmd->bhgqm', qb, ksel) + bias_s
        p_s = masked_softmax(s_s, mask_s)
        o_s = jnp.einsum('bhgqm,bhqmd->bqhgd', p_s, vsel)
        start = qi * Q_BLOCK
        kwin = lax.dynamic_slice_in_dim(kw_pad, start, WINDOW + Q_BLOCK, axis=1)
        vwin = lax.dynamic_slice_in_dim(vw_pad, start, WINDOW + Q_BLOCK, axis=1)
        kpos = start - WINDOW + win_off
        dist_w = t[:, None] - kpos[None, :]
        mask_w = (dist_w >= 0) & (dist_w < WINDOW) & (kpos[None, :] >= 0)
        s_w = jnp.einsum('bqhgd,bkhd->bhgqk', qb, kwin) + rel_bias_dense(rel_table, dist_w)
        p_w = masked_softmax(s_w, mask_w)
        o_w = jnp.einsum('bhgqk,bkhd->bqhgd', p_w, vwin)
        o = gb[..., 0:1] * o_c + gb[..., 1:2] * o_s + gb[..., 2:3] * o_w
        return o.reshape(bsz, Q_BLOCK, NSA_WIDTH)

    out = lax.map(block, (jnp.arange(n_qb), q_blocks, g_blocks))
    return out.transpose(1, 0, 2, 3).reshape(bsz, seq, NSA_WIDTH).astype(q.dtype)


def rglru_mixer(xb, gb, conv_w, conv_b, w_a, b_a, w_x, b_x, lam):
    bsz, seq, width = xb.shape
    xc = lax.conv_general_dilated(xb, conv_w[:, None, :], window_strides=(1,),
                                  padding=((CONV_WIDTH - 1, 0),),
                                  dimension_numbers=('NWC', 'WIO', 'NWC'),
                                  feature_group_count=width) + conv_b
    xf = xc.astype(jnp.float32)
    xh = xf.reshape(bsz, seq, LRU_HEADS, LRU_HEAD_DIM)
    gate_r = jax.nn.sigmoid(jnp.einsum('bshi,hij->bshj', xh, w_a.astype(jnp.float32)).reshape(
        bsz, seq, width) + b_a.astype(jnp.float32))
    gate_i = jax.nn.sigmoid(jnp.einsum('bshi,hij->bshj', xh, w_x.astype(jnp.float32)).reshape(
        bsz, seq, width) + b_x.astype(jnp.float32))
    log_a = -LRU_C * gate_r * jax.nn.softplus(-lam.astype(jnp.float32))
    a = jnp.exp(log_a)
    mult = jnp.sqrt(-jnp.expm1(2.0 * log_a))
    bt = mult * gate_i * xf

    def combine(e1, e2):
        a1, b1 = e1
        a2, b2 = e2
        return (a1 * a2, a2 * b1 + b2)

    _, h = lax.associative_scan(combine, (a, bt), axis=1)
    y = h * jax.nn.gelu(gb.astype(jnp.float32))
    return y.astype(xb.dtype)


def swiglu(h, w_gate, w_up, w_down):
    return (jax.nn.silu(h @ w_gate) * (h @ w_up)) @ w_down


def setup_inputs(seed: int = 0) -> dict:
    key = jax.random.key(seed)
    ks = iter(jax.random.split(key, 48))
    f32 = jnp.float32
    L = DEPTH

    def nrm(shape, scale):
        return jax.random.normal(next(ks), shape, f32) * scale

    x = nrm((BATCH, SEQ, D_MODEL), 1.0)
    rel_bias_table = nrm((REL_BUCKETS, NSA_Q_HEADS), 0.1)
    norm_mix = 1.0 + nrm((L, D_MODEL), 0.02)
    w_in = nrm((L, D_MODEL, IN_WIDTH), D_MODEL ** -0.5)
    w_out = nrm((L, MIX_WIDTH, D_MODEL), MIX_WIDTH ** -0.5)
    s5_lam_re = -0.5 + nrm((L, S5_GROUPS, S5_STATE), 0.01)
    s5_lam_im = math.pi * jnp.arange(S5_STATE, dtype=f32) + nrm((L, S5_GROUPS, S5_STATE), 0.01)
    s5_log_dt = jax.random.uniform(next(ks), (L, S5_GROUPS), f32,
                                   minval=math.log(1e-3), maxval=math.log(1e-1))
    s5_b_re = nrm((L, S5_GROUPS, S5_STATE, S5_GROUP), (2 * S5_GROUP) ** -0.5)
    s5_b_im = nrm((L, S5_GROUPS, S5_STATE, S5_GROUP), (2 * S5_GROUP) ** -0.5)
    s5_c_re = nrm((L, S5_GROUPS, S5_GROUP, S5_STATE), S5_STATE ** -0.5)
    s5_c_im = nrm((L, S5_GROUPS, S5_GROUP, S5_STATE), S5_STATE ** -0.5)
    s5_d = nrm((L, SSM_WIDTH), 1.0)
    s5_w_glu = nrm((L, SSM_WIDTH, 2 * SSM_WIDTH), SSM_WIDTH ** -0.5)
    nsa_pe_k = nrm((L, CMP_LEN, HEAD_DIM), 0.02)
    nsa_w1_k = nrm((L, CMP_LEN * HEAD_DIM, HEAD_DIM), (CMP_LEN * HEAD_DIM) ** -0.5)
    nsa_w2_k = nrm((L, HEAD_DIM, HEAD_DIM), HEAD_DIM ** -0.5)
    nsa_pe_v = nrm((L, CMP_LEN, HEAD_DIM), 0.02)
    nsa_w1_v = nrm((L, CMP_LEN * HEAD_DIM, HEAD_DIM), (CMP_LEN * HEAD_DIM) ** -0.5)
    nsa_w2_v = nrm((L, HEAD_DIM, HEAD_DIM), HEAD_DIM ** -0.5)
    lru_conv_w = nrm((L, CONV_WIDTH, LRU_WIDTH), CONV_WIDTH ** -0.5)
    lru_conv_b = nrm((L, LRU_WIDTH), 0.01)
    lru_w_a = nrm((L, LRU_HEADS, LRU_HEAD_DIM, LRU_HEAD_DIM), LRU_HEAD_DIM ** -0.5)
    lru_b_a = nrm((L, LRU_WIDTH), 0.01)
    lru_w_x = nrm((L, LRU_HEADS, LRU_HEAD_DIM, LRU_HEAD_DIM), LRU_HEAD_DIM ** -0.5)
    lru_b_x = nrm((L, LRU_WIDTH), 0.01)
    a_pow = jax.random.uniform(next(ks), (L, LRU_WIDTH), f32, minval=0.9, maxval=0.999)
    a0 = a_pow ** (1.0 / LRU_C)
    lru_lam = jnp.log(a0) - jnp.log1p(-a0)
    norm_ffn = 1.0 + nrm((L, D_MODEL), 0.02)
    w_gate = nrm((L, D_MODEL, D_FF), D_MODEL ** -0.5)
    w_up = nrm((L, D_MODEL, D_FF), D_MODEL ** -0.5)
    w_down = nrm((L, D_FF, D_MODEL), D_FF ** -0.5)
    norm_final = 1.0 + nrm((D_MODEL,), 0.02)
    return {'x': x, 'rel_bias_table': rel_bias_table, 'norm_mix': norm_mix, 'w_in': w_in,
            'w_out': w_out, 's5_lam_re': s5_lam_re, 's5_lam_im': s5_lam_im,
            's5_log_dt': s5_log_dt, 's5_b_re': s5_b_re, 's5_b_im': s5_b_im,
            's5_c_re': s5_c_re, 's5_c_im': s5_c_im, 's5_d': s5_d, 's5_w_glu': s5_w_glu,
            'nsa_pe_k': nsa_pe_k, 'nsa_w1_k': nsa_w1_k, 'nsa_w2_k': nsa_w2_k,
            'nsa_pe_v': nsa_pe_v, 'nsa_w1_v': nsa_w1_v, 'nsa_w2_v': nsa_w2_v,
            'lru_conv_w': lru_conv_w, 'lru_conv_b': lru_conv_b, 'lru_w_a': lru_w_a,
            'lru_b_a': lru_b_a, 'lru_w_x': lru_w_x, 'lru_b_x': lru_b_x, 'lru_lam': lru_lam,
            'norm_ffn': norm_ffn, 'w_gate': w_gate, 'w_up': w_up, 'w_down': w_down,
            'norm_final': norm_final}


def reference(x, rel_bias_table, norm_mix, w_in, w_out, s5_lam_re, s5_lam_im, s5_log_dt,
              s5_b_re, s5_b_im, s5_c_re, s5_c_im, s5_d, s5_w_glu, nsa_pe_k, nsa_w1_k,
              nsa_w2_k, nsa_pe_v, nsa_w1_v, nsa_w2_v, lru_conv_w, lru_conv_b, lru_w_a,
              lru_b_a, lru_w_x, lru_b_x, lru_lam, norm_ffn, w_gate, w_up, w_down, norm_final):
    h = x
    splits = in_proj_splits()
    for l in range(DEPTH):
        hn = rmsnorm(h, norm_mix[l])
        z = hn @ w_in[l]
        u_ssm, q, kv, gate_logits, lru_x, lru_g = jnp.split(z, splits, axis=-1)
        y_ssm = s5_mixer(u_ssm, s5_lam_re[l], s5_lam_im[l], s5_log_dt[l], s5_b_re[l],
                         s5_b_im[l], s5_c_re[l], s5_c_im[l], s5_d[l], s5_w_glu[l])
        y_nsa = nsa_mixer(q, kv, gate_logits, rel_bias_table, nsa_pe_k[l], nsa_w1_k[l],
                          nsa_w2_k[l], nsa_pe_v[l], nsa_w1_v[l], nsa_w2_v[l])
        y_lru = rglru_mixer(lru_x, lru_g, lru_conv_w[l], lru_conv_b[l], lru_w_a[l], lru_b_a[l],
                            lru_w_x[l], lru_b_x[l], lru_lam[l])
        mix = jnp.concatenate([y_ssm, y_nsa, y_lru], axis=-1)
        h = h + mix @ w_out[l]
        h = h + swiglu(rmsnorm(h, norm_ffn[l]), w_gate[l], w_up[l], w_down[l])
    return rmsnorm(h, norm_final)
```

```cpp
#include <hip/hip_runtime.h>
#include <cstdio>
#include <cstdint>
namespace pg8 {
#define PG8_LAS __attribute__((address_space(3)))
typedef unsigned short bf16_t;
typedef short bf16x8 __attribute__((ext_vector_type(8)));
typedef float f32x4 __attribute__((ext_vector_type(4)));
typedef unsigned u32x4 __attribute__((ext_vector_type(4)));
constexpr int BM = 256, BK = 64, HALF = 128, HTB = HALF * BK * 2  , STAGE_BYTES = 8 * HTB, NXCD = 8, WGM = 8;

__host__ __device__ __forceinline__ int lds_byte(int r, int c) { const int st = (r >> 4) * 2 + (c >> 5), rr = r & 15, cc = c & 31, ob = rr * 64 + cc * 2; return st * 1024 + (ob ^ (((ob >> 9) & 1) << 5)); }
__host__ __device__ __forceinline__ void stage_rc(int b, int& R, int& C) { const int st = b / 1024, sb = b % 1024, swz = sb ^ (((sb >> 9) & 1) << 5); R = (st >> 1) * 16 + swz / 64; C = (st & 1) * 32 + (swz % 64) / 2; }
__host__ __device__ __forceinline__ int perm32(int rho) { const int n = rho >> 4, i = rho & 15; return 8 * (i >> 2) + 4 * n + (i & 3); }


struct Unit { int pm, pn; };
struct Gemm { const bf16_t* A; const bf16_t* Bt; int lda, K; };

struct StaticOrder {
    int nM, nN, nwg, G, c;
    __host__ __device__ void init(int M, int N, int G_, int c_) { nM = M / BM; nN = N / BM; nwg = nM * nN; G = G_; c = c_; }
    __host__ __device__ bool next(int i, Unit& u) const {
        const long L = (long)i * G + c; if (L >= nwg) return false;
        int wgid = (int)L; { const int q = nwg / NXCD, r = nwg % NXCD, xcd = wgid % NXCD, off = wgid / NXCD; wgid = (xcd < r ? xcd * (q + 1) : r * (q + 1) + (xcd - r) * q) + off; }
        const int nig = WGM * nN, gid = wgid / nig, fm = gid * WGM, gsz = (nM - fm) < WGM ? (nM - fm) : WGM;
        u.pm = fm + ((wgid % nig) % gsz); u.pn = (wgid % nig) / gsz; return true;
    }
    __device__ __forceinline__ void a_ready(const Unit&) const {}
    __device__ __forceinline__ void done(const Unit&) const {}
};
struct GroupOrder {
    int mt, nt, ntb, total, G, c;
    __host__ __device__ void init(int ng, int mt_, int nt_, int ntb_, int G_, int blk, int off) { mt = mt_; nt = nt_; ntb = ntb_; total = ng * mt_ * nt_; G = G_; c = (blk + G_ - (off % G_)) % G_; }
    __host__ __device__ bool next(int i, Unit& u) const {
        const long L = (long)i * G + c; if (L >= total) return false;
        const int per = mt * nt, grp = (int)L / per, r = (int)L % per; u.pm = grp * mt + r / nt; u.pn = grp * ntb + r % nt; return true;
    }
    __device__ __forceinline__ void a_ready(const Unit&) const {}
    __device__ __forceinline__ void done(const Unit&) const {}
};
__device__ __forceinline__ unsigned cvt_pk_bf16(float lo, float hi) { unsigned r; asm volatile("v_cvt_pk_bf16_f32 %0, %1, %2" : "=v"(r) : "v"(lo), "v"(hi)); return r; }
__device__ __forceinline__ int lane_id() { int l; asm volatile("v_mbcnt_lo_u32_b32 %0, -1, 0\n\tv_mbcnt_hi_u32_b32 %0, -1, %0" : "=v"(l)); return l; }
template <class Epi, class Sched, bool ALIGN_EPI = false, bool SP2 = false>
__device__ __forceinline__ void gemm_phase(PG8_LAS unsigned char* lds, const Gemm g, const Sched& S, const Epi& E, const int wave_in) {
    int tid_o = wave_in * 64 + lane_id(); asm volatile("" : "+v"(tid_o));
    const int tid = tid_o, wid = __builtin_amdgcn_readfirstlane(tid >> 6), lane = tid & 63, wr = wid >> 2, wc = wid & 3, fr = lane & 15, fq = lane >> 4;
    const int K = g.K, lda = g.lda, nt = K / BK;
    unsigned voffA[2], voffB[2];
#pragma unroll
    for (int i = 0; i < 2; ++i) { int R, C; stage_rc(tid * 16 + i * 8192, R, C); const int Rb = Epi::PERM ? ((R & ~31) + perm32(R & 31)) : R;
        voffA[i] = (unsigned)(R * lda + C) * 2u; voffB[i] = (unsigned)(Rb * K + C) * 2u; }
    const size_t kstep = (size_t)(BK * 2);
    const size_t hstep = (size_t)HALF * K * 2;
    const size_t tstep = 2 * hstep; const size_t hstepA = (size_t)HALF * lda * 2, tstepA = 2 * hstepA;
    const unsigned ldsw = (unsigned)wid * 1024u;
    const int aoff = lds_byte(wr * 64 + fr, fq * 8), boff = lds_byte(wc * 32 + fr, fq * 8);
#define PG8_SA(b, h) (((b) * 2 + (h)) * HTB)
#define PG8_SB(b, h) ((4 + (b) * 2 + (h)) * HTB)
#define PG8_STAGE(bufoff, gbase, voff) do { _Pragma("unroll") for (int _i = 0; _i < 2; ++_i) \
        __builtin_amdgcn_global_load_lds((const unsigned*)((const char*)(gbase) + (voff)[_i]), (PG8_LAS unsigned*)(lds + (bufoff) + ldsw + _i * 8192), 16, 0, 0); } while (0)
#define PG8_LDA(dst, b, h) do { _Pragma("unroll") for (int m = 0; m < 4; ++m) _Pragma("unroll") for (int k = 0; k < 2; ++k) dst[m][k] = *(const PG8_LAS bf16x8*)(lds + PG8_SA(b, h) + aoff + m * 2048 + k * 1024); } while (0)
#define PG8_LDB(dst, b, h) do { _Pragma("unroll") for (int n = 0; n < 2; ++n) _Pragma("unroll") for (int k = 0; k < 2; ++k) dst[n][k] = *(const PG8_LAS bf16x8*)(lds + PG8_SB(b, h) + boff + n * 2048 + k * 1024); } while (0)
#define PG8_MMA(ai, bj, At, Bt) do { __builtin_amdgcn_s_setprio(1); _Pragma("unroll") for (int m = 0; m < 4; ++m) _Pragma("unroll") for (int n = 0; n < 2; ++n) _Pragma("unroll") for (int k = 0; k < 2; ++k) \
        acc[ai][bj][m][n] = __builtin_amdgcn_mfma_f32_16x16x32_bf16(Bt[n][k], At[m][k], acc[ai][bj][m][n], 0, 0, 0); __builtin_amdgcn_s_setprio(0); } while (0)
#define PG8_WAIT_V(n) asm volatile("s_waitcnt vmcnt(" #n ")" ::: "memory")
#define PG8_WAIT_L(n) asm volatile("s_waitcnt lgkmcnt(" #n ")" ::: "memory")
#define PG8_BAR __builtin_amdgcn_s_barrier()
#define PG8_SCHED __builtin_amdgcn_sched_barrier(0)
    Unit cur, nxt; int ui = 0;
    if (!S.next(0, cur)) return;
    f32x4 acc[2][2][4][2];
#pragma unroll
    for (int a = 0; a < 2; ++a)
#pragma unroll
        for (int b = 0; b < 2; ++b)
#pragma unroll
            for (int m = 0; m < 4; ++m)
#pragma unroll
                for (int n = 0; n < 2; ++n) acc[a][b][m][n] = (f32x4){0.f, 0.f, 0.f, 0.f};
    bf16x8 At[4][2], B0[2][2], B1[2][2];
    const char* cA = (const char*)g.A + (size_t)cur.pm * tstepA; const char* cB = (const char*)g.Bt + (size_t)cur.pn * tstep;
    S.a_ready(cur);
    if constexpr (SP2) {
        PG8_STAGE(PG8_SB(0, 0), cB, voffB); PG8_STAGE(PG8_SB(0, 1), cB + hstep, voffB); PG8_STAGE(PG8_SA(0, 0), cA, voffA); PG8_STAGE(PG8_SA(0, 1), cA + hstepA, voffA);
        if (wr == 1) PG8_BAR;
        PG8_WAIT_V(2); PG8_BAR;
        PG8_STAGE(PG8_SB(1, 0), cB + kstep, voffB); PG8_STAGE(PG8_SA(1, 0), cA + kstep, voffA); PG8_STAGE(PG8_SB(1, 1), cB + hstep + kstep, voffB);
        PG8_WAIT_V(6); PG8_BAR;
    } else {
        PG8_STAGE(PG8_SB(0, 0), cB, voffB); PG8_STAGE(PG8_SA(0, 0), cA, voffA); PG8_STAGE(PG8_SB(0, 1), cB + hstep, voffB); PG8_STAGE(PG8_SA(0, 1), cA + hstepA, voffA);
        if (wr == 1) PG8_BAR;
        PG8_WAIT_V(4); PG8_BAR;
        PG8_STAGE(PG8_SB(1, 0), cB + kstep, voffB); PG8_STAGE(PG8_SA(1, 0), cA + kstep, voffA); PG8_STAGE(PG8_SB(1, 1), cB + hstep + kstep, voffB);
        PG8_WAIT_V(6); PG8_BAR;
    }
    for (;;) {
        const bool has_next = S.next(ui + 1, nxt);
        const char* nA = has_next ? (const char*)g.A + (size_t)nxt.pm * tstepA : cA; const char* nB = has_next ? (const char*)g.Bt + (size_t)nxt.pn * tstep : cB;
        _Pragma("unroll 1") for (int t = 0; t < nt; t += 2) {
            const bool last = (t == nt - 2);
            const char* a1 = cA + (size_t)(t + 1) * kstep;
            const char* a2 = last ? nA : cA + (size_t)(t + 2) * kstep; const char* b2 = last ? nB : cB + (size_t)(t + 2) * kstep;
            const char* a3 = a2 + kstep; const char* b3 = b2 + kstep;
            if (last && has_next) S.a_ready(nxt);
            if constexpr (SP2) {
            PG8_LDB(B0, 0, 0); PG8_LDB(B1, 0, 1); PG8_SCHED; PG8_LDA(At, 0, 0); PG8_STAGE(PG8_SA(1, 1), a1 + hstepA, voffA);
            PG8_WAIT_V(8); PG8_WAIT_L(0); PG8_BAR; PG8_MMA(0, 0, At, B0); PG8_MMA(0, 1, At, B1); PG8_BAR; PG8_SCHED;
            PG8_LDA(At, 0, 1); PG8_STAGE(PG8_SB(0, 0), b2, voffB); PG8_STAGE(PG8_SB(0, 1), b2 + hstep, voffB); PG8_STAGE(PG8_SA(0, 0), a2, voffA);
            PG8_WAIT_V(8); PG8_WAIT_L(0); PG8_BAR; PG8_MMA(1, 0, At, B0); PG8_MMA(1, 1, At, B1); PG8_BAR; PG8_SCHED;
            PG8_LDB(B0, 1, 0); PG8_LDB(B1, 1, 1); PG8_SCHED; PG8_LDA(At, 1, 0); PG8_STAGE(PG8_SA(0, 1), a2 + hstepA, voffA);
            PG8_WAIT_V(8); PG8_WAIT_L(0); PG8_BAR; PG8_MMA(0, 0, At, B0); PG8_MMA(0, 1, At, B1); PG8_BAR; PG8_SCHED;
            PG8_LDA(At, 1, 1); PG8_STAGE(PG8_SB(1, 0), b3, voffB); PG8_STAGE(PG8_SB(1, 1), b3 + hstep, voffB); PG8_STAGE(PG8_SA(1, 0), a3, voffA);
            PG8_WAIT_V(8); PG8_WAIT_L(0); PG8_BAR; PG8_MMA(1, 0, At, B0); PG8_MMA(1, 1, At, B1); PG8_BAR; PG8_SCHED;
            } else {
            PG8_LDB(B0, 0, 0); PG8_SCHED; PG8_LDA(At, 0, 0); PG8_STAGE(PG8_SA(1, 1), a1 + hstepA, voffA);
            PG8_WAIT_L(8); PG8_BAR; PG8_WAIT_L(0); PG8_MMA(0, 0, At, B0); PG8_BAR; PG8_SCHED;
            PG8_LDB(B1, 0, 1); PG8_STAGE(PG8_SB(0, 0), b2, voffB);
            PG8_BAR; PG8_WAIT_L(0); PG8_MMA(0, 1, At, B1); PG8_BAR;
            PG8_LDA(At, 0, 1); PG8_STAGE(PG8_SA(0, 0), a2, voffA);
            PG8_BAR; PG8_WAIT_L(0); PG8_MMA(1, 0, At, B0); PG8_BAR; PG8_SCHED;
            PG8_STAGE(PG8_SB(0, 1), b2 + hstep, voffB);
            PG8_WAIT_V(6); PG8_BAR; PG8_MMA(1, 1, At, B1); PG8_BAR;
            PG8_LDB(B0, 1, 0); PG8_SCHED; PG8_LDA(At, 1, 0); PG8_STAGE(PG8_SA(0, 1), a2 + hstepA, voffA);
            PG8_WAIT_L(8); PG8_BAR; PG8_WAIT_L(0); PG8_MMA(0, 0, At, B0); PG8_BAR; PG8_SCHED;
            PG8_LDB(B1, 1, 1); PG8_STAGE(PG8_SB(1, 0), b3, voffB);
            PG8_BAR; PG8_WAIT_L(0); PG8_MMA(0, 1, At, B1); PG8_BAR;
            PG8_LDA(At, 1, 1); PG8_STAGE(PG8_SA(1, 0), a3, voffA);
            PG8_BAR; PG8_WAIT_L(0); PG8_MMA(1, 0, At, B0); PG8_BAR; PG8_SCHED;
            PG8_STAGE(PG8_SB(1, 1), b3 + hstep, voffB);
            PG8_WAIT_V(6); PG8_BAR; PG8_MMA(1, 1, At, B1); PG8_BAR;
            }
        }
        if constexpr (ALIGN_EPI) { if (wr == 0) PG8_BAR; }
        if constexpr (!Epi::AFTER_DRAIN) { { const int l2_ = lane_id(); E(acc, cur, wr, wc, l2_ & 15, l2_ >> 4); } S.done(cur); }
        if (!has_next) break;
#pragma unroll
        for (int a = 0; a < 2; ++a)
#pragma unroll
            for (int b = 0; b < 2; ++b)
#pragma unroll
                for (int m = 0; m < 4; ++m)
#pragma unroll
                    for (int n = 0; n < 2; ++n) acc[a][b][m][n] = (f32x4){0.f, 0.f, 0.f, 0.f};
        cur = nxt; cA = nA; cB = nB; ++ui;
        if constexpr (ALIGN_EPI) { if (wr == 1) PG8_BAR; }
    }
    PG8_WAIT_V(0);
    if constexpr (!ALIGN_EPI) { if (wr == 0) PG8_BAR; }
    PG8_BAR;
    if constexpr (Epi::AFTER_DRAIN) { E.fused(acc, cur, wr, wc, fr, fq, lds, wid, lane); S.done(cur); }
#undef PG8_SA
#undef PG8_SB
#undef PG8_STAGE
#undef PG8_LDA
#undef PG8_LDB
#undef PG8_MMA
#undef PG8_WAIT_V
#undef PG8_WAIT_L
#undef PG8_BAR
#undef PG8_SCHED
}
}
#define GAS __attribute__((address_space(1)))
#define LAS __attribute__((address_space(3)))
typedef unsigned short bf16;
typedef unsigned v4u __attribute__((ext_vector_type(4)));
typedef float f32x4 __attribute__((ext_vector_type(4)));
typedef short bf16x8 __attribute__((ext_vector_type(8)));
typedef GAS unsigned gu32;
typedef GAS unsigned long long gu64;
#define RLX_AGENT __ATOMIC_RELAXED, __HIP_MEMORY_SCOPE_AGENT
#define LDS_WAIT() asm volatile("s_waitcnt lgkmcnt(0)" ::: "memory")
#define VM_WAIT() asm volatile("s_waitcnt vmcnt(0)" ::: "memory")
__device__ __forceinline__ unsigned long long rt() { return __builtin_amdgcn_s_memrealtime(); }
__device__ __forceinline__ unsigned f2bf(float f) { unsigned u = __builtin_bit_cast(unsigned, f); return (u + 0x7fffu + ((u >> 16) & 1u)) >> 16; }
__device__ __forceinline__ unsigned pk2(float lo, float hi) { return f2bf(lo) | (f2bf(hi) << 16); }

#define XB_TMO      128
#define XB_XCNT(j)  (256  + 64 * (j))
#define XB_XSUB(j)  (1280 + 64 * (j))
#define XB_XGEN(j)  (2304 + 64 * (j))
#define XB_TOP      3328
#define XB_TOPGEN   3392
#define XCD_BAR_WORDS 3456
#define XB_SPIN_CAP (1u << 18)

__device__ __forceinline__ unsigned xb_ld(unsigned* p)              { return __hip_atomic_load(p, __ATOMIC_RELAXED, __HIP_MEMORY_SCOPE_AGENT); }
__device__ __forceinline__ unsigned xb_add(unsigned* p, unsigned v) { return __hip_atomic_fetch_add(p, v, __ATOMIC_RELAXED, __HIP_MEMORY_SCOPE_AGENT); }
__device__ __forceinline__ unsigned xb_xcc_id() { return (unsigned)__builtin_amdgcn_s_getreg((3 << 11) | 20) & 0xFu; }
#define XB_SPIN(cond, bar) do { unsigned _sp = 0; while (cond) { __builtin_amdgcn_s_sleep(1); \
    if ((++_sp & 255u) == 0u) { if (xb_ld(&(bar)[XB_TMO])) break; if (_sp > XB_SPIN_CAP) { atomicAdd(&(bar)[XB_TMO], 1u); break; } } } } while (0)

struct XcdBarrier {
    unsigned* bar; unsigned x;
    volatile LAS unsigned* st;
};

__device__ __forceinline__ XcdBarrier xcd_barrier_post(unsigned* bar, volatile LAS unsigned* st) {
    XcdBarrier b; b.bar = bar; b.x = xb_xcc_id(); b.st = st;
    if (threadIdx.x == 0) (void)xb_add(&bar[XB_XCNT(b.x)], 1u);
    return b;
}
__device__ __forceinline__ void xcd_barrier_complete(unsigned* bar, unsigned x, unsigned& nloc, unsigned& nx) {
    const unsigned G = gridDim.x * gridDim.y * gridDim.z;
    unsigned sum, cnt, mine, sp = 0u;
    for (;;) {
        sum = 0u; cnt = 0u; mine = 0u;
#pragma unroll
        for (unsigned j = 0; j < 16; ++j) { const unsigned c = xb_ld(&bar[XB_XCNT(j)]); sum += c; cnt += (c > 0u) ? 1u : 0u; mine = (j == x) ? c : mine; }
        if (sum == G) break;
        __builtin_amdgcn_s_sleep(1);
        if ((++sp & 255u) == 0u) { if (xb_ld(&bar[XB_TMO])) break; if (sp > XB_SPIN_CAP) { atomicAdd(&bar[XB_TMO], 1u); break; } }
    }
    nloc = mine > 0u ? mine : 1u; nx = cnt > 0u ? cnt : 1u;
}

__device__ __forceinline__ void xcd_barrier(const XcdBarrier& b) {
    asm volatile("s_waitcnt vmcnt(0)" ::: "memory");
    __syncthreads();
    if (threadIdx.x == 0) {
        unsigned* bar = b.bar;
        __builtin_amdgcn_s_waitcnt(0);
        unsigned nloc = b.st[0], nx = b.st[1];
        if (nloc == 0u) { xcd_barrier_complete(bar, b.x, nloc, nx); b.st[0] = nloc; b.st[1] = nx; }
        const unsigned old = xb_add(&bar[XB_XSUB(b.x)], 1u);
        const unsigned gen = old / nloc;
        if (old + 1u == (gen + 1u) * nloc) {
            __builtin_amdgcn_fence(__ATOMIC_RELEASE, "agent");
            asm volatile("s_waitcnt vmcnt(0)" ::: "memory");
            const unsigned og = xb_add(&bar[XB_TOP], 1u);
            const unsigned tg = og / nx;
            if (og + 1u == (tg + 1u) * nx) xb_add(&bar[XB_TOPGEN], 1u);
            else XB_SPIN(xb_ld(&bar[XB_TOPGEN]) == tg, bar);
            __builtin_amdgcn_fence(__ATOMIC_ACQUIRE, "agent");
            xb_add(&bar[XB_XGEN(b.x)], 1u);
            asm volatile("s_waitcnt vmcnt(0)" ::: "memory");
        } else {
            XB_SPIN(xb_ld(&bar[XB_XGEN(b.x)]) == gen, bar);
            __builtin_amdgcn_fence(__ATOMIC_ACQUIRE, "agent");
            asm volatile("s_waitcnt vmcnt(0)" ::: "memory");
        }
    }
    __syncthreads();
}

using pg8::bf16_t; using pg8::Unit; using pg8::BM; using pg8::HALF;
typedef unsigned u32x2v __attribute__((ext_vector_type(2)));
constexpr int NB = 16, SEQ = 2048, M = NB * SEQ, D = 1024, NIN = 2304, NINV = 2072, DFF = 2816, NGU = 2 * DFF, NLAYER = 2;
constexpr int L5 = 32, NCH = SEQ / L5, NS5 = 16 * L5, KS5 = NS5 + 128;
constexpr float LOG2E = 1.4426950408889634f, QSCALE = 0.125f * LOG2E;
constexpr int NWAVES = 8, NTHREADS = 512;
constexpr size_t MiB = 1u << 20;
constexpr size_t WS_CTL = 0, CTL_ZERO_BYTES = 64 * 1024;
constexpr size_t WS_WIN  = 1 * MiB;                                   constexpr size_t SZ_WIN  = (size_t)NIN * D * 2;
constexpr size_t WS_WOUT = WS_WIN  + NLAYER * SZ_WIN;                 constexpr size_t SZ_WOUT = (size_t)D * D * 2;
constexpr size_t WS_WGU  = WS_WOUT + NLAYER * SZ_WOUT;                constexpr size_t SZ_WGU  = (size_t)NGU * D * 2;
constexpr size_t WS_WD   = WS_WGU  + NLAYER * SZ_WGU;                 constexpr size_t SZ_WD   = (size_t)D * DFF * 2;
constexpr size_t WS_WGLU = WS_WD   + NLAYER * SZ_WD;                  constexpr size_t SZ_WGLU = (size_t)512 * 256 * 2;
constexpr size_t WS_WLRU = WS_WGLU + NLAYER * SZ_WGLU;                constexpr size_t SZ_WLRU = (size_t)512 * 256 * 2;
constexpr size_t WS_W1   = WS_WLRU + NLAYER * SZ_WLRU;                constexpr size_t SZ_W1   = (size_t)2 * 256 * 2048 * 2;
constexpr size_t WS_TOP  = WS_W1   + NLAYER * SZ_W1;                  constexpr size_t SZ_TOP  = (size_t)16 * NS5 * KS5 * 2;
constexpr size_t WS_MOP  = WS_TOP  + NLAYER * SZ_TOP;                 constexpr size_t SZ_MOP  = (size_t)16 * 256 * NS5 * 2;
constexpr size_t WS_TAB  = WS_MOP  + NLAYER * SZ_MOP;                 constexpr size_t SZ_TAB  = 16384;
constexpr size_t WS_LUT  = WS_TAB  + NLAYER * SZ_TAB;
constexpr size_t WS_RS   = (WS_LUT + 8192 + 255) & ~(size_t)255;
constexpr size_t WS_XN   = (WS_RS + (size_t)M * 16 * 4 + MiB - 1) & ~(MiB - 1);
constexpr size_t WS_MIXR = WS_XN + (size_t)M * D * 2;
constexpr size_t WS_Q    = WS_MIXR;
constexpr size_t WS_KC   = WS_Q   + (size_t)M * 512 * 2;
constexpr size_t WS_VC   = WS_KC  + (size_t)M * 128 * 2;
constexpr size_t WS_KS   = WS_VC  + (size_t)M * 128 * 2 + 65536;
constexpr size_t WS_KW   = WS_KS  + (size_t)M * 128 * 2;
constexpr size_t WS_VST  = WS_KW  + (size_t)M * 128 * 2;
constexpr size_t WS_VWT  = WS_VST + (size_t)M * 128 * 2;
constexpr size_t WS_AS5  = WS_VWT + (size_t)M * 128 * 2;
constexpr size_t WS_SLOC = WS_AS5 + (size_t)16 * 1024 * KS5 * 2;
constexpr size_t WS_YS   = WS_SLOC + (size_t)16 * 1024 * 128 * 4;
constexpr size_t WS_LX   = WS_YS  + (size_t)M * 256 * 2;
constexpr size_t WS_LG   = WS_LX  + (size_t)M * 256 * 2;
constexpr size_t WS_XC   = WS_LG  + (size_t)M * 256 * 2;
constexpr size_t WS_LA   = WS_XC  + (size_t)M * 256 * 2;
constexpr size_t WS_LB   = WS_LA  + (size_t)M * 256 * 4;
constexpr size_t WS_GATES= WS_LB  + (size_t)M * 256 * 4;
constexpr size_t WS_H1C  = WS_GATES + (size_t)M * 32 * 4;
constexpr size_t WS_KCC  = WS_H1C + (size_t)2 * 32 * 128 * 64 * 4;
constexpr size_t WS_VCT  = WS_KCC + (size_t)32 * 128 * 64 * 2;
constexpr size_t WS_MIX  = WS_VCT + (size_t)32 * 128 * 64 * 2;
constexpr size_t WS_END  = WS_MIX + (size_t)M * D * 2;
constexpr size_t WS_HMID = WS_MIXR;
static_assert(WS_HMID + (size_t)M * DFF * 2 <= WS_MIX, "HMID overlay must end before MIX");
constexpr int TB_BIAS1 = 0;
constexpr int TB_SP    = 128;
constexpr int TB_A32   = 512;
constexpr int CW_BAR = 4096;

constexpr int RING_BYTES = 131072, MISC_OFF = RING_BYTES + 320, LDS_BYTES = 147456;

__device__ __forceinline__ float bf2f(unsigned h) { return __uint_as_float(h << 16); }
__device__ __forceinline__ float sigmoidf_(float x) { return __builtin_amdgcn_rcpf(1.0f + __expf(-x)); }
__device__ __forceinline__ float gelu_tanh(float x) { const float u = 1.5957691216057308f * (x + 0.044715f * x * x * x); return x * __builtin_amdgcn_rcpf(1.0f + __expf(-u)); }
__device__ __forceinline__ v4u pack8(const float (&v)[8]) { v4u w; w.x = pg8::cvt_pk_bf16(v[0], v[1]); w.y = pg8::cvt_pk_bf16(v[2], v[3]); w.z = pg8::cvt_pk_bf16(v[4], v[5]); w.w = pg8::cvt_pk_bf16(v[6], v[7]); return w; }
__device__ __forceinline__ void unpack8(const v4u w, float (&v)[8]) { v[0] = bf2f(w.x & 0xffffu); v[1] = bf2f(w.x >> 16); v[2] = bf2f(w.y & 0xffffu); v[3] = bf2f(w.y >> 16); v[4] = bf2f(w.z & 0xffffu); v[5] = bf2f(w.z >> 16); v[6] = bf2f(w.w & 0xffffu); v[7] = bf2f(w.w >> 16); }
__device__ __forceinline__ float row_rstd(const float* RS, int row, int fq) {
    const f32x4 v = *(const f32x4*)(RS + (size_t)row * 16 + 4 * fq);
    float s = (v.x + v.y) + (v.z + v.w); s += __shfl_xor(s, 16); s += __shfl_xor(s, 32);
    return rsqrtf(s * (1.0f / 1024.0f) + 1e-6f);
}
typedef const pg8::f32x4 (&AccRef)[2][2][4][2];

struct EpiInProj {
    static constexpr bool PERM = true, AFTER_DRAIN = false;
    unsigned char* w;
    __device__ __forceinline__ void operator()(AccRef acc, const Unit& u, int wr, int wc, int fr, int fq) const {
        const int pn = u.pn;
        const float* RS = (const float*)(w + WS_RS); bf16_t* Q = (bf16_t*)(w + WS_Q); bf16_t* KC = (bf16_t*)(w + WS_KC); bf16_t* VC = (bf16_t*)(w + WS_VC); bf16_t* KS = (bf16_t*)(w + WS_KS); bf16_t* KW = (bf16_t*)(w + WS_KW);
        bf16_t* VST = (bf16_t*)(w + WS_VST); bf16_t* VWT = (bf16_t*)(w + WS_VWT); bf16_t* AS5 = (bf16_t*)(w + WS_AS5); bf16_t* LX = (bf16_t*)(w + WS_LX); bf16_t* LG = (bf16_t*)(w + WS_LG); float* GATES = (float*)(w + WS_GATES);
#pragma unroll
        for (int ai = 0; ai < 2; ++ai)
#pragma unroll
            for (int m = 0; m < 4; ++m) {
                const int row = u.pm * BM + ai * HALF + wr * 64 + m * 16 + fr;
                const float rs = row_rstd(RS, row, fq);
                const int b = row >> 11, t = row & 2047;
#pragma unroll
                for (int bj = 0; bj < 2; ++bj) {
                    const int c8 = bj * HALF + wc * 32 + 8 * fq;
                    float v[8];
#pragma unroll
                    for (int j = 0; j < 4; ++j) { v[j] = acc[ai][bj][m][0][j] * rs; v[4 + j] = acc[ai][bj][m][1][j] * rs; }
                    if (pn == 0) {
                        const int g = c8 >> 4, co = c8 & 15;
                        *(v4u*)(AS5 + ((size_t)(g * 1024 + b * 64 + (t >> 5)) * KS5 + (t & 31) * 16 + co)) = pack8(v);
                    } else if (pn <= 2) {
#pragma unroll
                        for (int j = 0; j < 8; ++j) v[j] *= QSCALE;
                        *(v4u*)(Q + (size_t)row * 512 + (pn - 1) * 256 + c8) = pack8(v);
                    } else if (pn <= 5) {
                        const int c = c8 & 127, h = c >> 6, d = c & 63;
                        const size_t kvrow = (size_t)(b * 2 + h) * 2048 + t;
                        if (bj == 0) { bf16_t* base = pn == 3 ? KC : (pn == 4 ? KS : KW); *(v4u*)(base + kvrow * 64 + d) = pack8(v); }
                        else if (pn == 3) { *(v4u*)(VC + kvrow * 64 + d) = pack8(v); }
                        else { bf16_t* base = pn == 4 ? VST : VWT;
#pragma unroll
                            for (int j = 0; j < 8; ++j) base[((size_t)(b * 2 + h) * 64 + d + j) * 2048 + t] = (bf16_t)f2bf(v[j]); }
                    } else if (pn == 6) {
                        *(v4u*)(LX + (size_t)row * 256 + c8) = pack8(v);
                    } else if (pn == 7) {
#pragma unroll
                        for (int j = 0; j < 8; ++j) v[j] = gelu_tanh(v[j]);
                        *(v4u*)(LG + (size_t)row * 256 + c8) = pack8(v);
                    } else {
                        if (bj == 0 && wc == 0 && fq < 3) {
                            f32x4 a, c; a.x = sigmoidf_(v[0]); a.y = sigmoidf_(v[1]); a.z = sigmoidf_(v[2]); a.w = sigmoidf_(v[3]);
                            c.x = sigmoidf_(v[4]); c.y = sigmoidf_(v[5]); c.z = sigmoidf_(v[6]); c.w = sigmoidf_(v[7]);
                            *(f32x4*)(GATES + (size_t)row * 32 + 8 * fq) = a; *(f32x4*)(GATES + (size_t)row * 32 + 8 * fq + 4) = c; }
                    }
                }
            }
    }
};
struct EpiResid {
    static constexpr bool PERM = false, AFTER_DRAIN = false;
    const float* Hin; float* Hout; bf16_t* XN; float* RS;
    __device__ __forceinline__ void operator()(AccRef acc, const Unit& u, int wr, int wc, int fr, int fq) const {
#pragma unroll
        for (int ai = 0; ai < 2; ++ai)
#pragma unroll
            for (int m = 0; m < 4; ++m) {
                const int row = u.pm * BM + ai * HALF + wr * 64 + m * 16 + fr; float ss = 0.f;
#pragma unroll
                for (int bj = 0; bj < 2; ++bj)
#pragma unroll
                    for (int n = 0; n < 2; ++n) {
                        const size_t off = (size_t)row * D + u.pn * BM + bj * HALF + wc * 32 + 16 * n + 4 * fq;
                        f32x4 h = *(const f32x4*)(Hin + off); h = h + acc[ai][bj][m][n];
                        *(f32x4*)(Hout + off) = h;
                        u32x2v w; w.x = pg8::cvt_pk_bf16(h.x, h.y); w.y = pg8::cvt_pk_bf16(h.z, h.w); *(u32x2v*)(XN + off) = w;
                        ss += (h.x * h.x + h.y * h.y) + (h.z * h.z + h.w * h.w);
                    }
                ss += __shfl_xor(ss, 16); ss += __shfl_xor(ss, 32);
                if (fq == 0) RS[(size_t)row * 16 + u.pn * 4 + wc] = ss;
            }
    }
};
struct EpiGateUp {
    static constexpr bool PERM = true, AFTER_DRAIN = false;
    const float* RS; bf16_t* HM;
    __device__ __forceinline__ void operator()(AccRef acc, const Unit& u, int wr, int wc, int fr, int fq) const {
#pragma unroll
        for (int ai = 0; ai < 2; ++ai)
#pragma unroll
            for (int m = 0; m < 4; ++m) {
                const int row = u.pm * BM + ai * HALF + wr * 64 + m * 16 + fr;
                const float rs = row_rstd(RS, row, fq);
                float v[8];
#pragma unroll
                for (int n = 0; n < 2; ++n)
#pragma unroll
                    for (int j = 0; j < 4; ++j) { const float g = acc[ai][0][m][n][j] * rs, up = acc[ai][1][m][n][j] * rs; v[4 * n + j] = g * sigmoidf_(g) * up; }
                *(v4u*)(HM + (size_t)row * DFF + u.pn * 128 + wc * 32 + 8 * fq) = pack8(v);
                asm volatile("" ::: "memory");
            }
    }
};
struct EpiS5State {
    static constexpr bool PERM = false, AFTER_DRAIN = false;
    float* SLOC;
    __device__ __forceinline__ void operator()(AccRef acc, const Unit& u, int wr, int wc, int fr, int fq) const {
#pragma unroll
        for (int ai = 0; ai < 2; ++ai)
#pragma unroll
            for (int m = 0; m < 4; ++m) {
                const int row = u.pm * BM + ai * HALF + wr * 64 + m * 16 + fr;
#pragma unroll
                for (int n = 0; n < 2; ++n) *(f32x4*)(SLOC + (size_t)row * 128 + wc * 32 + 16 * n + 4 * fq) = acc[ai][0][m][n];
            }
    }
};
struct EpiS5Main {
    static constexpr bool PERM = true, AFTER_DRAIN = false;
    const bf16_t* AS5; const float* dskip; bf16_t* YS;
    __device__ __forceinline__ void operator()(AccRef acc, const Unit& u, int wr, int wc, int fr, int fq) const {
#pragma unroll
        for (int ai = 0; ai < 2; ++ai)
#pragma unroll
            for (int m = 0; m < 4; ++m) {
                const int R = u.pm * BM + ai * HALF + wr * 64 + m * 16 + fr;
                const int g = R >> 10, b = (R >> 6) & 15, ch = R & 63;
#pragma unroll
                for (int bj = 0; bj < 2; ++bj) {
                    const int cg = (u.pn & 1) * 256 + bj * HALF + wc * 32 + 8 * fq, t = cg >> 4, co = cg & 15;
                    float uu[8], v[8]; unpack8(*(const v4u*)(AS5 + (size_t)R * KS5 + cg), uu);
                    const f32x4 d0 = *(const f32x4*)(dskip + 16 * g + co), d1 = *(const f32x4*)(dskip + 16 * g + co + 4);
#pragma unroll
                    for (int j = 0; j < 4; ++j) { v[j] = gelu_tanh(acc[ai][bj][m][0][j] + d0[j] * uu[j]); v[4 + j] = gelu_tanh(acc[ai][bj][m][1][j] + d1[j] * uu[4 + j]); }
                    *(v4u*)(YS + (size_t)(b * 2048 + ch * 32 + t) * 256 + 16 * g + co) = pack8(v);
                }
            }
    }
};
struct EpiGlu {
    static constexpr bool PERM = true, AFTER_DRAIN = false;
    bf16_t* MIX;
    __device__ __forceinline__ void operator()(AccRef acc, const Unit& u, int wr, int wc, int fr, int fq) const {
#pragma unroll
        for (int ai = 0; ai < 2; ++ai)
#pragma unroll
            for (int m = 0; m < 4; ++m) {
                const int row = u.pm * BM + ai * HALF + wr * 64 + m * 16 + fr;
                float v[8];
#pragma unroll
                for (int n = 0; n < 2; ++n)
#pragma unroll
                    for (int j = 0; j < 4; ++j) v[4 * n + j] = acc[ai][0][m][n][j] * sigmoidf_(acc[ai][1][m][n][j]);
                *(v4u*)(MIX + (size_t)row * D + u.pn * 128 + wc * 32 + 8 * fq) = pack8(v);
                asm volatile("" ::: "memory");
            }
    }
};
struct EpiLruGates {
    static constexpr bool PERM = false, AFTER_DRAIN = false;
    const bf16_t* XC; const float *b_a, *b_x, *sp; float *LA, *LB;
    __device__ __forceinline__ void operator()(AccRef acc, const Unit& u, int wr, int wc, int fr, int fq) const {
#pragma unroll
        for (int n = 0; n < 2; ++n) {
            const int ch = u.pn * 128 + wc * 32 + 16 * n + 4 * fq;
            const f32x4 ba = *(const f32x4*)(b_a + ch), bx = *(const f32x4*)(b_x + ch), s4 = *(const f32x4*)(sp + ch);
#pragma unroll
            for (int ai = 0; ai < 2; ++ai)
#pragma unroll
                for (int m = 0; m < 4; ++m) {
                    const int row = u.pm * BM + ai * HALF + wr * 64 + m * 16 + fr;
                    const u32x2v xw = *(const u32x2v*)(XC + (size_t)row * 256 + ch);
                    const float xc[4] = {bf2f(xw.x & 0xffffu), bf2f(xw.x >> 16), bf2f(xw.y & 0xffffu), bf2f(xw.y >> 16)};
                    f32x4 a, bt;
#pragma unroll
                    for (int j = 0; j < 4; ++j) {
                        const float r = sigmoidf_(acc[ai][0][m][n][j] + ba[j]), ig = sigmoidf_(acc[ai][1][m][n][j] + bx[j]);
                        const float la = -8.0f * r * s4[j];
                        const float av = __expf(la); a[j] = av; bt[j] = sqrtf(fmaxf(1.0f - av * av, 0.f)) * ig * xc[j];
                    }
                    *(f32x4*)(LA + (size_t)row * 256 + ch) = a; *(f32x4*)(LB + (size_t)row * 256 + ch) = bt;
                    asm volatile("" ::: "memory");
                }
        }
    }
};
struct EpiCompress {
    static constexpr bool PERM = false, AFTER_DRAIN = false;
    const float* bias1; float* H1C;
    __device__ __forceinline__ void operator()(AccRef acc, const Unit& u, int wr, int wc, int fr, int fq) const {
        if (wc >= 2) return;
#pragma unroll
        for (int n = 0; n < 2; ++n) {
            const int j0 = wc * 32 + 16 * n + 4 * fq;
            const f32x4 bv = *(const f32x4*)(bias1 + u.pn * 64 + j0);
#pragma unroll
            for (int ai = 0; ai < 2; ++ai)
#pragma unroll
                for (int m = 0; m < 4; ++m) {
                    const int row = u.pm * BM + ai * HALF + wr * 64 + m * 16 + fr;
                    f32x4 h = acc[ai][0][m][n] + bv; h.x = gelu_tanh(h.x); h.y = gelu_tanh(h.y); h.z = gelu_tanh(h.z); h.w = gelu_tanh(h.w);
                    *(f32x4*)(H1C + (size_t)row * 64 + j0) = h;
                }
        }
    }
};

__device__ __forceinline__ float wave_sum(float v) {
#pragma unroll
    for (int o = 1; o < 64; o <<= 1) v += __shfl_xor(v, o);
    return v;
}
struct RmIdent { __device__ __forceinline__ int operator()(int n) const { return n; } };
struct RmWin   { __device__ __forceinline__ int operator()(int n) const { return n < 1536 ? n : (n < 1560 ? 2048 + (n - 1536) : n - 24); } };
struct RmPair  { int half, split; __device__ __forceinline__ int operator()(int n) const { const int c = n - split; return 256 * (c >> 7) + half * 128 + (c & 127); } };
struct RmGlu   { __device__ __forceinline__ int operator()(int n) const { const int hf = n >= 256, c = n - 256 * hf; return 256 * (c >> 7) + hf * 128 + (c & 127); } };
template <class RowMap>
__device__ __forceinline__ void tr_item(const float* W, int ldw, int ncols, int K, const float* kscale, bf16_t* WT, const RowMap rm, LAS float* scr, int item, int lane) {
    const int nblk = (ncols + 31) >> 5, kb = item / nblk, nb = item - kb * nblk, k0 = 64 * kb, n0 = 32 * nb;
    const int nn = n0 + (lane & 31);
#pragma unroll 8
    for (int i = 0; i < 32; ++i) { const int kk = 2 * i + (lane >> 5); float v = nn < ncols ? W[(size_t)(k0 + kk) * ldw + nn] : 0.f; if (kscale) v *= kscale[k0 + kk]; scr[kk * 33 + (lane & 31)] = v; }
    LDS_WAIT(); asm volatile("" ::: "memory");
    const int c = lane & 7;
#pragma unroll
    for (int j = 0; j < 4; ++j) { const int nl = (lane >> 3) + 8 * j, n = n0 + nl; const LAS float* s = scr + (8 * c) * 33 + nl;
        v4u o; o.x = pk2(s[0 * 33], s[1 * 33]); o.y = pk2(s[2 * 33], s[3 * 33]); o.z = pk2(s[4 * 33], s[5 * 33]); o.w = pk2(s[6 * 33], s[7 * 33]);
        if (n < ncols) *(v4u*)(WT + (size_t)rm(n) * K + k0 + 8 * c) = o; }
    LDS_WAIT(); asm volatile("" ::: "memory");
}
template <class RowMap>
__device__ __forceinline__ void tr_job(const float* W, int ldw, int ncols, int K, const float* kscale, bf16_t* WT, const RowMap rm, LAS float* scr, int gw, int NGW, int lane, int rot) {
    const int nitems = (K >> 6) * ((ncols + 31) >> 5);
    for (int it = (gw + rot) % NGW; it < nitems; it += NGW) tr_item(W, ldw, ncols, K, kscale, WT, rm, scr, it, lane);
}
__device__ __forceinline__ void zero_job(void* p, size_t n16, int gtid, int NT) { v4u z = {0u, 0u, 0u, 0u}; for (size_t i = gtid; i < n16; i += NT) ((v4u*)p)[i] = z; }

struct S5Coef { float lr, li, dt; };
__device__ __forceinline__ S5Coef s5_coef(const float* lam_re, const float* lam_im, const float* log_dt, int l, int g, int p) {
    S5Coef c; c.lr = lam_re[(l * 16 + g) * 64 + p]; c.li = lam_im[(l * 16 + g) * 64 + p]; c.dt = expf(log_dt[l * 16 + g]); return c; }
__device__ __forceinline__ void s5_apow(const S5Coef& c, float tau, float& re, float& im) { const float mag = expf(c.lr * c.dt * tau), ang = c.li * c.dt * tau; re = mag * cosf(ang); im = mag * sinf(ang); }
__device__ __forceinline__ void s5_f(const S5Coef& c, float& fre, float& fim) {
    float are, aim; s5_apow(c, 1.0f, are, aim); const float den = c.lr * c.lr + c.li * c.li;
    fre = ((are - 1.0f) * c.lr + aim * c.li) / den; fim = (aim * c.lr - (are - 1.0f) * c.li) / den; }

struct Args { const float* in[32]; float* out; unsigned char* ws; int ph_lo, ph_hi; };

__device__ __forceinline__ int t5_bucket(int n) { if (n < 16) return n; const int lg = 16 + (int)(logf((float)n * (1.0f / 16.0f)) / 2.0794415416798357f * 16.0f); return lg < 31 ? lg : 31; }

__device__ __forceinline__ void p0_prologue(const Args& P, LAS unsigned char* lds, int tid, int lane, int wave, int bid, int G) {
    LAS float* scr = (LAS float*)(lds + wave * 16384);
    const int gw = bid * NWAVES + wave, NGW = G * NWAVES, gtid = bid * NTHREADS + tid, NT = G * NTHREADS;
    unsigned char* ws = P.ws;
    { const float* x = P.in[0]; bf16_t* XN = (bf16_t*)(ws + WS_XN); float* RS = (float*)(ws + WS_RS);
      for (int m = gw; m < M; m += NGW) {
          const f32x4* xr = (const f32x4*)(x + (size_t)m * D) + lane; f32x4 v[4]; float s = 0.f;
#pragma unroll
          for (int j = 0; j < 4; ++j) { v[j] = xr[64 * j]; s += (v[j].x * v[j].x + v[j].y * v[j].y) + (v[j].z * v[j].z + v[j].w * v[j].w); }
          s = wave_sum(s);
#pragma unroll
          for (int j = 0; j < 4; ++j) { u32x2v w; w.x = pg8::cvt_pk_bf16(v[j].x, v[j].y); w.y = pg8::cvt_pk_bf16(v[j].z, v[j].w); *(u32x2v*)(XN + (size_t)m * D + (64 * j + lane) * 4) = w; }
          if (lane < 16) RS[(size_t)m * 16 + lane] = lane == 0 ? s : 0.f;
      } }
    for (int l = 0; l < NLAYER; ++l) {
        bf16_t* WinT = (bf16_t*)(ws + WS_WIN + l * SZ_WIN); bf16_t* WoutT = (bf16_t*)(ws + WS_WOUT + l * SZ_WOUT); bf16_t* WguT = (bf16_t*)(ws + WS_WGU + l * SZ_WGU);
        bf16_t* WdT = (bf16_t*)(ws + WS_WD + l * SZ_WD); bf16_t* WgluT = (bf16_t*)(ws + WS_WGLU + l * SZ_WGLU); bf16_t* W1T = (bf16_t*)(ws + WS_W1 + l * SZ_W1);
        tr_job(P.in[3] + (size_t)l * D * NINV, NINV, NINV, D, P.in[2] + l * D, WinT, RmWin(), scr, gw, NGW, lane, 0);
        tr_job(P.in[4] + (size_t)l * D * D, D, D, D, (const float*)nullptr, WoutT, RmIdent(), scr, gw, NGW, lane, 1040);
        tr_job(P.in[28] + (size_t)l * D * DFF, DFF, DFF, D, P.in[27] + l * D, WguT, RmPair{0, 0}, scr, gw, NGW, lane, 1552);
        tr_job(P.in[29] + (size_t)l * D * DFF, DFF, DFF, D, P.in[27] + l * D, WguT, RmPair{1, 0}, scr, gw, NGW, lane, 912);
        tr_job(P.in[30] + (size_t)l * DFF * D, D, D, DFF, (const float*)nullptr, WdT, RmIdent(), scr, gw, NGW, lane, 272);
        tr_job(P.in[13] + (size_t)l * 256 * 512, 512, 512, 256, (const float*)nullptr, WgluT, RmGlu(), scr, gw, NGW, lane, 1680);
        tr_job(P.in[15] + (size_t)l * 2048 * 64, 64, 64, 2048, (const float*)nullptr, W1T, RmIdent(), scr, gw, NGW, lane, 1744);
        tr_job(P.in[18] + (size_t)l * 2048 * 64, 64, 64, 2048, (const float*)nullptr, W1T + 256 * 2048, RmIdent(), scr, gw, NGW, lane, 1808);
        zero_job(WinT + (size_t)NINV * D, (size_t)(NIN - NINV) * D * 2 / 16, gtid, NT);
        zero_job(W1T + 64 * 2048, (size_t)192 * 2048 * 2 / 16, gtid, NT);
        zero_job(W1T + 256 * 2048 + 64 * 2048, (size_t)192 * 2048 * 2 / 16, gtid, NT);
        { bf16_t* WlT = (bf16_t*)(ws + WS_WLRU + l * SZ_WLRU); const float* wa = P.in[22] + (size_t)l * 4 * 64 * 64; const float* wx = P.in[24] + (size_t)l * 4 * 64 * 64;
          for (int i = gtid; i < 512 * 256; i += NT) { const int r = i >> 8, k = i & 255, pn = r >> 8, hf = (r >> 7) & 1, ch = pn * 128 + (r & 127), h = ch >> 6, j = ch & 63;
              float v = 0.f; if ((k >> 6) == h) v = (hf ? wx : wa)[(h * 64 + (k & 63)) * 64 + j]; WlT[i] = (bf16_t)f2bf(v); } }
        { float* TB = (float*)(ws + WS_TAB + l * SZ_TAB);
          for (int i = gtid; i < 128; i += NT) { const int kv = i >> 6, j = i & 63; const float* pe = P.in[kv ? 17 : 14] + (size_t)l * 2048; const float* w1 = P.in[kv ? 18 : 15] + (size_t)l * 2048 * 64;
              float s = 0.f; for (int k = 0; k < 2048; ++k) s += pe[k] * w1[(size_t)k * 64 + j]; TB[TB_BIAS1 + i] = s; }
          for (int i = gtid; i < 256; i += NT) { const float lam = P.in[26][l * 256 + i]; TB[TB_SP + i] = lam > 15.f ? expf(-lam) : log1pf(expf(-lam)); }
          for (int i = gtid; i < 1024; i += NT) { const S5Coef c = s5_coef(P.in[5], P.in[6], P.in[7], l, i >> 6, i & 63); float re, im; s5_apow(c, (float)L5, re, im); TB[TB_A32 + 2 * i] = re; TB[TB_A32 + 2 * i + 1] = im; } }
        { bf16_t* TOP = (bf16_t*)(ws + WS_TOP + l * SZ_TOP); bf16_t* MOP = (bf16_t*)(ws + WS_MOP + l * SZ_MOP);
          const float *bre = P.in[8] + (size_t)l * 16384, *bim = P.in[9] + (size_t)l * 16384, *cre = P.in[10] + (size_t)l * 16384, *cim = P.in[11] + (size_t)l * 16384;
          for (int it = (gw + 64) % NGW; it < 16 * L5; it += NGW) {
              const int g = it >> 5, tau = it & 31, co = lane >> 2, ci0 = 4 * (lane & 3);
              float k4[4] = {0.f, 0.f, 0.f, 0.f};
              for (int p = 0; p < 64; ++p) {
                  const S5Coef c = s5_coef(P.in[5], P.in[6], P.in[7], l, g, p); float are, aim, fre, fim; s5_apow(c, (float)tau, are, aim); s5_f(c, fre, fim);
                  const float cr = cre[(g * 16 + co) * 64 + p], cI = cim[(g * 16 + co) * 64 + p];
                  const float wr_ = cr * are - cI * aim, wi_ = cr * aim + cI * are;
#pragma unroll
                  for (int j = 0; j < 4; ++j) { const float br = bre[(g * 64 + p) * 16 + ci0 + j], bi = bim[(g * 64 + p) * 16 + ci0 + j];
                      const float bbr = fre * br - fim * bi, bbi = fre * bi + fim * br; k4[j] += wr_ * bbr - wi_ * bbi; }
              }
              u32x2v kw; kw.x = pk2(k4[0], k4[1]); kw.y = pk2(k4[2], k4[3]); const u32x2v zw = {0u, 0u};
              bf16_t* Tg = TOP + (size_t)g * NS5 * KS5;
              for (int t = tau; t < L5; ++t) { const int s = t - tau;
                  *(u32x2v*)(Tg + (size_t)(t * 16 + co) * KS5 + s * 16 + ci0) = kw;
                  if (tau) *(u32x2v*)(Tg + (size_t)(s * 16 + co) * KS5 + t * 16 + ci0) = zw; }
          }
          for (int i = gtid; i < 16 * L5 * 16 * 64; i += NT) { const int p = i & 63, co = (i >> 6) & 15, t = (i >> 10) & 31, g = i >> 15;
              const S5Coef c = s5_coef(P.in[5], P.in[6], P.in[7], l, g, p); float are, aim; s5_apow(c, (float)(t + 1), are, aim);
              const float cr = cre[(g * 16 + co) * 64 + p], cI = cim[(g * 16 + co) * 64 + p];
              bf16_t* row = TOP + ((size_t)g * NS5 + t * 16 + co) * KS5 + NS5;
              row[p] = (bf16_t)f2bf(cr * are - cI * aim); row[64 + p] = (bf16_t)f2bf(-(cr * aim + cI * are)); }
          for (int i = gtid; i < 16 * 64 * L5 * 16; i += NT) { const int ci = i & 15, s = (i >> 4) & 31, p = (i >> 9) & 63, g = i >> 15;
              const S5Coef c = s5_coef(P.in[5], P.in[6], P.in[7], l, g, p); float are, aim, fre, fim; s5_apow(c, (float)(L5 - 1 - s), are, aim); s5_f(c, fre, fim);
              const float br = bre[(g * 64 + p) * 16 + ci], bi = bim[(g * 64 + p) * 16 + ci]; const float bbr = fre * br - fim * bi, bbi = fre * bi + fim * br;
              bf16_t* base = MOP + (size_t)g * 256 * NS5 + s * 16 + ci;
              base[(size_t)p * NS5] = (bf16_t)f2bf(are * bbr - aim * bbi); base[(size_t)(64 + p) * NS5] = (bf16_t)f2bf(are * bbi + aim * bbr); }
          for (int g = 0; g < 16; ++g) zero_job(MOP + (size_t)g * 256 * NS5 + 128 * NS5, (size_t)128 * NS5 * 2 / 16, gtid, NT);
        }
    }
    { float* LUT = (float*)(ws + WS_LUT); const float* tab = P.in[1];
      for (int i = gtid; i < 8 * 132; i += NT) { const int hq = i / 132, dd = i - hq * 132; LUT[i] = tab[t5_bucket(dd < 128 ? dd : 128) * 8 + hq] * LOG2E; } }
}

__device__ __forceinline__ void lru_conv_job(const bf16_t* LX, const float* cw, const float* cb, bf16_t* XC, int gtid, int NT) {
    for (int i = gtid; i < M * 32; i += NT) { const int row = i >> 5, c8 = (i & 31) * 8, t = row & 2047;
        float acc[8];
#pragma unroll
        for (int j = 0; j < 8; ++j) acc[j] = cb[c8 + j];
#pragma unroll
        for (int k = 0; k < 4; ++k) { const int dt = k - 3; if (t + dt >= 0) { float xv[8]; unpack8(*(const v4u*)(LX + (size_t)(row + dt) * 256 + c8), xv);
#pragma unroll
            for (int j = 0; j < 8; ++j) acc[j] += cw[k * 256 + c8 + j] * xv[j]; } }
        *(v4u*)(XC + (size_t)row * 256 + c8) = pack8(acc); }
}
__device__ __forceinline__ void s5_scan_job(const float* SLOC, const float* a32, bf16_t* AS5, int gtid, int NT) {
    for (int i = gtid; i < 16 * 16 * 64; i += NT) { const int p = i & 63, gb = i >> 6, g = gb >> 4;
        const float ar = a32[2 * (g * 64 + p)], aI = a32[2 * (g * 64 + p) + 1]; float hr = 0.f, hi = 0.f;
        for (int ch = 0; ch < NCH; ++ch) { const size_t R = (size_t)gb * 64 + ch;
            AS5[R * KS5 + NS5 + p] = (bf16_t)f2bf(hr); AS5[R * KS5 + NS5 + 64 + p] = (bf16_t)f2bf(hi);
            const float sr = SLOC[R * 128 + p], si = SLOC[R * 128 + 64 + p];
            const float nr = ar * hr - aI * hi + sr, ni = ar * hi + aI * hr + si; hr = nr; hi = ni; } }
}
__device__ __forceinline__ void compress2_job(const float* H1C, const float* w2k, const float* w2v, bf16_t* KCC, bf16_t* VCT, int gtid, int NT) {
    for (int i = gtid; i < 2 * 32 * 128 * 64; i += NT) { const int j = i & 63, n = (i >> 6) & 127, bh = (i >> 13) & 31, kv = i >> 18;
        const float* h = H1C + ((size_t)(kv * 32 + bh) * 128 + n) * 64; const float* w2 = kv ? w2v : w2k; float s = 0.f;
        if (n < 127) {
#pragma unroll 8
            for (int k = 0; k < 64; ++k) s += h[k] * w2[k * 64 + j]; }
        if (kv == 0) KCC[((size_t)bh * 128 + n) * 64 + j] = (bf16_t)f2bf(s); else VCT[((size_t)bh * 64 + j) * 128 + n] = (bf16_t)f2bf(s); }
}
__device__ __forceinline__ void lru_scan_job(const float* LA, const float* LB, const bf16_t* LG, bf16_t* MIX, LAS unsigned char* lds, int tid, int bid, int G) {
    LAS float* sP = (LAS float*)lds; LAS float* sH = sP + 512;
    const int k = tid >> 5, c = tid & 31;
    for (int it = bid; it < NB * 8; it += G) { const int b = it >> 3, ch = (it & 7) * 32 + c;
        const size_t base = ((size_t)b * 2048 + k * 128) * 256 + ch;
        float Pp = 1.f, Hh = 0.f;
#pragma unroll 8
        for (int i = 0; i < 128; ++i) { const float a = LA[base + (size_t)i * 256], bt = LB[base + (size_t)i * 256]; Hh = a * Hh + bt; Pp *= a; }
        sP[tid] = Pp; sH[tid] = Hh; __syncthreads();
        float h0 = 0.f; for (int kk = 0; kk < k; ++kk) h0 = sP[kk * 32 + c] * h0 + sH[kk * 32 + c];
        Hh = h0;
#pragma unroll 8
        for (int i = 0; i < 128; ++i) { const float a = LA[base + (size_t)i * 256], bt = LB[base + (size_t)i * 256]; Hh = a * Hh + bt;
            MIX[((size_t)b * 2048 + k * 128 + i) * D + 768 + ch] = (bf16_t)f2bf(Hh * bf2f(LG[base + (size_t)i * 256])); }
        __syncthreads(); }
}
__device__ __forceinline__ void final_norm_job(float* H, const float* RS, const float* gain, int gw, int NGW, int lane) {
    for (int m = gw; m < M; m += NGW) { float s = lane < 16 ? RS[(size_t)m * 16 + lane] : 0.f; s = wave_sum(s); const float rs = rsqrtf(s * (1.0f / 1024.0f) + 1e-6f);
        f32x4* hr = (f32x4*)(H + (size_t)m * D) + lane;
#pragma unroll
        for (int j = 0; j < 4; ++j) { const f32x4 gv = ((const f32x4*)gain)[64 * j + lane]; f32x4 v = hr[64 * j]; v = v * rs; v = v * gv; hr[64 * j] = v; } }
}

__device__ __forceinline__ float wave_max(float v) {
#pragma unroll
    for (int o = 1; o < 64; o <<= 1) v = fmaxf(v, __shfl_xor(v, o));
    return v;
}
struct MbCmp { int t; __device__ __forceinline__ int operator()(int, int n) const { return t - (16 * n + 31); }
               __device__ __forceinline__ int tp(int i) const { return 64 * i; } };
struct MbSel { int t; unsigned ok; unsigned long long selp;
               __device__ __forceinline__ int operator()(int i, int pos) const { return ((ok >> i) & 1u) ? t - pos : -1; }
               __device__ __forceinline__ int tp(int i) const { return 64 * (int)((selp >> (5 * i)) & 31ull); } };
struct MbWin { int t, first; __device__ __forceinline__ int operator()(int, int pos) const { const int d = t - pos; return d < 256 ? d : -1; }
               __device__ __forceinline__ int tp(int i) const { return 64 * (first + i); } };
template <class MB>
__device__ __forceinline__ void nsa_branch(const int ntiles, const bf16_t* Kb, const bf16_t* VTb, const int vpitch, const MB mb, const int hq0,
                                           const LAS float* q_lds, LAS float* P_lds, const LAS float* lut, const int lane, float (&o)[4], float (&inv)[4]) {
    float mx[4] = {-1e30f, -1e30f, -1e30f, -1e30f};
#pragma unroll 1
    for (int i = 0; i < ntiles; ++i) {
        const int pos = mb.tp(i) + lane; const int dist = mb(i, pos);
        const bf16_t* kp = Kb + (size_t)pos * 64; float a0 = 0.f, a1 = 0.f, a2 = 0.f, a3 = 0.f;
#pragma unroll 1
        for (int c = 0; c < 8; ++c) { float kd[8]; unpack8(*(const v4u*)(kp + 8 * c), kd);
#pragma unroll
            for (int j = 0; j < 8; ++j) { const f32x4 q4 = *(const LAS f32x4*)(q_lds + (8 * c + j) * 4); a0 += q4.x * kd[j]; a1 += q4.y * kd[j]; a2 += q4.z * kd[j]; a3 += q4.w * kd[j]; } }
        f32x4 sv = {-1e30f, -1e30f, -1e30f, -1e30f};
        if (dist >= 0) { const int dd = dist < 128 ? dist : 128;
            sv.x = a0 + lut[(hq0 + 0) * 132 + dd]; sv.y = a1 + lut[(hq0 + 1) * 132 + dd]; sv.z = a2 + lut[(hq0 + 2) * 132 + dd]; sv.w = a3 + lut[(hq0 + 3) * 132 + dd];
            mx[0] = fmaxf(mx[0], sv.x); mx[1] = fmaxf(mx[1], sv.y); mx[2] = fmaxf(mx[2], sv.z); mx[3] = fmaxf(mx[3], sv.w); }
        *(LAS f32x4*)(P_lds + (i * 64 + lane) * 4) = sv;
    }
    float sum[4] = {0.f, 0.f, 0.f, 0.f};
#pragma unroll
    for (int g = 0; g < 4; ++g) mx[g] = wave_max(mx[g]);
    asm volatile("s_waitcnt lgkmcnt(0)" ::: "memory");
#pragma unroll 1
    for (int i = 0; i < ntiles; ++i) { f32x4 sv = *(LAS f32x4*)(P_lds + (i * 64 + lane) * 4);
        sv.x = sv.x > -1e29f ? exp2f(sv.x - mx[0]) : 0.f; sv.y = sv.y > -1e29f ? exp2f(sv.y - mx[1]) : 0.f; sv.z = sv.z > -1e29f ? exp2f(sv.z - mx[2]) : 0.f; sv.w = sv.w > -1e29f ? exp2f(sv.w - mx[3]) : 0.f;
        sum[0] += sv.x; sum[1] += sv.y; sum[2] += sv.z; sum[3] += sv.w; *(LAS f32x4*)(P_lds + (i * 64 + lane) * 4) = sv; }
#pragma unroll
    for (int g = 0; g < 4; ++g) { sum[g] = wave_sum(sum[g]); inv[g] = sum[g] > 0.f ? 1.0f / sum[g] : 0.f; }
    asm volatile("s_waitcnt lgkmcnt(0)" ::: "memory");
    const bf16_t* vp = VTb + (size_t)lane * vpitch; float t0 = 0.f, t1 = 0.f, t2 = 0.f, t3 = 0.f;
#pragma unroll 1
    for (int i = 0; i < ntiles; ++i) { const int tp = mb.tp(i);
#pragma unroll 1
        for (int kk = 0; kk < 8; ++kk) { float vv[8]; unpack8(*(const v4u*)(vp + tp + 8 * kk), vv);
#pragma unroll
            for (int j = 0; j < 8; ++j) { const f32x4 p4 = *(const LAS f32x4*)(P_lds + (i * 64 + 8 * kk + j) * 4); t0 += p4.x * vv[j]; t1 += p4.y * vv[j]; t2 += p4.z * vv[j]; t3 += p4.w * vv[j]; } } }
    o[0] += t0 * inv[0]; o[1] += t1 * inv[1]; o[2] += t2 * inv[2]; o[3] += t3 * inv[3];
    asm volatile("s_waitcnt lgkmcnt(0)" ::: "memory");
}
__device__ __forceinline__ void nsa_ref_job(const bf16_t* Q, const bf16_t* KCC, const bf16_t* VCT, const bf16_t* KS, const bf16_t* VST, const bf16_t* KW, const bf16_t* VWT,
                                            const float* GATES, const float* LUT, bf16_t* MIX, LAS unsigned char* lds, int lane, int wave, int gw, int NGW) {
    LAS float* q_lds = (LAS float*)(lds + wave * 16384); LAS float* P_lds = q_lds + 256; LAS float* lut = P_lds + 2048;
    for (int i = lane; i < 8 * 132; i += 64) lut[i] = LUT[i];
    asm volatile("s_waitcnt vmcnt(0) lgkmcnt(0)" ::: "memory");
#pragma unroll 1
    for (int it = gw; it < NB * 2 * SEQ; it += NGW) {
        const int t = it & 2047, bh = it >> 11, b = bh >> 1, h = bh & 1, cur = t >> 6; const size_t m = (size_t)b * 2048 + t;
        { const u32x2v qw = *(const u32x2v*)(Q + m * 512 + h * 256 + lane * 4); const int g = lane >> 4, d0 = (lane & 15) * 4;
          q_lds[(d0 + 0) * 4 + g] = bf2f(qw.x & 0xffffu); q_lds[(d0 + 1) * 4 + g] = bf2f(qw.x >> 16); q_lds[(d0 + 2) * 4 + g] = bf2f(qw.y & 0xffffu); q_lds[(d0 + 3) * 4 + g] = bf2f(qw.y >> 16); }
        const float gate = lane < 12 ? GATES[m * 32 + h * 12 + lane] : 0.f;
        asm volatile("s_waitcnt lgkmcnt(0)" ::: "memory");
        float oc[4] = {0.f, 0.f, 0.f, 0.f}, os[4] = {0.f, 0.f, 0.f, 0.f}, ow[4] = {0.f, 0.f, 0.f, 0.f}, inv[4];
        nsa_branch(2, KCC + (size_t)bh * 128 * 64, VCT + (size_t)bh * 64 * 128, 128, MbCmp{t}, h * 4, q_lds, P_lds, lut, lane, oc, inv);
        float sc = -3e38f;
        if (lane < 32) { float imp = 0.f;
#pragma unroll
            for (int k = -1; k <= 3; ++k) { const int n = 4 * lane + k; if (n >= 0) { const f32x4 p4 = *(const LAS f32x4*)(P_lds + n * 4); imp += (p4.x * inv[0] + p4.y * inv[1]) + (p4.z * inv[2] + p4.w * inv[3]); } }
            const bool avail = 64 * lane <= t, forced = (lane == 0) | (lane == cur) | (lane == cur - 1);
            sc = avail ? imp + (forced ? 1e4f : 0.f) : -1e9f; }
        unsigned long long selp = 0ull; unsigned okm = 0u;
#pragma unroll
        for (int r = 0; r < 8; ++r) { const float mv = wave_max(sc); const unsigned long long bal = __ballot(sc == mv); const int idx = __builtin_amdgcn_readfirstlane(__ffsll((long long)bal) - 1);
            selp |= (unsigned long long)(idx & 31) << (5 * r); if (mv > -5e8f) okm |= 1u << r; if (lane == idx) sc = -3e38f; }
        asm volatile("s_waitcnt lgkmcnt(0)" ::: "memory");
        nsa_branch(8, KS + (size_t)bh * 2048 * 64, VST + (size_t)bh * 64 * 2048, 2048, MbSel{t, okm, selp}, h * 4, q_lds, P_lds, lut, lane, os, inv);
        { const int first = (t > 255 ? t - 255 : 0) >> 6;
          nsa_branch(cur - first + 1, KW + (size_t)bh * 2048 * 64, VWT + (size_t)bh * 64 * 2048, 2048, MbWin{t, first}, h * 4, q_lds, P_lds, lut, lane, ow, inv); }
#pragma unroll
        for (int g = 0; g < 4; ++g) { const float r = __shfl(gate, 3 * g) * oc[g] + __shfl(gate, 3 * g + 1) * os[g] + __shfl(gate, 3 * g + 2) * ow[g];
            MIX[m * D + 256 + (h * 4 + g) * 64 + lane] = (bf16_t)f2bf(r); }
    }
}

#ifndef EN_MASK
#define EN_MASK 0xffff
#endif
#define EN(b) ((EN_MASK >> (b)) & 1)
#ifndef PG8_SP2_
#define PG8_SP2_ false
#endif
constexpr int N_PHASES = 18;
__global__ void __launch_bounds__(NTHREADS, 2) mk_fwd(Args args) {
    extern __shared__ __attribute__((aligned(16))) unsigned char lds_raw[];
    LAS unsigned char* lds = (LAS unsigned char*)lds_raw;
    volatile LAS unsigned* MISC = (volatile LAS unsigned*)(lds + MISC_OFF);
    const int wave = __builtin_amdgcn_readfirstlane((int)threadIdx.x >> 6), bid = blockIdx.x, G = gridDim.x;
#define tid (wave * 64 + pg8::lane_id())
#define gw (bid * NWAVES + wave)
#define NGW (G * NWAVES)
#define NT (G * NTHREADS)
    const int lo = args.ph_lo, hi = args.ph_hi;
    unsigned char* ws = args.ws;
    for (int u = tid; u < (LDS_BYTES - RING_BYTES) / 4; u += NTHREADS) ((LAS unsigned*)(lds + RING_BYTES))[u] = 0u;
    __syncthreads();
    XcdBarrier bar; bar.bar = (unsigned*)(ws + WS_CTL) + CW_BAR; bar.x = 0; bar.st = nullptr;
    if (hi - lo > 1) bar = xcd_barrier_post((unsigned*)(ws + WS_CTL) + CW_BAR, MISC + 8);
#define PH(k) (lo <= (k) && (k) < hi)
#define SEAM(k) do { if (PH(k) && PH((k) + 1)) xcd_barrier(bar); } while (0)
    typedef const float* kptr_t; typedef const __attribute__((address_space(4))) kptr_t* kargs_t;
#define OPQ_WS() unsigned char* w = ws; asm volatile("" : "+s"(w))
#define OPQ_IN() kargs_t inp = (kargs_t)__builtin_amdgcn_kernarg_segment_ptr(); asm volatile("" : "+s"(inp))
#define WP(T, off) ((T*)(w + (off)))
#define OPQ_TID() int tid_p = tid; asm volatile("" : "+v"(tid_p)); const int lane_p = tid_p & 63, gtid_p = bid * NTHREADS + tid_p; (void)lane_p; (void)gtid_p

    if (PH(0) && EN(0)) { OPQ_TID(); p0_prologue(args, lds, tid_p, lane_p, wave, bid, G); VM_WAIT(); __syncthreads(); }
    SEAM(0);
#pragma unroll 1
    for (int l = 0; l < NLAYER; ++l) {
        const int pb = 1 + 8 * l;
        if (PH(pb + 0) && EN(1)) {
            OPQ_WS();
            pg8::Gemm g{WP(bf16_t, WS_XN), WP(bf16_t, WS_WIN + l * SZ_WIN), D, D}; pg8::StaticOrder S; S.init(M, NIN, G, bid);
            EpiInProj E{w};
            pg8::gemm_phase<EpiInProj, pg8::StaticOrder, true, PG8_SP2_>(lds, g, S, E, wave);
        }
        SEAM(pb + 0);
        if (PH(pb + 1)) {
            if (EN(2)) { OPQ_WS(); pg8::Gemm g{WP(bf16_t, WS_KC), WP(bf16_t, WS_W1 + l * SZ_W1), 1024, 2048}; pg8::GroupOrder S; S.init(2, 16, 1, 1, G, bid, 0);
              EpiCompress E{WP(float, WS_TAB + l * SZ_TAB) + TB_BIAS1, WP(float, WS_H1C)}; pg8::gemm_phase<EpiCompress, pg8::GroupOrder, true, PG8_SP2_>(lds, g, S, E, wave); }
            if (EN(3)) { OPQ_WS(); pg8::Gemm g{WP(bf16_t, WS_AS5), WP(bf16_t, WS_MOP + l * SZ_MOP), KS5, NS5}; pg8::GroupOrder S; S.init(16, 4, 1, 1, G, bid, 32);
              EpiS5State E{WP(float, WS_SLOC)}; pg8::gemm_phase<EpiS5State, pg8::GroupOrder, true, PG8_SP2_>(lds, g, S, E, wave); }
            if (EN(4)) { OPQ_WS(); OPQ_IN(); OPQ_TID(); lru_conv_job(WP(bf16_t, WS_LX), inp[20] + l * 4 * 256, inp[21] + l * 256, WP(bf16_t, WS_XC), gtid_p, NT); }
        }
        SEAM(pb + 1);
        if (PH(pb + 2)) {
            if (EN(5)) { OPQ_WS(); OPQ_IN(); pg8::Gemm g{WP(bf16_t, WS_XC), WP(bf16_t, WS_WLRU + l * SZ_WLRU), 256, 256}; pg8::StaticOrder S; S.init(M, 512, G, bid);
              EpiLruGates E{WP(bf16_t, WS_XC), inp[23] + l * 256, inp[25] + l * 256, WP(float, WS_TAB + l * SZ_TAB) + TB_SP, WP(float, WS_LA), WP(float, WS_LB)}; pg8::gemm_phase<EpiLruGates, pg8::StaticOrder, true, PG8_SP2_>(lds, g, S, E, wave); }
            if (EN(6)) { OPQ_WS(); OPQ_IN(); OPQ_TID(); compress2_job(WP(float, WS_H1C), inp[16] + l * 4096, inp[19] + l * 4096, WP(bf16_t, WS_KCC), WP(bf16_t, WS_VCT), gtid_p, NT); }
            if (EN(7)) { OPQ_WS(); OPQ_TID(); s5_scan_job(WP(float, WS_SLOC), WP(float, WS_TAB + l * SZ_TAB) + TB_A32, WP(bf16_t, WS_AS5), gtid_p, NT); }
        }
        SEAM(pb + 2);
        if (PH(pb + 3)) {
            if (EN(8)) { OPQ_WS(); OPQ_IN(); pg8::Gemm g{WP(bf16_t, WS_AS5), WP(bf16_t, WS_TOP + l * SZ_TOP), KS5, KS5}; pg8::GroupOrder S; S.init(16, 4, 2, 2, G, bid, 0);
              EpiS5Main E{WP(bf16_t, WS_AS5), inp[12] + l * 256, WP(bf16_t, WS_YS)}; pg8::gemm_phase<EpiS5Main, pg8::GroupOrder, true, PG8_SP2_>(lds, g, S, E, wave); }
            __syncthreads();
            if (EN(9)) { OPQ_WS(); OPQ_TID(); lru_scan_job(WP(float, WS_LA), WP(float, WS_LB), WP(bf16_t, WS_LG), WP(bf16_t, WS_MIX), lds, tid_p, (bid + G - 128 % G) % G, G); }
            __syncthreads();
            if (EN(10)) { OPQ_WS(); OPQ_TID(); nsa_ref_job(WP(bf16_t, WS_Q), WP(bf16_t, WS_KCC), WP(bf16_t, WS_VCT), WP(bf16_t, WS_KS), WP(bf16_t, WS_VST), WP(bf16_t, WS_KW), WP(bf16_t, WS_VWT), WP(float, WS_GATES), WP(float, WS_LUT), WP(bf16_t, WS_MIX), lds, lane_p, wave, gw, NGW); }
        }
        SEAM(pb + 3);
        if (PH(pb + 4) && EN(11)) {
            OPQ_WS(); pg8::Gemm g{WP(bf16_t, WS_YS), WP(bf16_t, WS_WGLU + l * SZ_WGLU), 256, 256}; pg8::StaticOrder S; S.init(M, 512, G, bid);
            EpiGlu E{WP(bf16_t, WS_MIX)}; pg8::gemm_phase<EpiGlu, pg8::StaticOrder, true, PG8_SP2_>(lds, g, S, E, wave);
        }
        SEAM(pb + 4);
        if (PH(pb + 5) && EN(12)) {
            OPQ_WS(); OPQ_IN(); float* Hres = args.out; asm volatile("" : "+s"(Hres));
            pg8::Gemm g{WP(bf16_t, WS_MIX), WP(bf16_t, WS_WOUT + l * SZ_WOUT), D, D}; pg8::StaticOrder S; S.init(M, D, G, bid);
            EpiResid E{l == 0 ? inp[0] : (const float*)Hres, Hres, WP(bf16_t, WS_XN), WP(float, WS_RS)}; pg8::gemm_phase<EpiResid, pg8::StaticOrder, true, PG8_SP2_>(lds, g, S, E, wave);
        }
        SEAM(pb + 5);
        if (PH(pb + 6) && EN(13)) {
            OPQ_WS(); pg8::Gemm g{WP(bf16_t, WS_XN), WP(bf16_t, WS_WGU + l * SZ_WGU), D, D}; pg8::StaticOrder S; S.init(M, NGU, G, bid);
            EpiGateUp E{WP(float, WS_RS), WP(bf16_t, WS_HMID)}; pg8::gemm_phase<EpiGateUp, pg8::StaticOrder, true, PG8_SP2_>(lds, g, S, E, wave);
        }
        SEAM(pb + 6);
        if (PH(pb + 7) && EN(14)) {
            OPQ_WS(); float* Hres = args.out; asm volatile("" : "+s"(Hres));
            pg8::Gemm g{WP(bf16_t, WS_HMID), WP(bf16_t, WS_WD + l * SZ_WD), DFF, DFF}; pg8::StaticOrder S; S.init(M, D, G, bid);
            EpiResid E{Hres, Hres, WP(bf16_t, WS_XN), WP(float, WS_RS)}; pg8::gemm_phase<EpiResid, pg8::StaticOrder, true, PG8_SP2_>(lds, g, S, E, wave);
        }
        SEAM(pb + 7);
    }
    if (PH(17) && EN(15)) { OPQ_WS(); OPQ_IN(); float* Hres = args.out; asm volatile("" : "+s"(Hres)); OPQ_TID(); final_norm_job(Hres, WP(float, WS_RS), inp[31], gw, NGW, lane_p); }
#undef PH
#undef tid
#undef gw
#undef NGW
#undef NT
#undef SEAM
}

#ifndef MK_N_LAUNCHES
#define MK_N_LAUNCHES 18
#endif
extern "C" void kernel_launch(void* const* d_in, const int* in_sizes, int n_in, void* d_out, int out_size, void* d_ws, size_t ws_size, hipStream_t stream) {
    static int grid = 0;
    if (grid == 0) {
        if (n_in != 32 || in_sizes[0] != M * D || out_size != M * D || ws_size < WS_END) { fprintf(stderr, "kernel_launch: shape/workspace mismatch (n_in %d, in0 %d, out %d, ws %zu, need %zu)\n", n_in, n_in > 0 ? in_sizes[0] : -1, out_size, ws_size, (size_t)WS_END); grid = -1; return; }
        int dev = 0, cus = 0, per_cu = 0;
        if (hipGetDevice(&dev) != hipSuccess || hipDeviceGetAttribute(&cus, hipDeviceAttributeMultiprocessorCount, dev) != hipSuccess) { grid = -1; return; }
        if (hipFuncSetAttribute((const void*)mk_fwd, hipFuncAttributeMaxDynamicSharedMemorySize, LDS_BYTES) != hipSuccess) { fprintf(stderr, "kernel_launch: hipFuncSetAttribute failed\n"); grid = -1; return; }
        if (hipOccupancyMaxActiveBlocksPerMultiprocessor(&per_cu, (const void*)mk_fwd, NTHREADS, LDS_BYTES) != hipSuccess || per_cu < 1) { fprintf(stderr, "kernel_launch: occupancy query says %d blocks per CU\n", per_cu); (void)hipGetLastError(); grid = -1; return; }
        grid = cus;
    }
    if (grid < 0) return;
    (void)hipMemsetAsync((char*)d_ws + WS_CTL, 0, CTL_ZERO_BYTES, stream);
    Args a{};
    for (int i = 0; i < 32; ++i) a.in[i] = (const float*)d_in[i];
    a.out = (float*)d_out; a.ws = (unsigned char*)d_ws;
    if (MK_N_LAUNCHES == 1) { a.ph_lo = 0; a.ph_hi = N_PHASES; hipLaunchKernelGGL(mk_fwd, dim3(grid), dim3(NTHREADS), LDS_BYTES, stream, a); }
    else for (int p = 0; p < N_PHASES; ++p) { a.ph_lo = p; a.ph_hi = p + 1; hipLaunchKernelGGL(mk_fwd, dim3(grid), dim3(NTHREADS), LDS_BYTES, stream, a); }
}
```

```cpp
#include <hip/hip_runtime.h>
#include <cstdio>
#include <cstdint>
namespace pg8 {
#define PG8_LAS __attribute__((address_space(3)))
typedef unsigned short bf16_t;
typedef short bf16x8 __attribute__((ext_vector_type(8)));
typedef float f32x4 __attribute__((ext_vector_type(4)));
typedef unsigned u32x4 __attribute__((ext_vector_type(4)));
constexpr int BM = 256, BK = 64, HALF = 128, HTB = HALF * BK * 2  , STAGE_BYTES = 8 * HTB, NXCD = 8, WGM = 8;

__host__ __device__ __forceinline__ int lds_byte(int r, int c) { const int st = (r >> 4) * 2 + (c >> 5), rr = r & 15, cc = c & 31, ob = rr * 64 + cc * 2; return st * 1024 + (ob ^ (((ob >> 9) & 1) << 5)); }
__host__ __device__ __forceinline__ void stage_rc(int b, int& R, int& C) { const int st = b / 1024, sb = b % 1024, swz = sb ^ (((sb >> 9) & 1) << 5); R = (st >> 1) * 16 + swz / 64; C = (st & 1) * 32 + (swz % 64) / 2; }
__host__ __device__ __forceinline__ int perm32(int rho) { const int n = rho >> 4, i = rho & 15; return 8 * (i >> 2) + 4 * n + (i & 3); }


struct Unit { int pm, pn; };
struct Gemm { const bf16_t* A; const bf16_t* Bt; int lda, K; };

struct StaticOrder {
    int nM, nN, nwg, G, c;
    __host__ __device__ __forceinline__ void init(int M, int N, int G_, int c_) { nM = M / BM; nN = N / BM; nwg = nM * nN; G = G_; c = c_; }
    __host__ __device__ __forceinline__ bool next(int i, Unit& u) const {
        const long L = (long)i * G + c; if (L >= nwg) return false;
        int wgid = (int)L; { const int q = nwg / NXCD, r = nwg % NXCD, xcd = wgid % NXCD, off = wgid / NXCD; wgid = (xcd < r ? xcd * (q + 1) : r * (q + 1) + (xcd - r) * q) + off; }
        const int nig = WGM * nN, gid = wgid / nig, fm = gid * WGM, gsz = (nM - fm) < WGM ? (nM - fm) : WGM;
        u.pm = fm + ((wgid % nig) % gsz); u.pn = (wgid % nig) / gsz; return true;
    }
    __device__ __forceinline__ void a_ready(const Unit&) const {}
    __device__ __forceinline__ void done(const Unit&) const {}
};
struct GroupOrder {
    int mt, nt, ntb, total, G, c;
    __host__ __device__ __forceinline__ void init(int ng, int mt_, int nt_, int ntb_, int G_, int blk, int off) { mt = mt_; nt = nt_; ntb = ntb_; total = ng * mt_ * nt_; G = G_; c = (blk + G_ - (off % G_)) % G_; }
    __host__ __device__ __forceinline__ bool next(int i, Unit& u) const {
        const long L = (long)i * G + c; if (L >= total) return false;
        const int per = mt * nt, grp = (int)L / per, r = (int)L % per; u.pm = grp * mt + r / nt; u.pn = grp * ntb + r % nt; return true;
    }
    __device__ __forceinline__ void a_ready(const Unit&) const {}
    __device__ __forceinline__ void done(const Unit&) const {}
};
typedef float f32x2_cv __attribute__((ext_vector_type(2))); typedef __bf16 bf16x2_cv __attribute__((ext_vector_type(2)));
__device__ __forceinline__ unsigned cvt_pk_bf16(float lo, float hi) { const f32x2_cv v = {lo, hi}; const bf16x2_cv b = __builtin_convertvector(v, bf16x2_cv); return __builtin_bit_cast(unsigned, b); }
__device__ __forceinline__ int lane_id() { int l; asm volatile("v_mbcnt_lo_u32_b32 %0, -1, 0\n\tv_mbcnt_hi_u32_b32 %0, -1, %0" : "=v"(l)); return l; }
template <class Epi, class Sched, bool ALIGN_EPI = false, bool SP2 = false>
__device__ __forceinline__ void gemm_phase(PG8_LAS unsigned char* lds, const Gemm g, const Sched& S, const Epi& E, const int wave_in) {
    int tid_o = wave_in * 64 + lane_id(); asm volatile("" : "+v"(tid_o));
    const int tid = tid_o, wid = __builtin_amdgcn_readfirstlane(tid >> 6), lane = tid & 63, wr = wid >> 2, wc = wid & 3, fr = lane & 15, fq = lane >> 4;
    const int K = g.K, lda = g.lda, nt = K / BK;
    unsigned voffA[2], voffB[2];
#pragma unroll
    for (int i = 0; i < 2; ++i) { int R, C; stage_rc(tid * 16 + i * 8192, R, C); const int Rb = Epi::PERM ? ((R & ~31) + perm32(R & 31)) : R;
        voffA[i] = (unsigned)(R * lda + C) * 2u; voffB[i] = (unsigned)(Rb * K + C) * 2u; }
    const size_t kstep = (size_t)(BK * 2);
    const size_t hstep = (size_t)HALF * K * 2;
    const size_t tstep = 2 * hstep; const size_t hstepA = (size_t)HALF * lda * 2, tstepA = 2 * hstepA;
    const unsigned ldsw = (unsigned)wid * 1024u;
    const int aoff = lds_byte(wr * 64 + fr, fq * 8), boff = lds_byte(wc * 32 + fr, fq * 8);
#define PG8_SA(b, h) (((b) * 2 + (h)) * HTB)
#define PG8_SB(b, h) ((4 + (b) * 2 + (h)) * HTB)
#define PG8_STAGE(bufoff, gbase, voff) do { _Pragma("unroll") for (int _i = 0; _i < 2; ++_i) \
        __builtin_amdgcn_global_load_lds((const unsigned*)((const char*)(gbase) + (voff)[_i]), (PG8_LAS unsigned*)(lds + (bufoff) + ldsw + _i * 8192), 16, 0, 0); } while (0)
#define PG8_LDA(dst, b, h) do { _Pragma("unroll") for (int m = 0; m < 4; ++m) _Pragma("unroll") for (int k = 0; k < 2; ++k) dst[m][k] = *(const PG8_LAS bf16x8*)(lds + PG8_SA(b, h) + aoff + m * 2048 + k * 1024); } while (0)
#define PG8_LDB(dst, b, h) do { _Pragma("unroll") for (int n = 0; n < 2; ++n) _Pragma("unroll") for (int k = 0; k < 2; ++k) dst[n][k] = *(const PG8_LAS bf16x8*)(lds + PG8_SB(b, h) + boff + n * 2048 + k * 1024); } while (0)
#define PG8_MMA(ai, bj, At, Bt) do { __builtin_amdgcn_s_setprio(1); _Pragma("unroll") for (int m = 0; m < 4; ++m) _Pragma("unroll") for (int n = 0; n < 2; ++n) _Pragma("unroll") for (int k = 0; k < 2; ++k) \
        acc[ai][bj][m][n] = __builtin_amdgcn_mfma_f32_16x16x32_bf16(Bt[n][k], At[m][k], acc[ai][bj][m][n], 0, 0, 0); __builtin_amdgcn_s_setprio(0); } while (0)
#define PG8_WAIT_V(n) asm volatile("s_waitcnt vmcnt(" #n ")" ::: "memory")
#define PG8_WAIT_L(n) asm volatile("s_waitcnt lgkmcnt(" #n ")" ::: "memory")
#define PG8_BAR __builtin_amdgcn_s_barrier()
#define PG8_SCHED __builtin_amdgcn_sched_barrier(0)
    Unit cur, nxt; int ui = 0;
    if (!S.next(0, cur)) return;
    f32x4 acc[2][2][4][2];
#pragma unroll
    for (int a = 0; a < 2; ++a)
#pragma unroll
        for (int b = 0; b < 2; ++b)
#pragma unroll
            for (int m = 0; m < 4; ++m)
#pragma unroll
                for (int n = 0; n < 2; ++n) acc[a][b][m][n] = (f32x4){0.f, 0.f, 0.f, 0.f};
    bf16x8 At[4][2], B0[2][2], B1[2][2];
    const char* cA = (const char*)g.A + (size_t)cur.pm * tstepA; const char* cB = (const char*)g.Bt + (size_t)cur.pn * tstep;
    S.a_ready(cur);
    if constexpr (SP2) {
        PG8_STAGE(PG8_SB(0, 0), cB, voffB); PG8_STAGE(PG8_SB(0, 1), cB + hstep, voffB); PG8_STAGE(PG8_SA(0, 0), cA, voffA); PG8_STAGE(PG8_SA(0, 1), cA + hstepA, voffA);
        if (wr == 1) PG8_BAR;
        PG8_WAIT_V(2); PG8_BAR;
        PG8_STAGE(PG8_SB(1, 0), cB + kstep, voffB); PG8_STAGE(PG8_SA(1, 0), cA + kstep, voffA); PG8_STAGE(PG8_SB(1, 1), cB + hstep + kstep, voffB);
        PG8_WAIT_V(6); PG8_BAR;
    } else {
        PG8_STAGE(PG8_SB(0, 0), cB, voffB); PG8_STAGE(PG8_SA(0, 0), cA, voffA); PG8_STAGE(PG8_SB(0, 1), cB + hstep, voffB); PG8_STAGE(PG8_SA(0, 1), cA + hstepA, voffA);
        if (wr == 1) PG8_BAR;
        PG8_WAIT_V(4); PG8_BAR;
        PG8_STAGE(PG8_SB(1, 0), cB + kstep, voffB); PG8_STAGE(PG8_SA(1, 0), cA + kstep, voffA); PG8_STAGE(PG8_SB(1, 1), cB + hstep + kstep, voffB);
        PG8_WAIT_V(6); PG8_BAR;
    }
    for (;;) {
        const bool has_next = S.next(ui + 1, nxt);
        const char* nA = has_next ? (const char*)g.A + (size_t)nxt.pm * tstepA : cA; const char* nB = has_next ? (const char*)g.Bt + (size_t)nxt.pn * tstep : cB;
        _Pragma("unroll 1") for (int t = 0; t < nt; t += 2) {
            const bool last = (t == nt - 2);
            const char* a1 = cA + (size_t)(t + 1) * kstep;
            const char* a2 = last ? nA : cA + (size_t)(t + 2) * kstep; const char* b2 = last ? nB : cB + (size_t)(t + 2) * kstep;
            const char* a3 = a2 + kstep; const char* b3 = b2 + kstep;
            if (last && has_next) S.a_ready(nxt);
            if constexpr (SP2) {
            PG8_LDB(B0, 0, 0); PG8_LDB(B1, 0, 1); PG8_SCHED; PG8_LDA(At, 0, 0); PG8_STAGE(PG8_SA(1, 1), a1 + hstepA, voffA);
            PG8_WAIT_V(8); PG8_WAIT_L(0); PG8_BAR; PG8_MMA(0, 0, At, B0); PG8_MMA(0, 1, At, B1); PG8_BAR; PG8_SCHED;
            PG8_LDA(At, 0, 1); PG8_STAGE(PG8_SB(0, 0), b2, voffB); PG8_STAGE(PG8_SB(0, 1), b2 + hstep, voffB); PG8_STAGE(PG8_SA(0, 0), a2, voffA);
            PG8_WAIT_V(8); PG8_WAIT_L(0); PG8_BAR; PG8_MMA(1, 0, At, B0); PG8_MMA(1, 1, At, B1); PG8_BAR; PG8_SCHED;
            PG8_LDB(B0, 1, 0); PG8_LDB(B1, 1, 1); PG8_SCHED; PG8_LDA(At, 1, 0); PG8_STAGE(PG8_SA(0, 1), a2 + hstepA, voffA);
            PG8_WAIT_V(8); PG8_WAIT_L(0); PG8_BAR; PG8_MMA(0, 0, At, B0); PG8_MMA(0, 1, At, B1); PG8_BAR; PG8_SCHED;
            PG8_LDA(At, 1, 1); PG8_STAGE(PG8_SB(1, 0), b3, voffB); PG8_STAGE(PG8_SB(1, 1), b3 + hstep, voffB); PG8_STAGE(PG8_SA(1, 0), a3, voffA);
            PG8_WAIT_V(8); PG8_WAIT_L(0); PG8_BAR; PG8_MMA(1, 0, At, B0); PG8_MMA(1, 1, At, B1); PG8_BAR; PG8_SCHED;
            } else {
            PG8_LDB(B0, 0, 0); PG8_SCHED; PG8_LDA(At, 0, 0); PG8_STAGE(PG8_SA(1, 1), a1 + hstepA, voffA);
            PG8_WAIT_L(8); PG8_BAR; PG8_WAIT_L(0); PG8_MMA(0, 0, At, B0); PG8_BAR; PG8_SCHED;
            PG8_LDB(B1, 0, 1); PG8_STAGE(PG8_SB(0, 0), b2, voffB);
            PG8_BAR; PG8_WAIT_L(0); PG8_MMA(0, 1, At, B1); PG8_BAR;
            PG8_LDA(At, 0, 1); PG8_STAGE(PG8_SA(0, 0), a2, voffA);
            PG8_BAR; PG8_WAIT_L(0); PG8_MMA(1, 0, At, B0); PG8_BAR; PG8_SCHED;
            PG8_STAGE(PG8_SB(0, 1), b2 + hstep, voffB);
            PG8_WAIT_V(6); PG8_BAR; PG8_MMA(1, 1, At, B1); PG8_BAR;
            PG8_LDB(B0, 1, 0); PG8_SCHED; PG8_LDA(At, 1, 0); PG8_STAGE(PG8_SA(0, 1), a2 + hstepA, voffA);
            PG8_WAIT_L(8); PG8_BAR; PG8_WAIT_L(0); PG8_MMA(0, 0, At, B0); PG8_BAR; PG8_SCHED;
            PG8_LDB(B1, 1, 1); PG8_STAGE(PG8_SB(1, 0), b3, voffB);
            PG8_BAR; PG8_WAIT_L(0); PG8_MMA(0, 1, At, B1); PG8_BAR;
            PG8_LDA(At, 1, 1); PG8_STAGE(PG8_SA(1, 0), a3, voffA);
            PG8_BAR; PG8_WAIT_L(0); PG8_MMA(1, 0, At, B0); PG8_BAR; PG8_SCHED;
            PG8_STAGE(PG8_SB(1, 1), b3 + hstep, voffB);
            PG8_WAIT_V(6); PG8_BAR; PG8_MMA(1, 1, At, B1); PG8_BAR;
            }
        }
        if constexpr (ALIGN_EPI) { if (wr == 0) PG8_BAR; }
        if constexpr (!Epi::AFTER_DRAIN) { { const int l2_ = lane_id(); E(acc, cur, wr, wc, l2_ & 15, l2_ >> 4); } S.done(cur); }
        if (!has_next) break;
#pragma unroll
        for (int a = 0; a < 2; ++a)
#pragma unroll
            for (int b = 0; b < 2; ++b)
#pragma unroll
                for (int m = 0; m < 4; ++m)
#pragma unroll
                    for (int n = 0; n < 2; ++n) acc[a][b][m][n] = (f32x4){0.f, 0.f, 0.f, 0.f};
        cur = nxt; cA = nA; cB = nB; ++ui;
        if constexpr (ALIGN_EPI) { if (wr == 1) PG8_BAR; }
    }
    PG8_WAIT_V(0);
    if constexpr (!ALIGN_EPI) { if (wr == 0) PG8_BAR; }
    PG8_BAR;
    if constexpr (Epi::AFTER_DRAIN) { E.fused(acc, cur, wr, wc, fr, fq, lds, wid, lane); S.done(cur); }
#undef PG8_SA
#undef PG8_SB
#undef PG8_STAGE
#undef PG8_LDA
#undef PG8_LDB
#undef PG8_MMA
#undef PG8_WAIT_V
#undef PG8_WAIT_L
#undef PG8_BAR
#undef PG8_SCHED
}
}
#define GAS __attribute__((address_space(1)))
#define LAS __attribute__((address_space(3)))
typedef unsigned short bf16;
typedef unsigned v4u __attribute__((ext_vector_type(4)));
typedef float f32x4 __attribute__((ext_vector_type(4)));
typedef short bf16x8 __attribute__((ext_vector_type(8)));
typedef GAS unsigned gu32;
typedef GAS unsigned long long gu64;
#define RLX_AGENT __ATOMIC_RELAXED, __HIP_MEMORY_SCOPE_AGENT
#define LDS_WAIT() asm volatile("s_waitcnt lgkmcnt(0)" ::: "memory")
#define VM_WAIT() asm volatile("s_waitcnt vmcnt(0)" ::: "memory")
__device__ __forceinline__ unsigned long long rt() { return __builtin_amdgcn_s_memrealtime(); }
__device__ __forceinline__ unsigned f2bf(float f) { unsigned u = __builtin_bit_cast(unsigned, f); return (u + 0x7fffu + ((u >> 16) & 1u)) >> 16; }
__device__ __forceinline__ unsigned pk2(float lo, float hi) { return f2bf(lo) | (f2bf(hi) << 16); }

#define XB_TMO      128
#define XB_XCNT(j)  (256  + 64 * (j))
#define XB_XSUB(j)  (1280 + 64 * (j))
#define XB_XGEN(j)  (2304 + 64 * (j))
#define XB_TOP      3328
#define XB_TOPGEN   3392
#define XCD_BAR_WORDS 3456
#define XB_SPIN_CAP (1u << 18)

__device__ __forceinline__ unsigned xb_ld(unsigned* p)              { return __hip_atomic_load(p, __ATOMIC_RELAXED, __HIP_MEMORY_SCOPE_AGENT); }
__device__ __forceinline__ unsigned xb_add(unsigned* p, unsigned v) { return __hip_atomic_fetch_add(p, v, __ATOMIC_RELAXED, __HIP_MEMORY_SCOPE_AGENT); }
__device__ __forceinline__ unsigned xb_xcc_id() { return (unsigned)__builtin_amdgcn_s_getreg((3 << 11) | 20) & 0xFu; }
#define XB_SPIN(cond, bar) do { unsigned _sp = 0; while (cond) { __builtin_amdgcn_s_sleep(1); \
    if ((++_sp & 255u) == 0u) { if (xb_ld(&(bar)[XB_TMO])) break; if (_sp > XB_SPIN_CAP) { atomicAdd(&(bar)[XB_TMO], 1u); break; } } } } while (0)

struct XcdBarrier {
    unsigned* bar; unsigned x;
    volatile LAS unsigned* st;
};

__device__ __forceinline__ XcdBarrier xcd_barrier_post(unsigned* bar, volatile LAS unsigned* st) {
    XcdBarrier b; b.bar = bar; b.x = xb_xcc_id(); b.st = st;
    if (threadIdx.x == 0) (void)xb_add(&bar[XB_XCNT(b.x)], 1u);
    return b;
}
__device__ __forceinline__ void xcd_barrier_complete(unsigned* bar, unsigned x, unsigned& nloc, unsigned& nx) {
    const unsigned G = gridDim.x * gridDim.y * gridDim.z;
    unsigned sum, cnt, mine, sp = 0u;
    for (;;) {
        sum = 0u; cnt = 0u; mine = 0u;
#pragma unroll
        for (unsigned j = 0; j < 16; ++j) { const unsigned c = xb_ld(&bar[XB_XCNT(j)]); sum += c; cnt += (c > 0u) ? 1u : 0u; mine = (j == x) ? c : mine; }
        if (sum == G) break;
        __builtin_amdgcn_s_sleep(1);
        if ((++sp & 255u) == 0u) { if (xb_ld(&bar[XB_TMO])) break; if (sp > XB_SPIN_CAP) { atomicAdd(&bar[XB_TMO], 1u); break; } }
    }
    nloc = mine > 0u ? mine : 1u; nx = cnt > 0u ? cnt : 1u;
}

__device__ __forceinline__ void xcd_barrier(const XcdBarrier& b) {
    asm volatile("s_waitcnt vmcnt(0)" ::: "memory");
    __syncthreads();
    if (threadIdx.x == 0) {
        unsigned* bar = b.bar;
        __builtin_amdgcn_s_waitcnt(0);
        unsigned nloc = b.st[0], nx = b.st[1];
        if (nloc == 0u) { xcd_barrier_complete(bar, b.x, nloc, nx); b.st[0] = nloc; b.st[1] = nx; }
        const unsigned old = xb_add(&bar[XB_XSUB(b.x)], 1u);
        const unsigned gen = old / nloc;
        if (old + 1u == (gen + 1u) * nloc) {
            __builtin_amdgcn_fence(__ATOMIC_RELEASE, "agent");
            asm volatile("s_waitcnt vmcnt(0)" ::: "memory");
            const unsigned og = xb_add(&bar[XB_TOP], 1u);
            const unsigned tg = og / nx;
            if (og + 1u == (tg + 1u) * nx) xb_add(&bar[XB_TOPGEN], 1u);
            else XB_SPIN(xb_ld(&bar[XB_TOPGEN]) == tg, bar);
            __builtin_amdgcn_fence(__ATOMIC_ACQUIRE, "agent");
            xb_add(&bar[XB_XGEN(b.x)], 1u);
            asm volatile("s_waitcnt vmcnt(0)" ::: "memory");
        } else {
            XB_SPIN(xb_ld(&bar[XB_XGEN(b.x)]) == gen, bar);
            __builtin_amdgcn_fence(__ATOMIC_ACQUIRE, "agent");
            asm volatile("s_waitcnt vmcnt(0)" ::: "memory");
        }
    }
    __syncthreads();
}

using pg8::bf16_t; using pg8::Unit; using pg8::BM; using pg8::HALF;
typedef unsigned u32x2v __attribute__((ext_vector_type(2)));
constexpr int NB = 16, SEQ = 2048, M = NB * SEQ, D = 1024, NIN = 2304, NINV = 2072, DFF = 2816, NGU = 2 * DFF, NLAYER = 2;
constexpr int L5 = 32, NCH = SEQ / L5, NS5 = 16 * L5, KS5 = NS5 + 128;
constexpr float LOG2E = 1.4426950408889634f, QSCALE = 0.125f * LOG2E;
constexpr int NWAVES = 8, NTHREADS = 512;
constexpr size_t MiB = 1u << 20;
constexpr size_t WS_CTL = 0, CTL_ZERO_BYTES = 64 * 1024;
constexpr size_t WS_WIN  = 1 * MiB;                                   constexpr size_t SZ_WIN  = (size_t)NIN * D * 2;
constexpr size_t WS_WOUT = WS_WIN  + NLAYER * SZ_WIN;                 constexpr size_t SZ_WOUT = (size_t)D * D * 2;
constexpr size_t WS_WGU  = WS_WOUT + NLAYER * SZ_WOUT;                constexpr size_t SZ_WGU  = (size_t)NGU * D * 2;
constexpr size_t WS_WD   = WS_WGU  + NLAYER * SZ_WGU;                 constexpr size_t SZ_WD   = (size_t)D * DFF * 2;
constexpr size_t WS_WGLU = WS_WD   + NLAYER * SZ_WD;                  constexpr size_t SZ_WGLU = (size_t)512 * 256 * 2;
constexpr size_t WS_WLRU = WS_WGLU + NLAYER * SZ_WGLU;                constexpr size_t SZ_WLRU = (size_t)512 * 256 * 2;
constexpr size_t WS_W1   = WS_WLRU + NLAYER * SZ_WLRU;                constexpr size_t SZ_W1   = (size_t)2 * 256 * 2048 * 2;
constexpr size_t WS_TOP  = WS_W1   + NLAYER * SZ_W1;                  constexpr size_t SZ_TOP  = (size_t)16 * NS5 * KS5 * 2;
constexpr size_t WS_MOP  = WS_TOP  + NLAYER * SZ_TOP;                 constexpr size_t SZ_MOP  = (size_t)16 * 256 * NS5 * 2;
constexpr size_t WS_TAB  = WS_MOP  + NLAYER * SZ_MOP;                 constexpr size_t SZ_TAB  = 16384;
constexpr size_t WS_LUT  = WS_TAB  + NLAYER * SZ_TAB;
constexpr size_t WS_RS   = (WS_LUT + 8192 + 255) & ~(size_t)255;
constexpr size_t WS_XN   = (WS_RS + (size_t)M * 16 * 4 + MiB - 1) & ~(MiB - 1);
constexpr size_t WS_MIXR = WS_XN + (size_t)M * D * 2;
constexpr size_t WS_Q    = WS_MIXR;
constexpr size_t WS_KC   = WS_Q   + (size_t)M * 512 * 2;
constexpr size_t WS_VC   = WS_KC  + (size_t)M * 128 * 2;
constexpr size_t WS_KS   = WS_VC  + (size_t)M * 128 * 2 + 65536;
constexpr size_t WS_KW   = WS_KS  + (size_t)M * 128 * 2;
constexpr size_t WS_VST  = WS_KW  + (size_t)M * 128 * 2;
constexpr size_t WS_VWT  = WS_VST + (size_t)M * 128 * 2;
constexpr size_t WS_AS5  = WS_VWT + (size_t)M * 128 * 2;
constexpr size_t WS_SLOC = WS_AS5 + (size_t)16 * 1024 * KS5 * 2;
constexpr size_t WS_YS   = WS_SLOC + (size_t)16 * 1024 * 128 * 4;
constexpr size_t WS_LX   = WS_YS  + (size_t)M * 256 * 2;
constexpr size_t WS_LG   = WS_LX  + (size_t)M * 256 * 2;
constexpr size_t WS_XC   = WS_LG  + (size_t)M * 256 * 2;
constexpr size_t WS_LA   = WS_XC  + (size_t)M * 256 * 2;
constexpr size_t WS_LB   = WS_LA  + (size_t)M * 256 * 4;
constexpr size_t WS_GATES= WS_LB  + (size_t)M * 256 * 4;
constexpr size_t WS_H1C  = WS_GATES + (size_t)M * 32 * 4;
constexpr size_t WS_KCC  = WS_H1C + (size_t)2 * 32 * 128 * 64 * 4;
constexpr size_t WS_VCT  = WS_KCC + (size_t)32 * 128 * 64 * 2;
constexpr size_t WS_MIX  = WS_VCT + (size_t)32 * 128 * 64 * 2;
constexpr size_t WS_END  = WS_MIX + (size_t)M * D * 2;
constexpr size_t WS_HMID = WS_MIXR;
static_assert(WS_HMID + (size_t)M * DFF * 2 <= WS_MIX, "HMID overlay must end before MIX");
constexpr int TB_BIAS1 = 0;
constexpr int TB_SP    = 128;
constexpr int TB_A32   = 512;
constexpr int CW_BAR = 4096;
constexpr int CW_PANEL = 1024;
constexpr int CW_CNT = 2048;

constexpr int RING_BYTES = 131072, MISC_OFF = RING_BYTES + 320, LDS_BYTES = 147456;

__device__ __forceinline__ float bf2f(unsigned h) { return __uint_as_float(h << 16); }
__device__ __forceinline__ float sigmoidf_(float x) { return __builtin_amdgcn_rcpf(1.0f + __expf(-x)); }
__device__ __forceinline__ float gelu_tanh(float x) { const float u = 1.5957691216057308f * (x + 0.044715f * x * x * x); return x * __builtin_amdgcn_rcpf(1.0f + __expf(-u)); }
__device__ __forceinline__ v4u pack8(const float (&v)[8]) { v4u w; w.x = pg8::cvt_pk_bf16(v[0], v[1]); w.y = pg8::cvt_pk_bf16(v[2], v[3]); w.z = pg8::cvt_pk_bf16(v[4], v[5]); w.w = pg8::cvt_pk_bf16(v[6], v[7]); return w; }
__device__ __forceinline__ void unpack8(const v4u w, float (&v)[8]) { v[0] = bf2f(w.x & 0xffffu); v[1] = bf2f(w.x >> 16); v[2] = bf2f(w.y & 0xffffu); v[3] = bf2f(w.y >> 16); v[4] = bf2f(w.z & 0xffffu); v[5] = bf2f(w.z >> 16); v[6] = bf2f(w.w & 0xffffu); v[7] = bf2f(w.w >> 16); }
__device__ __forceinline__ float row_rstd(const float* RS, int row, int fq) {
    const f32x4 v = *(const f32x4*)(RS + (size_t)row * 16 + 4 * fq);
    float s = (v.x + v.y) + (v.z + v.w); s += __shfl_xor(s, 16); s += __shfl_xor(s, 32);
    return rsqrtf(s * (1.0f / 1024.0f) + 1e-6f);
}
typedef const pg8::f32x4 (&AccRef)[2][2][4][2];
constexpr int RSL_OFF = RING_BYTES + 1024, RSL_MAX_UNITS = 12;
static_assert(RSL_OFF + RSL_MAX_UNITS * 256 * 4 <= LDS_BYTES, "row-scale table fits the spare LDS");
template <class Sched>
__device__ __forceinline__ void rsl_fill(const float* RS, const Sched& S, LAS unsigned char* lds, int tid) {
    LAS float* RL = (LAS float*)(lds + RSL_OFF); const int r = tid >> 1, hf = tid & 1;
    Unit u; f32x4 a[RSL_MAX_UNITS], b[RSL_MAX_UNITS];
#pragma unroll
    for (int i = 0; i < RSL_MAX_UNITS; ++i) if (S.next(i, u)) { const float* p = RS + (size_t)(u.pm * BM + r) * 16 + 8 * hf; a[i] = *(const f32x4*)p; b[i] = *(const f32x4*)(p + 4); }
#pragma unroll
    for (int i = 0; i < RSL_MAX_UNITS; ++i) if (S.next(i, u)) { float s = ((a[i].x + a[i].y) + (a[i].z + a[i].w)) + ((b[i].x + b[i].y) + (b[i].z + b[i].w)); s += __shfl_xor(s, 1);
        if (hf == 0) RL[i * 256 + r] = rsqrtf(s * (1.0f / 1024.0f) + 1e-6f); }
    __syncthreads();
}
__device__ __forceinline__ void rsl_read8(const LAS unsigned char* lds, int ui, int wr, int fr, float (&rs)[2][4]) {
    const LAS float* RL = (const LAS float*)(lds + RSL_OFF) + ui * 256 + wr * 64 + fr;
#pragma unroll
    for (int ai = 0; ai < 2; ++ai)
#pragma unroll
        for (int m = 0; m < 4; ++m) rs[ai][m] = RL[ai * HALF + m * 16];
}
__device__ __forceinline__ void row_rstd8(const float* RS, int row0, int fq, float (&rs)[2][4]) {
    f32x4 v[2][4];
#pragma unroll
    for (int ai = 0; ai < 2; ++ai)
#pragma unroll
        for (int m = 0; m < 4; ++m) v[ai][m] = *(const f32x4*)(RS + (size_t)(row0 + ai * HALF + m * 16) * 16 + 4 * fq);
#pragma unroll
    for (int ai = 0; ai < 2; ++ai)
#pragma unroll
        for (int m = 0; m < 4; ++m) { float s = (v[ai][m].x + v[ai][m].y) + (v[ai][m].z + v[ai][m].w); s += __shfl_xor(s, 16); s += __shfl_xor(s, 32); rs[ai][m] = rsqrtf(s * (1.0f / 1024.0f) + 1e-6f); }
}

struct EpiInProj {
    static constexpr bool PERM = true, AFTER_DRAIN = false;
    unsigned char* w; const LAS unsigned char* lds; mutable int ui;
    __device__ __forceinline__ void operator()(AccRef acc, const Unit& u, int wr, int wc, int fr, int fq) const {
        const int pn = u.pn;
        float rs8[2][4]; rsl_read8(lds, ui, wr, fr, rs8); ++ui;
        const float* RS = (const float*)(w + WS_RS); (void)RS; bf16_t* Q = (bf16_t*)(w + WS_Q); bf16_t* KC = (bf16_t*)(w + WS_KC); bf16_t* VC = (bf16_t*)(w + WS_VC); bf16_t* KS = (bf16_t*)(w + WS_KS); bf16_t* KW = (bf16_t*)(w + WS_KW);
        bf16_t* VST = (bf16_t*)(w + WS_VST); bf16_t* VWT = (bf16_t*)(w + WS_VWT); bf16_t* AS5 = (bf16_t*)(w + WS_AS5); bf16_t* LX = (bf16_t*)(w + WS_LX); bf16_t* LG = (bf16_t*)(w + WS_LG); float* GATES = (float*)(w + WS_GATES);
#pragma unroll
        for (int ai = 0; ai < 2; ++ai)
#pragma unroll
            for (int m = 0; m < 4; ++m) {
                const int row = u.pm * BM + ai * HALF + wr * 64 + m * 16 + fr;
                const float rs = rs8[ai][m];
                const int b = row >> 11, t = row & 2047;
#pragma unroll
                for (int bj = 0; bj < 2; ++bj) {
                    const int c8 = bj * HALF + wc * 32 + 8 * fq;
                    float v[8];
#pragma unroll
                    for (int j = 0; j < 4; ++j) { v[j] = acc[ai][bj][m][0][j] * rs; v[4 + j] = acc[ai][bj][m][1][j] * rs; }
                    if (pn == 0) {
                        const int g = c8 >> 4, co = c8 & 15;
                        *(v4u*)(AS5 + ((size_t)(g * 1024 + b * 64 + (t >> 5)) * KS5 + (t & 31) * 16 + co)) = pack8(v);
                    } else if (pn <= 2) {
#pragma unroll
                        for (int j = 0; j < 8; ++j) v[j] *= QSCALE;
                        *(v4u*)(Q + (size_t)row * 512 + (pn - 1) * 256 + c8) = pack8(v);
                    } else if (pn <= 5) {
                        const int c = c8 & 127, h = c >> 6, d = c & 63;
                        const size_t kvrow = (size_t)(b * 2 + h) * 2048 + t;
                        if (bj == 0) { bf16_t* base = pn == 3 ? KC : (pn == 4 ? KS : KW); *(v4u*)(base + kvrow * 64 + d) = pack8(v); }
                        else if (pn == 3) { *(v4u*)(VC + kvrow * 64 + d) = pack8(v); }
                        else { bf16_t* base = pn == 4 ? VST : VWT;
#pragma unroll
                            for (int j = 0; j < 8; ++j) base[((size_t)(b * 2 + h) * 64 + d + j) * 2048 + t] = (bf16_t)f2bf(v[j]); }
                    } else if (pn == 6) {
                        *(v4u*)(LX + (size_t)row * 256 + c8) = pack8(v);
                    } else if (pn == 7) {
#pragma unroll
                        for (int j = 0; j < 8; ++j) v[j] = gelu_tanh(v[j]);
                        *(v4u*)(LG + (size_t)row * 256 + c8) = pack8(v);
                    } else {
                        if (bj == 0 && wc == 0 && fq < 3) {
                            f32x4 a, c; a.x = sigmoidf_(v[0]); a.y = sigmoidf_(v[1]); a.z = sigmoidf_(v[2]); a.w = sigmoidf_(v[3]);
                            c.x = sigmoidf_(v[4]); c.y = sigmoidf_(v[5]); c.z = sigmoidf_(v[6]); c.w = sigmoidf_(v[7]);
                            *(f32x4*)(GATES + (size_t)row * 32 + 8 * fq) = a; *(f32x4*)(GATES + (size_t)row * 32 + 8 * fq + 4) = c; }
                    }
                }
            }
    }
};
struct EpiGates {
    static constexpr bool PERM = true, AFTER_DRAIN = false;
    unsigned char* w;
    __device__ __forceinline__ void operator()(AccRef acc, const Unit& u, int wr, int wc, int fr, int fq) const {
        if (wc != 0) return;
        float* GATES = (float*)(w + WS_GATES);
        float rs8[2][4]; row_rstd8((const float*)(w + WS_RS), u.pm * BM + wr * 64 + fr, fq, rs8);
#pragma unroll
        for (int ai = 0; ai < 2; ++ai)
#pragma unroll
            for (int m = 0; m < 4; ++m) {
                const int row = u.pm * BM + ai * HALF + wr * 64 + m * 16 + fr;
                const float rs = rs8[ai][m];
                if (fq < 3) { f32x4 a, c;
#pragma unroll
                    for (int j = 0; j < 4; ++j) { a[j] = sigmoidf_(acc[ai][0][m][0][j] * rs); c[j] = sigmoidf_(acc[ai][0][m][1][j] * rs); }
                    *(f32x4*)(GATES + (size_t)row * 32 + 8 * fq) = a; *(f32x4*)(GATES + (size_t)row * 32 + 8 * fq + 4) = c; }
            }
    }
};
struct EpiResid {
    static constexpr bool PERM = true, AFTER_DRAIN = false;
    bf16_t* XN; float* RS;
    __device__ __forceinline__ void operator()(AccRef acc, const Unit& u, int wr, int wc, int fr, int fq) const {
        const int row0 = u.pm * BM + wr * 64 + fr, col0 = u.pn * BM + wc * 32 + 8 * fq;
        v4u hv[4][2];
#pragma unroll
        for (int g = 0; g < 4; ++g)
#pragma unroll
            for (int bj = 0; bj < 2; ++bj) hv[g][bj] = *(const v4u*)(XN + (size_t)(row0 + (g & 3) * 16) * D + col0 + bj * HALF);
#pragma unroll
        for (int g = 0; g < 8; ++g) { const int ai = g >> 2, m = g & 3; const int row = row0 + ai * HALF + m * 16; float ss = 0.f;
            v4u cur0 = hv[g & 3][0], cur1 = hv[g & 3][1];
            if (g < 4) {
#pragma unroll
                for (int bj = 0; bj < 2; ++bj) hv[g & 3][bj] = *(const v4u*)(XN + (size_t)(row0 + HALF + (g & 3) * 16) * D + col0 + bj * HALF); }
#pragma unroll
            for (int bj = 0; bj < 2; ++bj) { float h[8]; unpack8(bj == 0 ? cur0 : cur1, h);
#pragma unroll
                for (int j = 0; j < 4; ++j) { h[j] += acc[ai][bj][m][0][j]; h[4 + j] += acc[ai][bj][m][1][j]; }
#pragma unroll
                for (int j = 0; j < 8; ++j) ss += h[j] * h[j];
                *(v4u*)(XN + (size_t)row * D + col0 + bj * HALF) = pack8(h); }
            ss += __shfl_xor(ss, 16); ss += __shfl_xor(ss, 32);
            if (fq == 0) RS[(size_t)row * 16 + u.pn * 4 + wc] = ss; }
    }
};
struct EpiGateUp {
    static constexpr bool PERM = true, AFTER_DRAIN = false;
    const LAS unsigned char* lds; bf16_t* HM; mutable int ui;
    __device__ __forceinline__ void operator()(AccRef acc, const Unit& u, int wr, int wc, int fr, int fq) const {
        typedef float f32x2 __attribute__((ext_vector_type(2)));
        float rs8[2][4]; rsl_read8(lds, ui, wr, fr, rs8); ++ui;
#pragma unroll
        for (int ai = 0; ai < 2; ++ai)
#pragma unroll
            for (int m = 0; m < 4; ++m) {
                const int row = u.pm * BM + ai * HALF + wr * 64 + m * 16 + fr;
                const float rs = rs8[ai][m], k1 = -rs * LOG2E, k2 = rs * rs;
                float v[8];
#pragma unroll
                for (int n = 0; n < 2; ++n)
#pragma unroll
                    for (int jp = 0; jp < 2; ++jp) {
                        const f32x2 g = {acc[ai][0][m][n][2 * jp], acc[ai][0][m][n][2 * jp + 1]}, up = {acc[ai][1][m][n][2 * jp], acc[ai][1][m][n][2 * jp + 1]};
                        const f32x2 x = g * k1; f32x2 e; e.x = __builtin_amdgcn_exp2f(x.x); e.y = __builtin_amdgcn_exp2f(x.y);
                        const f32x2 d = e + 1.0f; f32x2 r; r.x = __builtin_amdgcn_rcpf(d.x); r.y = __builtin_amdgcn_rcpf(d.y);
                        const f32x2 o = ((g * up) * k2) * r; v[4 * n + 2 * jp] = o.x; v[4 * n + 2 * jp + 1] = o.y; }
                *(v4u*)(HM + (size_t)row * DFF + u.pn * 128 + wc * 32 + 8 * fq) = pack8(v);
                asm volatile("" ::: "memory");
            }
    }
};
struct EpiProbeRaw {
    static constexpr bool PERM = true, AFTER_DRAIN = false;
    bf16_t* HM;
    __device__ __forceinline__ void operator()(AccRef acc, const Unit& u, int wr, int wc, int fr, int fq) const {
#pragma unroll
        for (int ai = 0; ai < 2; ++ai)
#pragma unroll
            for (int m = 0; m < 4; ++m) { const int row = u.pm * BM + ai * HALF + wr * 64 + m * 16 + fr; float v[8];
#pragma unroll
                for (int n = 0; n < 2; ++n)
#pragma unroll
                    for (int j = 0; j < 4; ++j) v[4 * n + j] = acc[ai][0][m][n][j] + acc[ai][1][m][n][j];
                *(v4u*)(HM + (size_t)row * DFF + u.pn * 128 + wc * 32 + 8 * fq) = pack8(v); }
    }
};
struct EpiS5StateScan {
    static constexpr bool PERM = false, AFTER_DRAIN = true;
    const float* a32; bf16_t* AS5;
    __device__ __forceinline__ void fused(AccRef acc, const Unit& u, int wr, int wc, int fr, int fq, PG8_LAS unsigned char* lds, int wid, int lane) const {
        LAS float* S = (LAS float*)lds;
#pragma unroll
        for (int ai = 0; ai < 2; ++ai)
#pragma unroll
            for (int m = 0; m < 4; ++m) { const int rowl = ai * HALF + wr * 64 + m * 16 + fr;
#pragma unroll
                for (int n = 0; n < 2; ++n) *(LAS f32x4*)(S + rowl * 128 + wc * 32 + 16 * n + 4 * fq) = acc[ai][0][m][n]; }
        asm volatile("s_waitcnt lgkmcnt(0)" ::: "memory"); __builtin_amdgcn_s_barrier(); asm volatile("" ::: "memory");
        const int tid = wid * 64 + lane;
        if (tid < 256) { const int bl = tid >> 6, p = tid & 63, g = u.pm >> 2;
            const float ar = a32[2 * (g * 64 + p)], aI = a32[2 * (g * 64 + p) + 1]; float hr = 0.f, hi = 0.f;
#pragma unroll 4
            for (int ch = 0; ch < NCH; ++ch) { const size_t R = (size_t)u.pm * BM + bl * 64 + ch;
                AS5[R * KS5 + NS5 + p] = (bf16_t)f2bf(hr); AS5[R * KS5 + NS5 + 64 + p] = (bf16_t)f2bf(hi);
                const float sr = S[(bl * 64 + ch) * 128 + p], si = S[(bl * 64 + ch) * 128 + 64 + p];
                const float nr = ar * hr - aI * hi + sr, ni = ar * hi + aI * hr + si; hr = nr; hi = ni; } }
        asm volatile("s_waitcnt lgkmcnt(0)" ::: "memory"); __builtin_amdgcn_s_barrier(); asm volatile("" ::: "memory");
    }
};
struct EpiS5Main {
    static constexpr bool PERM = true, AFTER_DRAIN = false;
    const bf16_t* AS5; const float* dskip; bf16_t* YS;
    __device__ __forceinline__ void operator()(AccRef acc, const Unit& u, int wr, int wc, int fr, int fq) const {
#pragma unroll
        for (int ai = 0; ai < 2; ++ai)
#pragma unroll
            for (int m = 0; m < 4; ++m) {
                const int R = u.pm * BM + ai * HALF + wr * 64 + m * 16 + fr;
                const int g = R >> 10, b = (R >> 6) & 15, ch = R & 63;
#pragma unroll
                for (int bj = 0; bj < 2; ++bj) {
                    const int cg = (u.pn & 1) * 256 + bj * HALF + wc * 32 + 8 * fq, t = cg >> 4, co = cg & 15;
                    float uu[8], v[8]; unpack8(*(const v4u*)(AS5 + (size_t)R * KS5 + cg), uu);
                    const f32x4 d0 = *(const f32x4*)(dskip + 16 * g + co), d1 = *(const f32x4*)(dskip + 16 * g + co + 4);
#pragma unroll
                    for (int j = 0; j < 4; ++j) { v[j] = gelu_tanh(acc[ai][bj][m][0][j] + d0[j] * uu[j]); v[4 + j] = gelu_tanh(acc[ai][bj][m][1][j] + d1[j] * uu[4 + j]); }
                    *(v4u*)(YS + (size_t)(b * 2048 + ch * 32 + t) * 256 + 16 * g + co) = pack8(v);
                }
            }
    }
};
struct EpiGlu {
    static constexpr bool PERM = true, AFTER_DRAIN = false;
    bf16_t* MIX;
    __device__ __forceinline__ void operator()(AccRef acc, const Unit& u, int wr, int wc, int fr, int fq) const {
#pragma unroll
        for (int ai = 0; ai < 2; ++ai)
#pragma unroll
            for (int m = 0; m < 4; ++m) {
                const int row = u.pm * BM + ai * HALF + wr * 64 + m * 16 + fr;
                float v[8];
#pragma unroll
                for (int n = 0; n < 2; ++n)
#pragma unroll
                    for (int j = 0; j < 4; ++j) v[4 * n + j] = acc[ai][0][m][n][j] * sigmoidf_(acc[ai][1][m][n][j]);
                *(v4u*)(MIX + (size_t)row * D + u.pn * 128 + wc * 32 + 8 * fq) = pack8(v);
                asm volatile("" ::: "memory");
            }
    }
};
struct EpiLruGates {
    static constexpr bool PERM = true, AFTER_DRAIN = false;
    const bf16_t* XC; const float *b_a, *b_x, *sp; bf16_t *LA, *LB;
    __device__ __forceinline__ void operator()(AccRef acc, const Unit& u, int wr, int wc, int fr, int fq) const {
        const int ch = u.pn * 128 + wc * 32 + 8 * fq;
        float ba[8], bx[8], s8[8];
#pragma unroll
        for (int j = 0; j < 8; ++j) { ba[j] = b_a[ch + j]; bx[j] = b_x[ch + j]; s8[j] = sp[ch + j]; }
#pragma unroll
        for (int ai = 0; ai < 2; ++ai)
#pragma unroll
            for (int m = 0; m < 4; ++m) {
                const int row = u.pm * BM + ai * HALF + wr * 64 + m * 16 + fr;
                float xc[8], oa[8], ob[8]; unpack8(*(const v4u*)(XC + (size_t)row * 256 + ch), xc);
#pragma unroll
                for (int j = 0; j < 8; ++j) { const float ar = acc[ai][0][m][j >> 2][j & 3], ai_ = acc[ai][1][m][j >> 2][j & 3];
                    const float r = sigmoidf_(ar + ba[j]), ig = sigmoidf_(ai_ + bx[j]);
                    const float la = -8.0f * r * s8[j]; const float av = __expf(la);
                    oa[j] = 1.0f - av; ob[j] = sqrtf(fmaxf(1.0f - av * av, 0.f)) * ig * xc[j]; }
                *(v4u*)(LA + (size_t)row * 256 + ch) = pack8(oa); *(v4u*)(LB + (size_t)row * 256 + ch) = pack8(ob);
                asm volatile("" ::: "memory");
            }
    }
};
struct EpiCompress2 {
    static constexpr bool PERM = false, AFTER_DRAIN = true;
    const float* bias1; const float* w2k; const float* w2v; bf16_t* KCC; bf16_t* VCT;
    __device__ __forceinline__ void fused(AccRef acc, const Unit& u, int wr, int wc, int fr, int fq, PG8_LAS unsigned char* lds, int wid, int lane) const {
        LAS float* Hs = (LAS float*)lds; LAS float* W2s = (LAS float*)(lds + 256 * 65 * 4 + 64);
        const int kv = u.pn, tid = wid * 64 + lane; const float* w2 = kv ? w2v : w2k;
        for (int i = tid; i < 4096; i += NTHREADS) W2s[i] = w2[i];
        if (wc < 2) {
#pragma unroll
            for (int n = 0; n < 2; ++n) { const int j0 = wc * 32 + 16 * n + 4 * fq; const f32x4 bv = *(const f32x4*)(bias1 + kv * 64 + j0);
#pragma unroll
                for (int ai = 0; ai < 2; ++ai)
#pragma unroll
                    for (int m = 0; m < 4; ++m) { const int rowl = ai * HALF + wr * 64 + m * 16 + fr; const f32x4 h = acc[ai][0][m][n] + bv;
                        Hs[rowl * 65 + j0] = gelu_tanh(h.x); Hs[rowl * 65 + j0 + 1] = gelu_tanh(h.y); Hs[rowl * 65 + j0 + 2] = gelu_tanh(h.z); Hs[rowl * 65 + j0 + 3] = gelu_tanh(h.w); } } }
        asm volatile("s_waitcnt vmcnt(0) lgkmcnt(0)" ::: "memory"); __builtin_amdgcn_s_barrier(); asm volatile("" ::: "memory");
        const int rowl = tid >> 1, jh = tid & 1, rr = u.pm * BM + rowl - kv * 4096, bh = rr >> 7, n = rr & 127;
        float o[32];
#pragma unroll
        for (int j = 0; j < 32; ++j) o[j] = 0.f;
        if (n < 127) {
#pragma unroll 2
            for (int k = 0; k < 64; ++k) { const float hk = Hs[rowl * 65 + k];
#pragma unroll
                for (int j4 = 0; j4 < 8; ++j4) { const f32x4 wv = *(const LAS f32x4*)(W2s + k * 64 + jh * 32 + 4 * j4); o[4 * j4] += hk * wv.x; o[4 * j4 + 1] += hk * wv.y; o[4 * j4 + 2] += hk * wv.z; o[4 * j4 + 3] += hk * wv.w; } } }
        if (kv == 0) { bf16_t* dst = KCC + ((size_t)bh * 128 + n) * 64 + jh * 32;
#pragma unroll
            for (int j8 = 0; j8 < 4; ++j8) { float v8[8];
#pragma unroll
                for (int j = 0; j < 8; ++j) v8[j] = o[8 * j8 + j];
                *(v4u*)(dst + 8 * j8) = pack8(v8); } }
        else {
#pragma unroll
            for (int j = 0; j < 32; ++j) VCT[((size_t)bh * 64 + jh * 32 + j) * 128 + n] = (bf16_t)f2bf(o[j]); }
        asm volatile("s_waitcnt lgkmcnt(0)" ::: "memory"); __builtin_amdgcn_s_barrier(); asm volatile("" ::: "memory");
    }
};

__device__ __forceinline__ float wave_sum(float v) {
#pragma unroll
    for (int o = 1; o < 64; o <<= 1) v += __shfl_xor(v, o);
    return v;
}
struct RmIdent { __device__ __forceinline__ int operator()(int n) const { return n; } };
struct RmWin   { __device__ __forceinline__ int operator()(int n) const { return n < 1536 ? n : (n < 1560 ? 2048 + (n - 1536) : n - 24); } };
struct RmPair  { int half, split; __device__ __forceinline__ int operator()(int n) const { const int c = n - split; return 256 * (c >> 7) + half * 128 + (c & 127); } };
struct RmGlu   { __device__ __forceinline__ int operator()(int n) const { const int hf = n >= 256, c = n - 256 * hf; return 256 * (c >> 7) + hf * 128 + (c & 127); } };
template <class RowMap>
__device__ __forceinline__ void tr_item(const float* W, int ldw, int ncols, int K, const float* kscale, bf16_t* WT, const RowMap rm, LAS float* scr, int item, int lane) {
    const int nblk = (ncols + 31) >> 5, kb = item / nblk, nb = item - kb * nblk, k0 = 64 * kb, n0 = 32 * nb;
    const int nn = n0 + (lane & 31);
    float wv[32];
#pragma unroll
    for (int i = 0; i < 32; ++i) { const int kk = 2 * i + (lane >> 5); wv[i] = nn < ncols ? W[(size_t)(k0 + kk) * ldw + nn] : 0.f; }
#pragma unroll
    for (int i = 0; i < 32; ++i) { const int kk = 2 * i + (lane >> 5); float v = wv[i]; if (kscale) v *= kscale[k0 + kk]; scr[kk * 33 + (lane & 31)] = v; }
    LDS_WAIT(); asm volatile("" ::: "memory");
    const int c = lane & 7;
#pragma unroll
    for (int j = 0; j < 4; ++j) { const int nl = (lane >> 3) + 8 * j, n = n0 + nl; const LAS float* s = scr + (8 * c) * 33 + nl;
        v4u o; o.x = pk2(s[0 * 33], s[1 * 33]); o.y = pk2(s[2 * 33], s[3 * 33]); o.z = pk2(s[4 * 33], s[5 * 33]); o.w = pk2(s[6 * 33], s[7 * 33]);
        if (n < ncols) *(v4u*)(WT + (size_t)rm(n) * K + k0 + 8 * c) = o; }
    LDS_WAIT(); asm volatile("" ::: "memory");
}
template <class RowMap>
__device__ __forceinline__ void tr_job(const float* W, int ldw, int ncols, int K, const float* kscale, bf16_t* WT, const RowMap rm, LAS float* scr, int gw, int NGW, int lane, int rot) {
    const int nitems = (K >> 6) * ((ncols + 31) >> 5);
    for (int it = (gw + rot) % NGW; it < nitems; it += NGW) tr_item(W, ldw, ncols, K, kscale, WT, rm, scr, it, lane);
}
template <class RowMap>
__device__ __forceinline__ void trb_job(const float* W, int ldw, int ncols, int K, const float* kscale, bf16_t* WT, const RowMap rm, LAS unsigned char* lds, int bid, int G, int tid, int rot) {
    LAS bf16_t* T = (LAS bf16_t*)lds; constexpr int TP = 258;
    const int nblk = (ncols + 255) >> 8, nitems = (K >> 6) * nblk;
    for (int it = ((bid - rot) % G + G) % G; it < nitems; it += G) {
        const int kb = it / nblk, nb = it - kb * nblk, k0 = 64 * kb, n0 = 256 * nb, c4 = (tid & 63) * 4, kr = tid >> 6;
        f32x4 v[8];
#pragma unroll
        for (int p = 0; p < 8; ++p) { const f32x4 z = {0.f, 0.f, 0.f, 0.f}; v[p] = (n0 + c4 < ncols) ? *(const GAS f32x4*)(W + (size_t)(k0 + p * 8 + kr) * ldw + n0 + c4) : z; }
#pragma unroll
        for (int p = 0; p < 8; ++p) { const int kk = p * 8 + kr; const float sc = kscale ? kscale[k0 + kk] : 1.0f;
            LAS unsigned* d = (LAS unsigned*)(T + kk * TP + c4); d[0] = pk2(v[p].x * sc, v[p].y * sc); d[1] = pk2(v[p].z * sc, v[p].w * sc); }
        __syncthreads();
#pragma unroll
        for (int q = 0; q < 4; ++q) { const int idx = tid + q * NTHREADS, n = idx >> 3, c = idx & 7; const LAS bf16_t* src = T + (8 * c) * TP + n;
            v4u o; o.x = (unsigned)src[0] | ((unsigned)src[TP] << 16); o.y = (unsigned)src[2 * TP] | ((unsigned)src[3 * TP] << 16); o.z = (unsigned)src[4 * TP] | ((unsigned)src[5 * TP] << 16); o.w = (unsigned)src[6 * TP] | ((unsigned)src[7 * TP] << 16);
            if (n0 + n < ncols) *(v4u*)(WT + (size_t)rm(n0 + n) * K + k0 + 8 * c) = o; }
        __syncthreads();
    }
}
__device__ __forceinline__ void zero_job(void* p, size_t n16, int gtid, int NT) { v4u z = {0u, 0u, 0u, 0u}; for (size_t i = gtid; i < n16; i += NT) ((v4u*)p)[i] = z; }

struct S5Coef { float lr, li, dt; };
__device__ __forceinline__ S5Coef s5_coef(const float* lam_re, const float* lam_im, const float* log_dt, int l, int g, int p) {
    S5Coef c; c.lr = lam_re[(l * 16 + g) * 64 + p]; c.li = lam_im[(l * 16 + g) * 64 + p]; c.dt = expf(log_dt[l * 16 + g]); return c; }
__device__ __forceinline__ void s5_apow(const S5Coef& c, float tau, float& re, float& im) { const float mag = expf(c.lr * c.dt * tau), ang = c.li * c.dt * tau; re = mag * cosf(ang); im = mag * sinf(ang); }
__device__ __forceinline__ void s5_apow_fast(const S5Coef& c, float tau, float& re, float& im) { const float mag = __expf(c.lr * c.dt * tau), ang = c.li * c.dt * tau; re = mag * __cosf(ang); im = mag * __sinf(ang); }
__device__ __forceinline__ void s5_f_fast(const S5Coef& c, float& fre, float& fim) {
    float are, aim; s5_apow_fast(c, 1.0f, are, aim); const float rden = __builtin_amdgcn_rcpf(c.lr * c.lr + c.li * c.li);
    fre = ((are - 1.0f) * c.lr + aim * c.li) * rden; fim = (aim * c.lr - (are - 1.0f) * c.li) * rden; }
__device__ __forceinline__ void s5_f(const S5Coef& c, float& fre, float& fim) {
    float are, aim; s5_apow(c, 1.0f, are, aim); const float den = c.lr * c.lr + c.li * c.li;
    fre = ((are - 1.0f) * c.lr + aim * c.li) / den; fim = (aim * c.lr - (are - 1.0f) * c.li) / den; }

struct Args { const float* in[32]; float* out; unsigned char* ws; int ph_lo, ph_hi, li, pad; };

__device__ __forceinline__ int t5_bucket(int n) { if (n < 16) return n; const int lg = 16 + (int)(logf((float)n * (1.0f / 16.0f)) / 2.0794415416798357f * 16.0f); return lg < 31 ? lg : 31; }

__device__ __forceinline__ void p0_prologue(const Args& P, LAS unsigned char* lds, int tid, int lane, int wave, int bid, int G, const int which) {
    LAS float* scr = (LAS float*)(lds + wave * 16384);
    const int gw = bid * NWAVES + wave, NGW = G * NWAVES, gtid = bid * NTHREADS + tid, NT = G * NTHREADS;
    unsigned char* ws = P.ws;
    if (which & 1) {
    { const float* x = P.in[0]; bf16_t* XN = (bf16_t*)(ws + WS_XN); float* RS = (float*)(ws + WS_RS);
      for (int m0 = gw * 4; m0 < M; m0 += NGW * 4) {
          f32x4 v[4][4]; float s[4];
#pragma unroll
          for (int q = 0; q < 4; ++q) { const f32x4* xr = (const f32x4*)(x + (size_t)(m0 + q) * D) + lane;
#pragma unroll
              for (int j = 0; j < 4; ++j) v[q][j] = xr[64 * j]; }
#pragma unroll
          for (int q = 0; q < 4; ++q) { s[q] = 0.f;
#pragma unroll
              for (int j = 0; j < 4; ++j) s[q] += (v[q][j].x * v[q][j].x + v[q][j].y * v[q][j].y) + (v[q][j].z * v[q][j].z + v[q][j].w * v[q][j].w);
              s[q] = wave_sum(s[q]); }
#pragma unroll
          for (int q = 0; q < 4; ++q) { const int m = m0 + q;
#pragma unroll
              for (int j = 0; j < 4; ++j) { u32x2v w; w.x = pg8::cvt_pk_bf16(v[q][j].x, v[q][j].y); w.y = pg8::cvt_pk_bf16(v[q][j].z, v[q][j].w); *(u32x2v*)(XN + (size_t)m * D + (64 * j + lane) * 4) = w; }
              if (lane < 16) RS[(size_t)m * 16 + lane] = lane == 0 ? s[q] : 0.f; }
      } }
    }
    if (!(which & 2)) return;
    for (int l = 0; l < NLAYER; ++l) {
        bf16_t* WinT = (bf16_t*)(ws + WS_WIN + l * SZ_WIN); bf16_t* WoutT = (bf16_t*)(ws + WS_WOUT + l * SZ_WOUT); bf16_t* WguT = (bf16_t*)(ws + WS_WGU + l * SZ_WGU);
        bf16_t* WdT = (bf16_t*)(ws + WS_WD + l * SZ_WD); bf16_t* WgluT = (bf16_t*)(ws + WS_WGLU + l * SZ_WGLU); bf16_t* W1T = (bf16_t*)(ws + WS_W1 + l * SZ_W1);
        __syncthreads();
        trb_job(P.in[3] + (size_t)l * D * NINV, NINV, NINV, D, P.in[2] + l * D, WinT, RmWin(), lds, bid, G, tid, 736 * l + 0);
        trb_job(P.in[4] + (size_t)l * D * D, D, D, D, (const float*)nullptr, WoutT, RmIdent(), lds, bid, G, tid, 736 * l + 144);
        trb_job(P.in[28] + (size_t)l * D * DFF, DFF, DFF, D, P.in[27] + l * D, WguT, RmPair{0, 0}, lds, bid, G, tid, 736 * l + 208);
        trb_job(P.in[29] + (size_t)l * D * DFF, DFF, DFF, D, P.in[27] + l * D, WguT, RmPair{1, 0}, lds, bid, G, tid, 736 * l + 384);
        trb_job(P.in[30] + (size_t)l * DFF * D, D, D, DFF, (const float*)nullptr, WdT, RmIdent(), lds, bid, G, tid, 736 * l + 560);
    }
    { const int l = gw & 1;
      const int gw_all = gw, NGW_all = NGW, gtid_all = gtid, NT_all = NT; (void)gw_all; (void)NGW_all; (void)gtid_all; (void)NT_all;
      const int gw2 = gw >> 1, NGW2 = NGW >> 1, gtid2 = gw2 * 64 + lane, NT2 = NT >> 1;
#define gw gw2
#define NGW NGW2
#define gtid gtid2
#define NT NT2
        bf16_t* WinT = (bf16_t*)(ws + WS_WIN + l * SZ_WIN); bf16_t* WoutT = (bf16_t*)(ws + WS_WOUT + l * SZ_WOUT); bf16_t* WguT = (bf16_t*)(ws + WS_WGU + l * SZ_WGU);
        bf16_t* WdT = (bf16_t*)(ws + WS_WD + l * SZ_WD); bf16_t* WgluT = (bf16_t*)(ws + WS_WGLU + l * SZ_WGLU); bf16_t* W1T = (bf16_t*)(ws + WS_W1 + l * SZ_W1);
        tr_job(P.in[13] + (size_t)l * 256 * 512, 512, 512, 256, (const float*)nullptr, WgluT, RmGlu(), scr, gw, NGW, lane, 1680);
        tr_job(P.in[15] + (size_t)l * 2048 * 64, 64, 64, 2048, (const float*)nullptr, W1T, RmIdent(), scr, gw, NGW, lane, 1744);
        tr_job(P.in[18] + (size_t)l * 2048 * 64, 64, 64, 2048, (const float*)nullptr, W1T + 256 * 2048, RmIdent(), scr, gw, NGW, lane, 1808);
        zero_job(WinT + (size_t)NINV * D, (size_t)(NIN - NINV) * D * 2 / 16, gtid, NT);
        zero_job(W1T + 64 * 2048, (size_t)192 * 2048 * 2 / 16, gtid, NT);
        zero_job(W1T + 256 * 2048 + 64 * 2048, (size_t)192 * 2048 * 2 / 16, gtid, NT);
        { bf16_t* WlT = (bf16_t*)(ws + WS_WLRU + l * SZ_WLRU); const float* wa = P.in[22] + (size_t)l * 4 * 64 * 64; const float* wx = P.in[24] + (size_t)l * 4 * 64 * 64;
          for (int i = gtid; i < 512 * 256; i += NT) { const int r = i >> 8, k = i & 255, pn = r >> 8, hf = (r >> 7) & 1, ch = pn * 128 + (r & 127), h = ch >> 6, j = ch & 63;
              float v = 0.f; if ((k >> 6) == h) v = (hf ? wx : wa)[(h * 64 + (k & 63)) * 64 + j]; WlT[i] = (bf16_t)f2bf(v); } }
        { float* TB = (float*)(ws + WS_TAB + l * SZ_TAB);
          for (int i = (gw + 96) % NGW; i < 128; i += NGW) { const int kv = i >> 6, j = i & 63; const float* pe = P.in[kv ? 17 : 14] + (size_t)l * 2048; const float* w1 = P.in[kv ? 18 : 15] + (size_t)l * 2048 * 64;
              float s = 0.f;
#pragma unroll 8
              for (int q = 0; q < 32; ++q) { const int k = lane + 64 * q; s += pe[k] * w1[(size_t)k * 64 + j]; }
              s = wave_sum(s); if (lane == 0) TB[TB_BIAS1 + i] = s; }
          for (int i = gtid; i < 256; i += NT) { const float lam = P.in[26][l * 256 + i]; TB[TB_SP + i] = lam > 15.f ? expf(-lam) : log1pf(expf(-lam)); }
          for (int i = gtid; i < 1024; i += NT) { const S5Coef c = s5_coef(P.in[5], P.in[6], P.in[7], l, i >> 6, i & 63); float re, im; s5_apow(c, (float)L5, re, im); TB[TB_A32 + 2 * i] = re; TB[TB_A32 + 2 * i + 1] = im; } }
        { bf16_t* TOP = (bf16_t*)(ws + WS_TOP + l * SZ_TOP); bf16_t* MOP = (bf16_t*)(ws + WS_MOP + l * SZ_MOP);
          const float *bre = P.in[8] + (size_t)l * 16384, *bim = P.in[9] + (size_t)l * 16384, *cre = P.in[10] + (size_t)l * 16384, *cim = P.in[11] + (size_t)l * 16384;
          for (int it = (gw + 64) % NGW; it < 16 * L5; it += NGW) {
              const int g = it >> 5, tau = it & 31, co = lane >> 2, ci0 = 4 * (lane & 3);
              float k4[4] = {0.f, 0.f, 0.f, 0.f};
              float pa_re, pa_im, pf_re, pf_im;
              { const S5Coef c = s5_coef(P.in[5], P.in[6], P.in[7], l, g, lane); s5_apow_fast(c, (float)tau, pa_re, pa_im); s5_f_fast(c, pf_re, pf_im); }
#pragma unroll 8
              for (int p = 0; p < 64; ++p) {
                  const float are = __shfl(pa_re, p), aim = __shfl(pa_im, p), fre = __shfl(pf_re, p), fim = __shfl(pf_im, p);
                  const float cr = cre[(g * 16 + co) * 64 + p], cI = cim[(g * 16 + co) * 64 + p];
                  const float wr_ = cr * are - cI * aim, wi_ = cr * aim + cI * are;
#pragma unroll
                  for (int j = 0; j < 4; ++j) { const float br = bre[(g * 64 + p) * 16 + ci0 + j], bi = bim[(g * 64 + p) * 16 + ci0 + j];
                      const float bbr = fre * br - fim * bi, bbi = fre * bi + fim * br; k4[j] += wr_ * bbr - wi_ * bbi; }
              }
              u32x2v kw; kw.x = pk2(k4[0], k4[1]); kw.y = pk2(k4[2], k4[3]); const u32x2v zw = {0u, 0u};
              bf16_t* Tg = TOP + (size_t)g * NS5 * KS5;
              for (int t = tau; t < L5; ++t) { const int s = t - tau;
                  *(u32x2v*)(Tg + (size_t)(t * 16 + co) * KS5 + s * 16 + ci0) = kw;
                  if (tau) *(u32x2v*)(Tg + (size_t)(s * 16 + co) * KS5 + t * 16 + ci0) = zw; }
          }
#pragma unroll 4
          for (int i = gtid; i < 16 * L5 * 16 * 64; i += NT) { const int p = i & 63, co = (i >> 6) & 15, t = (i >> 10) & 31, g = i >> 15;
              const S5Coef c = s5_coef(P.in[5], P.in[6], P.in[7], l, g, p); float are, aim; s5_apow_fast(c, (float)(t + 1), are, aim);
              const float cr = cre[(g * 16 + co) * 64 + p], cI = cim[(g * 16 + co) * 64 + p];
              bf16_t* row = TOP + ((size_t)g * NS5 + t * 16 + co) * KS5 + NS5;
              row[p] = (bf16_t)f2bf(cr * are - cI * aim); row[64 + p] = (bf16_t)f2bf(-(cr * aim + cI * are)); }
#pragma unroll 4
          for (int i = gtid; i < 16 * 64 * L5 * 16; i += NT) { const int ci = i & 15, s = (i >> 4) & 31, p = (i >> 9) & 63, g = i >> 15;
              const S5Coef c = s5_coef(P.in[5], P.in[6], P.in[7], l, g, p); float are, aim, fre, fim; s5_apow_fast(c, (float)(L5 - 1 - s), are, aim); s5_f_fast(c, fre, fim);
              const float br = bre[(g * 64 + p) * 16 + ci], bi = bim[(g * 64 + p) * 16 + ci]; const float bbr = fre * br - fim * bi, bbi = fre * bi + fim * br;
              bf16_t* base = MOP + (size_t)g * 256 * NS5 + s * 16 + ci;
              base[(size_t)p * NS5] = (bf16_t)f2bf(are * bbr - aim * bbi); base[(size_t)(64 + p) * NS5] = (bf16_t)f2bf(are * bbi + aim * bbr); }
          for (int g = 0; g < 16; ++g) zero_job(MOP + (size_t)g * 256 * NS5 + 128 * NS5, (size_t)128 * NS5 * 2 / 16, gtid, NT);
        }
#undef gw
#undef NGW
#undef gtid
#undef NT
    }
    { float* LUT = (float*)(ws + WS_LUT); const float* tab = P.in[1];
      for (int i = gtid; i < 8 * 132; i += NT) { const int hq = i / 132, dd = i - hq * 132; LUT[i] = tab[t5_bucket(dd < 128 ? dd : 128) * 8 + hq] * LOG2E; } }
}

__device__ __forceinline__ void lru_conv_job(const bf16_t* LX, const float* cw, const float* cb, bf16_t* XC, int gtid, int NT) {
    for (int i = gtid; i < M * 32; i += NT) { const int row = i >> 5, c8 = (i & 31) * 8, t = row & 2047;
        float acc[8];
#pragma unroll
        for (int j = 0; j < 8; ++j) acc[j] = cb[c8 + j];
#pragma unroll
        for (int k = 0; k < 4; ++k) { const int dt = k - 3; if (t + dt >= 0) { float xv[8]; unpack8(*(const v4u*)(LX + (size_t)(row + dt) * 256 + c8), xv);
#pragma unroll
            for (int j = 0; j < 8; ++j) acc[j] += cw[k * 256 + c8 + j] * xv[j]; } }
        *(v4u*)(XC + (size_t)row * 256 + c8) = pack8(acc); }
}
__device__ __forceinline__ void lru_conv_tile(const bf16_t* LX, const float* cw, const float* cb, bf16_t* XC, int row0, int tid) {
    const int c8 = (tid & 31) * 8, r0 = row0 + (tid >> 5) * 16; const bool halo = (r0 & 2047) != 0;
    v4u xr[19];
#pragma unroll
    for (int i = 0; i < 19; ++i) { const v4u z = {0u, 0u, 0u, 0u}; xr[i] = (i >= 3 || halo) ? *(const GAS v4u*)(LX + (size_t)(r0 + i - 3) * 256 + c8) : z; }
    float w[4][8], bias[8];
#pragma unroll
    for (int k = 0; k < 4; ++k)
#pragma unroll
        for (int j = 0; j < 8; ++j) w[k][j] = cw[k * 256 + c8 + j];
#pragma unroll
    for (int j = 0; j < 8; ++j) bias[j] = cb[c8 + j];
#pragma unroll
    for (int i = 0; i < 16; ++i) { float acc[8];
#pragma unroll
        for (int j = 0; j < 8; ++j) acc[j] = bias[j];
#pragma unroll
        for (int k = 0; k < 4; ++k) { float xv[8]; unpack8(xr[i + k], xv);
#pragma unroll
            for (int j = 0; j < 8; ++j) acc[j] += w[k][j] * xv[j]; }
        *(v4u*)(XC + (size_t)(r0 + i) * 256 + c8) = pack8(acc); }
}
__device__ __forceinline__ void s5_scan_job(const float* SLOC, const float* a32, bf16_t* AS5, int gtid, int NT) {
    for (int i = gtid; i < 16 * 16 * 64; i += NT) { const int p = i & 63, gb = i >> 6, g = gb >> 4;
        const float ar = a32[2 * (g * 64 + p)], aI = a32[2 * (g * 64 + p) + 1]; float hr = 0.f, hi = 0.f;
#pragma unroll 1
        for (int c0 = 0; c0 < NCH; c0 += 16) { float sr[16], si[16];
#pragma unroll
            for (int k = 0; k < 16; ++k) { const size_t R = (size_t)gb * 64 + c0 + k; sr[k] = SLOC[R * 128 + p]; si[k] = SLOC[R * 128 + 64 + p]; }
#pragma unroll
            for (int k = 0; k < 16; ++k) { const size_t R = (size_t)gb * 64 + c0 + k;
                AS5[R * KS5 + NS5 + p] = (bf16_t)f2bf(hr); AS5[R * KS5 + NS5 + 64 + p] = (bf16_t)f2bf(hi);
                const float nr = ar * hr - aI * hi + sr[k], ni = ar * hi + aI * hr + si[k]; hr = nr; hi = ni; } } }
}
__device__ __forceinline__ void compress2_job(const float* H1C, const float* w2k, const float* w2v, bf16_t* KCC, bf16_t* VCT, int gtid, int NT) {
    for (int i = gtid; i < 2 * 32 * 128 * 64; i += NT) { const int j = i & 63, n = (i >> 6) & 127, bh = (i >> 13) & 31, kv = i >> 18;
        const float* h = H1C + ((size_t)(kv * 32 + bh) * 128 + n) * 64; const float* w2 = kv ? w2v : w2k; float s = 0.f;
        if (n < 127) {
#pragma unroll 32
            for (int k = 0; k < 64; ++k) s += h[k] * w2[k * 64 + j]; }
        if (kv == 0) KCC[((size_t)bh * 128 + n) * 64 + j] = (bf16_t)f2bf(s); else VCT[((size_t)bh * 64 + j) * 128 + n] = (bf16_t)f2bf(s); }
}
__device__ __forceinline__ void lru_scan_job(const bf16_t* LA, const bf16_t* LB, const bf16_t* LG, bf16_t* MIX, LAS unsigned char* lds, int tid, int vb, int nvb) {
    LAS float* sP = (LAS float*)lds; LAS float* sH = sP + 128 * 32; LAS float* sC = sH + 128 * 32; LAS float* gP = sC + 128 * 32; LAS float* gH = gP + 256; LAS float* gC = gH + 256;
    const int k = tid >> 2, q = tid & 3;
    for (int it = vb; it < NB * 8; it += nvb) { const int b = it >> 3, ch0 = (it & 7) * 32 + q * 8;
        const size_t base = ((size_t)b * 2048 + k * 16) * 256 + ch0;
        float Pp[8], Hh[8];
#pragma unroll
        for (int j = 0; j < 8; ++j) { Pp[j] = 1.f; Hh[j] = 0.f; }
#pragma unroll 1
        for (int hfp = 0; hfp < 2; ++hfp) {
            v4u la[8], lb[8];
#pragma unroll
            for (int i = 0; i < 8; ++i) { la[i] = *(const GAS v4u*)(LA + base + (size_t)(8 * hfp + i) * 256); lb[i] = *(const GAS v4u*)(LB + base + (size_t)(8 * hfp + i) * 256); }
#pragma unroll
            for (int i = 0; i < 8; ++i) { float av[8], bv[8]; unpack8(la[i], av); unpack8(lb[i], bv);
#pragma unroll
                for (int j = 0; j < 8; ++j) { const float a = 1.0f - av[j]; Hh[j] = a * Hh[j] + bv[j]; Pp[j] *= a; } } }
#pragma unroll
        for (int j = 0; j < 8; ++j) { sP[k * 32 + q * 8 + j] = Pp[j]; sH[k * 32 + q * 8 + j] = Hh[j]; }
        __syncthreads();
        if (tid < 256) { const int c = tid & 31, sg = tid >> 5; float p = 1.f, h = 0.f;
#pragma unroll
            for (int kk = 0; kk < 16; ++kk) { const float pp = sP[(sg * 16 + kk) * 32 + c], hh = sH[(sg * 16 + kk) * 32 + c]; h = pp * h + hh; p *= pp; }
            gP[sg * 32 + c] = p; gH[sg * 32 + c] = h; }
        __syncthreads();
        if (tid < 32) { float h = 0.f;
#pragma unroll
            for (int sg = 0; sg < 8; ++sg) { gC[sg * 32 + tid] = h; h = gP[sg * 32 + tid] * h + gH[sg * 32 + tid]; } }
        __syncthreads();
        if (tid < 256) { const int c = tid & 31, sg = tid >> 5; float h = gC[sg * 32 + c];
#pragma unroll
            for (int kk = 0; kk < 16; ++kk) { sC[(sg * 16 + kk) * 32 + c] = h; h = sP[(sg * 16 + kk) * 32 + c] * h + sH[(sg * 16 + kk) * 32 + c]; } }
        __syncthreads();
#pragma unroll
        for (int j = 0; j < 8; ++j) Hh[j] = sC[k * 32 + q * 8 + j];
#pragma unroll 1
        for (int hfp = 0; hfp < 2; ++hfp) {
            v4u la[8], lb[8], lg[8];
#pragma unroll
            for (int i = 0; i < 8; ++i) { const size_t o = base + (size_t)(8 * hfp + i) * 256; la[i] = *(const GAS v4u*)(LA + o); lb[i] = *(const GAS v4u*)(LB + o); lg[i] = *(const GAS v4u*)(LG + o); }
#pragma unroll
            for (int i = 0; i < 8; ++i) { float av[8], bv[8], gv[8], y[8]; unpack8(la[i], av); unpack8(lb[i], bv); unpack8(lg[i], gv);
#pragma unroll
                for (int j = 0; j < 8; ++j) { Hh[j] = (1.0f - av[j]) * Hh[j] + bv[j]; y[j] = Hh[j] * gv[j]; }
                *(v4u*)(MIX + ((size_t)b * 2048 + k * 16 + 8 * hfp + i) * D + 768 + ch0) = pack8(y); } }
        __syncthreads(); }
}
__device__ __forceinline__ void final_norm_job(const bf16_t* XN, float* OUT, const float* RS, const float* gain, int gw, int NGW, int lane) {
    f32x4 gv[4];
#pragma unroll
    for (int j = 0; j < 4; ++j) gv[j] = ((const f32x4*)gain)[64 * j + lane];
    for (int m0 = gw * 4; m0 < M; m0 += NGW * 4) { u32x2v v[4][4]; float s[4];
#pragma unroll
        for (int q = 0; q < 4; ++q) { s[q] = lane < 16 ? RS[(size_t)(m0 + q) * 16 + lane] : 0.f; const u32x2v* hr = (const u32x2v*)(XN + (size_t)(m0 + q) * D) + lane;
#pragma unroll
            for (int j = 0; j < 4; ++j) v[q][j] = hr[64 * j]; }
#pragma unroll
        for (int q = 0; q < 4; ++q) { const float rs = rsqrtf(wave_sum(s[q]) * (1.0f / 1024.0f) + 1e-6f); f32x4* orow = (f32x4*)(OUT + (size_t)(m0 + q) * D) + lane;
#pragma unroll
            for (int j = 0; j < 4; ++j) { f32x4 o; o.x = bf2f(v[q][j].x & 0xffffu); o.y = bf2f(v[q][j].x >> 16); o.z = bf2f(v[q][j].y & 0xffffu); o.w = bf2f(v[q][j].y >> 16); o = o * rs; o = o * gv[j]; orow[64 * j] = o; } } }
}

__device__ __forceinline__ void final_norm_panel(const bf16_t* XN, float* OUT, const float* RS, const float* gain, int m_lo, int wave, int lane) {
    f32x4 gv[4];
#pragma unroll
    for (int j = 0; j < 4; ++j) gv[j] = ((const f32x4*)gain)[64 * j + lane];
    for (int m0 = m_lo + wave * 4; m0 < m_lo + 256; m0 += NWAVES * 4) { u32x2v v[4][4]; float s[4];
#pragma unroll
        for (int q = 0; q < 4; ++q) { s[q] = lane < 16 ? RS[(size_t)(m0 + q) * 16 + lane] : 0.f; const u32x2v* hr = (const u32x2v*)(XN + (size_t)(m0 + q) * D) + lane;
#pragma unroll
            for (int j = 0; j < 4; ++j) v[q][j] = hr[64 * j]; }
#pragma unroll
        for (int q = 0; q < 4; ++q) { const float rs = rsqrtf(wave_sum(s[q]) * (1.0f / 1024.0f) + 1e-6f); f32x4* orow = (f32x4*)(OUT + (size_t)(m0 + q) * D) + lane;
#pragma unroll
            for (int j = 0; j < 4; ++j) { f32x4 o; o.x = bf2f(v[q][j].x & 0xffffu); o.y = bf2f(v[q][j].x >> 16); o.z = bf2f(v[q][j].y & 0xffffu); o.w = bf2f(v[q][j].y >> 16); o = o * rs; o = o * gv[j]; orow[64 * j] = o; } } }
}

__device__ __forceinline__ float wave_max(float v) {
#pragma unroll
    for (int o = 1; o < 64; o <<= 1) v = fmaxf(v, __shfl_xor(v, o));
    return v;
}
struct MbCmp { int t; __device__ __forceinline__ int operator()(int, int n) const { return t - (16 * n + 31); }
               __device__ __forceinline__ int tp(int i) const { return 64 * i; } };
struct MbSel { int t; unsigned ok; unsigned long long selp;
               __device__ __forceinline__ int operator()(int i, int pos) const { return ((ok >> i) & 1u) ? t - pos : -1; }
               __device__ __forceinline__ int tp(int i) const { return 64 * (int)((selp >> (5 * i)) & 31ull); } };
struct MbWin { int t, first; __device__ __forceinline__ int operator()(int, int pos) const { const int d = t - pos; return d < 256 ? d : -1; }
               __device__ __forceinline__ int tp(int i) const { return 64 * (first + i); } };
template <class MB>
__device__ __forceinline__ void nsa_branch(const int ntiles, const bf16_t* Kb, const bf16_t* VTb, const int vpitch, const MB mb, const int hq0,
                                           const LAS float* q_lds, LAS float* P_lds, const LAS float* lut, const int lane, float (&o)[4], float (&inv)[4]) {
    float mx[4] = {-1e30f, -1e30f, -1e30f, -1e30f};
#pragma unroll 1
    for (int i = 0; i < ntiles; ++i) {
        const int pos = mb.tp(i) + lane; const int dist = mb(i, pos);
        const bf16_t* kp = Kb + (size_t)pos * 64; float a0 = 0.f, a1 = 0.f, a2 = 0.f, a3 = 0.f;
#pragma unroll 1
        for (int c = 0; c < 8; ++c) { float kd[8]; unpack8(*(const v4u*)(kp + 8 * c), kd);
#pragma unroll
            for (int j = 0; j < 8; ++j) { const f32x4 q4 = *(const LAS f32x4*)(q_lds + (8 * c + j) * 4); a0 += q4.x * kd[j]; a1 += q4.y * kd[j]; a2 += q4.z * kd[j]; a3 += q4.w * kd[j]; } }
        f32x4 sv = {-1e30f, -1e30f, -1e30f, -1e30f};
        if (dist >= 0) { const int dd = dist < 128 ? dist : 128;
            sv.x = a0 + lut[(hq0 + 0) * 132 + dd]; sv.y = a1 + lut[(hq0 + 1) * 132 + dd]; sv.z = a2 + lut[(hq0 + 2) * 132 + dd]; sv.w = a3 + lut[(hq0 + 3) * 132 + dd];
            mx[0] = fmaxf(mx[0], sv.x); mx[1] = fmaxf(mx[1], sv.y); mx[2] = fmaxf(mx[2], sv.z); mx[3] = fmaxf(mx[3], sv.w); }
        *(LAS f32x4*)(P_lds + (i * 64 + lane) * 4) = sv;
    }
    float sum[4] = {0.f, 0.f, 0.f, 0.f};
#pragma unroll
    for (int g = 0; g < 4; ++g) mx[g] = wave_max(mx[g]);
    asm volatile("s_waitcnt lgkmcnt(0)" ::: "memory");
#pragma unroll 1
    for (int i = 0; i < ntiles; ++i) { f32x4 sv = *(LAS f32x4*)(P_lds + (i * 64 + lane) * 4);
        sv.x = sv.x > -1e29f ? exp2f(sv.x - mx[0]) : 0.f; sv.y = sv.y > -1e29f ? exp2f(sv.y - mx[1]) : 0.f; sv.z = sv.z > -1e29f ? exp2f(sv.z - mx[2]) : 0.f; sv.w = sv.w > -1e29f ? exp2f(sv.w - mx[3]) : 0.f;
        sum[0] += sv.x; sum[1] += sv.y; sum[2] += sv.z; sum[3] += sv.w; *(LAS f32x4*)(P_lds + (i * 64 + lane) * 4) = sv; }
#pragma unroll
    for (int g = 0; g < 4; ++g) { sum[g] = wave_sum(sum[g]); inv[g] = sum[g] > 0.f ? 1.0f / sum[g] : 0.f; }
    asm volatile("s_waitcnt lgkmcnt(0)" ::: "memory");
    const bf16_t* vp = VTb + (size_t)lane * vpitch; float t0 = 0.f, t1 = 0.f, t2 = 0.f, t3 = 0.f;
#pragma unroll 1
    for (int i = 0; i < ntiles; ++i) { const int tp = mb.tp(i);
#pragma unroll 1
        for (int kk = 0; kk < 8; ++kk) { float vv[8]; unpack8(*(const v4u*)(vp + tp + 8 * kk), vv);
#pragma unroll
            for (int j = 0; j < 8; ++j) { const f32x4 p4 = *(const LAS f32x4*)(P_lds + (i * 64 + 8 * kk + j) * 4); t0 += p4.x * vv[j]; t1 += p4.y * vv[j]; t2 += p4.z * vv[j]; t3 += p4.w * vv[j]; } } }
    o[0] += t0 * inv[0]; o[1] += t1 * inv[1]; o[2] += t2 * inv[2]; o[3] += t3 * inv[3];
    asm volatile("s_waitcnt lgkmcnt(0)" ::: "memory");
}
__device__ __forceinline__ void nsa_ref_job(const bf16_t* Q, const bf16_t* KCC, const bf16_t* VCT, const bf16_t* KS, const bf16_t* VST, const bf16_t* KW, const bf16_t* VWT,
                                            const float* GATES, const float* LUT, bf16_t* MIX, LAS unsigned char* lds, int lane, int wave, int gw, int NGW) {
    LAS float* q_lds = (LAS float*)(lds + wave * 16384); LAS float* P_lds = q_lds + 256; LAS float* lut = P_lds + 2048;
    for (int i = lane; i < 8 * 132; i += 64) lut[i] = LUT[i];
    asm volatile("s_waitcnt vmcnt(0) lgkmcnt(0)" ::: "memory");
#pragma unroll 1
    for (int it = gw; it < NB * 2 * SEQ; it += NGW) {
        const int t = it & 2047, bh = it >> 11, b = bh >> 1, h = bh & 1, cur = t >> 6; const size_t m = (size_t)b * 2048 + t;
        { const u32x2v qw = *(const u32x2v*)(Q + m * 512 + h * 256 + lane * 4); const int g = lane >> 4, d0 = (lane & 15) * 4;
          q_lds[(d0 + 0) * 4 + g] = bf2f(qw.x & 0xffffu); q_lds[(d0 + 1) * 4 + g] = bf2f(qw.x >> 16); q_lds[(d0 + 2) * 4 + g] = bf2f(qw.y & 0xffffu); q_lds[(d0 + 3) * 4 + g] = bf2f(qw.y >> 16); }
        const float gate = lane < 12 ? GATES[m * 32 + h * 12 + lane] : 0.f;
        asm volatile("s_waitcnt lgkmcnt(0)" ::: "memory");
        float oc[4] = {0.f, 0.f, 0.f, 0.f}, os[4] = {0.f, 0.f, 0.f, 0.f}, ow[4] = {0.f, 0.f, 0.f, 0.f}, inv[4];
        nsa_branch(2, KCC + (size_t)bh * 128 * 64, VCT + (size_t)bh * 64 * 128, 128, MbCmp{t}, h * 4, q_lds, P_lds, lut, lane, oc, inv);
        float sc = -3e38f;
        if (lane < 32) { float imp = 0.f;
#pragma unroll
            for (int k = -1; k <= 3; ++k) { const int n = 4 * lane + k; if (n >= 0) { const f32x4 p4 = *(const LAS f32x4*)(P_lds + n * 4); imp += (p4.x * inv[0] + p4.y * inv[1]) + (p4.z * inv[2] + p4.w * inv[3]); } }
            const bool avail = 64 * lane <= t, forced = (lane == 0) | (lane == cur) | (lane == cur - 1);
            sc = avail ? imp + (forced ? 1e4f : 0.f) : -1e9f; }
        unsigned long long selp = 0ull; unsigned okm = 0u;
#pragma unroll
        for (int r = 0; r < 8; ++r) { const float mv = wave_max(sc); const unsigned long long bal = __ballot(sc == mv); const int idx = __builtin_amdgcn_readfirstlane(__ffsll((long long)bal) - 1);
            selp |= (unsigned long long)(idx & 31) << (5 * r); if (mv > -5e8f) okm |= 1u << r; if (lane == idx) sc = -3e38f; }
        asm volatile("s_waitcnt lgkmcnt(0)" ::: "memory");
        nsa_branch(8, KS + (size_t)bh * 2048 * 64, VST + (size_t)bh * 64 * 2048, 2048, MbSel{t, okm, selp}, h * 4, q_lds, P_lds, lut, lane, os, inv);
        { const int first = (t > 255 ? t - 255 : 0) >> 6;
          nsa_branch(cur - first + 1, KW + (size_t)bh * 2048 * 64, VWT + (size_t)bh * 64 * 2048, 2048, MbWin{t, first}, h * 4, q_lds, P_lds, lut, lane, ow, inv); }
#pragma unroll
        for (int g = 0; g < 4; ++g) { const float r = __shfl(gate, 3 * g) * oc[g] + __shfl(gate, 3 * g + 1) * os[g] + __shfl(gate, 3 * g + 2) * ow[g];
            MIX[m * D + 256 + (h * 4 + g) * 64 + lane] = (bf16_t)f2bf(r); }
    }
}

namespace nsa {
typedef short bf16x8 __attribute__((ext_vector_type(8)));
typedef float f32x16 __attribute__((ext_vector_type(16)));
constexpr int KROW = 144, VROW = 144, VROWC = 272;
constexpr int L_K = 0, L_V = 2 * 64 * KROW, L_CK = L_V + 2 * 64 * VROW, L_CV = L_CK + 128 * KROW, L_WK = L_CV + 64 * VROWC, L_WV = L_WK + 64 * KROW, L_LUT = L_WV + 64 * VROW, L_IMP = L_LUT + 8 * 132 * 4, L_END = L_IMP + 4 * 64 * 33 * 4;
constexpr int L_SEL = RING_BYTES + 1024, L_GATE = L_SEL + 256, L_END2 = L_GATE + 2 * 64 * 12 * 4;
static_assert(8 * 4096 <= 4 * 64 * 33 * 4 && L_END <= RING_BYTES && L_END2 <= LDS_BYTES && (L_LUT % 16) == 0 && (L_IMP % 16) == 0 && (L_CK % 16) == 0 && (L_CV % 16) == 0 && (L_WK % 16) == 0 && (L_WV % 16) == 0, "nsa LDS map");
__device__ __forceinline__ bf16x8 pk8(const f32x16& p, int o) {
    v4u w; w.x = pg8::cvt_pk_bf16(p[o], p[o + 1]); w.y = pg8::cvt_pk_bf16(p[o + 2], p[o + 3]); w.z = pg8::cvt_pk_bf16(p[o + 4], p[o + 5]); w.w = pg8::cvt_pk_bf16(p[o + 6], p[o + 7]);
    return __builtin_bit_cast(bf16x8, w); }
__device__ __forceinline__ bf16x8 ld_b128(const LAS unsigned char* p) { return *(const LAS bf16x8*)p; }
__device__ __forceinline__ bf16x8 ld_2b64(const LAS unsigned char* p) { u32x2v a = *(const LAS u32x2v*)p, b = *(const LAS u32x2v*)(p + 16); v4u w; w.x = a.x; w.y = a.y; w.z = b.x; w.w = b.y; return __builtin_bit_cast(bf16x8, w); }

__device__ __forceinline__ void step(const int MODE, const LAS unsigned char* KL, const LAS unsigned char* VL, const LAS float* lut_h, const bf16x8 (&qf)[4], const int lane, const int t, const int pos0, const bool selbit, const float bias_far,
                                     const bool first, float& mrun, float& lrun, f32x16 (&O)[2]) {
    const int r32 = lane & 31, hh = lane >> 5;
    const float c0 = (MODE != 3 && !selbit) ? -1e30f : ((MODE == 0 || MODE == 3) ? bias_far - mrun : -mrun);
    f32x16 sc[2];
    { bf16x8 kf[2][4];
#pragma unroll
      for (int kt = 0; kt < 2; ++kt)
#pragma unroll
          for (int s = 0; s < 4; ++s) kf[kt][s] = ld_b128(KL + (32 * kt + r32) * KROW + (16 * s + 8 * hh) * 2);
#ifdef PROBE_NSA_LDS2
      { bf16x8 k2[2][4];
#pragma unroll
        for (int kt = 0; kt < 2; ++kt)
#pragma unroll
            for (int s = 0; s < 4; ++s) { k2[kt][s] = ld_b128(KL + (32 * kt + (r32 ^ 1)) * KROW + (16 * s + 8 * hh) * 2); asm volatile("" :: "v"(k2[kt][s])); } }
#endif
#pragma unroll
      for (int kt = 0; kt < 2; ++kt) {
#pragma unroll
          for (int r = 0; r < 16; ++r) sc[kt][r] = c0; }
      __builtin_amdgcn_s_setprio(1);
#pragma unroll
      for (int kt = 0; kt < 2; ++kt) {
#pragma unroll
          for (int s = 0; s < 4; ++s) sc[kt] = __builtin_amdgcn_mfma_f32_32x32x16_bf16(kf[kt][s], qf[s], sc[kt], 0, 0, 0);
      }
      __builtin_amdgcn_s_setprio(0);
#ifdef PROBE_NSA_MFMA2
      { f32x16 d2[2];
#pragma unroll
        for (int kt = 0; kt < 2; ++kt) {
#pragma unroll
            for (int r = 0; r < 16; ++r) d2[kt][r] = c0;
#pragma unroll
            for (int s = 0; s < 4; ++s) d2[kt] = __builtin_amdgcn_mfma_f32_32x32x16_bf16(kf[kt][s], qf[3 - s], d2[kt], 0, 0, 0);
            asm volatile("" :: "v"(d2[kt][0])); } }
#endif
    }
    bf16x8 vf0[2][2], vf1[2][2];
#pragma unroll
    for (int s2 = 0; s2 < 2; ++s2)
#pragma unroll
        for (int dt = 0; dt < 2; ++dt) vf0[s2][dt] = ld_b128(VL + (32 * dt + r32) * VROW + 32 * s2 + 16 * hh);
    __builtin_amdgcn_sched_barrier(0);
    if (MODE == 1) {
#pragma unroll
        for (int kt = 0; kt < 2; ++kt)
#pragma unroll
            for (int r = 0; r < 16; ++r) { const int dist = t - (pos0 + 32 * kt + (r & 3) + 8 * (r >> 2) + 4 * hh); sc[kt][r] = dist >= 0 ? sc[kt][r] + lut_h[dist < 0 ? 0 : dist] : -1e30f; }
    } else if (MODE == 4) {
#pragma unroll
        for (int kt = 0; kt < 2; ++kt)
#pragma unroll
            for (int r = 0; r < 16; ++r) { const int dist = t - (pos0 + 32 * kt + (r & 3) + 8 * (r >> 2) + 4 * hh); sc[kt][r] += lut_h[dist < 128 ? dist : 128]; }
    } else if (MODE == 3) {
#pragma unroll
        for (int kt = 0; kt < 2; ++kt)
#pragma unroll
            for (int r = 0; r < 16; ++r) { const int dist = t - (pos0 + 32 * kt + (r & 3) + 8 * (r >> 2) + 4 * hh); sc[kt][r] = dist < 256 ? sc[kt][r] : -1e30f; }
    }
    float tm = -1e30f;
#pragma unroll
    for (int kt = 0; kt < 2; ++kt)
#pragma unroll
        for (int r = 0; r < 16; ++r) tm = fmaxf(tm, sc[kt][r]);
    tm = fmaxf(tm, __shfl_xor(tm, 32));
    const float delta = (tm > 8.0f || (first && tm > -1e29f)) ? tm : 0.f;
    if (__any(delta != 0.f)) {
#pragma unroll
        for (int kt = 0; kt < 2; ++kt)
#pragma unroll
            for (int r = 0; r < 16; ++r) sc[kt][r] -= delta; }
    const float alpha = __builtin_amdgcn_exp2f(-delta); mrun += delta; lrun *= alpha;
#pragma unroll
    for (int dt = 0; dt < 2; ++dt) O[dt] = O[dt] * alpha;
    f32x16 pacc;
#pragma unroll
    for (int r = 0; r < 16; ++r) { sc[0][r] = __builtin_amdgcn_exp2f(sc[0][r]); }
    __builtin_amdgcn_sched_barrier(0);
#pragma unroll
    for (int s2 = 0; s2 < 2; ++s2)
#pragma unroll
        for (int dt = 0; dt < 2; ++dt) vf1[s2][dt] = ld_b128(VL + (32 * dt + r32) * VROW + 64 + 32 * s2 + 16 * hh);
    __builtin_amdgcn_sched_barrier(0);
#pragma unroll
    for (int r = 0; r < 16; ++r) { sc[1][r] = __builtin_amdgcn_exp2f(sc[1][r]); }
#ifdef PROBE_NSA_EXP2
#pragma unroll
    for (int r = 0; r < 16; ++r) { float e0 = __builtin_amdgcn_exp2f(sc[0][r] * 0.5f), e1 = __builtin_amdgcn_exp2f(sc[1][r] * 0.5f); asm volatile("" :: "v"(e0), "v"(e1)); }
#endif
    pacc = sc[0] + sc[1];
    lrun += ((pacc[0] + pacc[1]) + (pacc[2] + pacc[3])) + ((pacc[4] + pacc[5]) + (pacc[6] + pacc[7])) + (((pacc[8] + pacc[9]) + (pacc[10] + pacc[11])) + ((pacc[12] + pacc[13]) + (pacc[14] + pacc[15])));
#pragma unroll
    for (int s2 = 0; s2 < 2; ++s2) { const bf16x8 pf = pk8(sc[0], 8 * s2);
#pragma unroll
        for (int dt = 0; dt < 2; ++dt) O[dt] = __builtin_amdgcn_mfma_f32_32x32x16_bf16(vf0[s2][dt], pf, O[dt], 0, 0, 0); }
#pragma unroll
    for (int s2 = 0; s2 < 2; ++s2) { const bf16x8 pf = pk8(sc[1], 8 * s2);
#pragma unroll
        for (int dt = 0; dt < 2; ++dt) O[dt] = __builtin_amdgcn_mfma_f32_32x32x16_bf16(vf1[s2][dt], pf, O[dt], 0, 0, 0); }
}
struct Stage { v4u k, v; };
__device__ __forceinline__ Stage stage_load(const bf16_t* Ksrc, const bf16_t* VTsrc, int vpitch, int tid) { Stage s; const int r = tid >> 3, c = tid & 7;
    s.k = *(const GAS v4u*)(Ksrc + r * 64 + c * 8); s.v = *(const GAS v4u*)(VTsrc + (size_t)r * vpitch + c * 8); return s; }
__device__ __forceinline__ void stage_store(LAS unsigned char* KL, LAS unsigned char* VL, const Stage& s, int tid) { const int r = tid >> 3, c = tid & 7;
    *(LAS v4u*)(KL + r * KROW + c * 16) = s.k; u32x2v a, b; a.x = s.v.x; a.y = s.v.y; b.x = s.v.z; b.y = s.v.w; *(LAS u32x2v*)(VL + r * VROW + (c >> 1) * 32 + (c & 1) * 8) = a; *(LAS u32x2v*)(VL + r * VROW + (c >> 1) * 32 + (c & 1) * 8 + 16) = b; }

__device__ __forceinline__ void job(unsigned char* w, LAS unsigned char* lds, const int tid0, const int wave, const int bid, const int G) {
#define NSA_P(T, off) ((T*)(w + (off)))
    const int g = wave & 3, qh = wave >> 2;
    LAS float* lut = (LAS float*)(lds + L_LUT); LAS float* IMP = (LAS float*)(lds + L_IMP); LAS unsigned* SELM = (LAS unsigned*)(lds + L_SEL);
    for (int i = tid0; i < 8 * 132; i += NTHREADS) lut[i] = NSA_P(const float, WS_LUT)[i];
    __syncthreads();
#pragma unroll 1
    for (int rnd = 0; rnd * G + bid < NB * 2 * 32; ++rnd) {
        const int tid = wave * 64 + pg8::lane_id();
        const int lane = tid & 63, r32 = lane & 31, hh = lane >> 5;
        const int vcu = (G & 7) == 0 ? (bid & 7) * (G >> 3) + (bid >> 3) : bid;
        const int itr = rnd * G + vcu, bh = itr >> 5, qb0 = itr & 31, qb = (rnd & 1) ? 31 - qb0 : qb0, b = bh >> 1, h = bh & 1, hq = h * 4 + g;
        const int t = 64 * qb + 32 * qh + r32; const size_t m = (size_t)b * 2048 + t;
        const LAS float* lut_h = lut + hq * 132;
        LAS float* GL = (LAS float*)(lds + L_GATE + (rnd & 1) * 64 * 12 * 4);
        if (tid < 192) { const int qq = tid / 3, w3 = tid - 3 * qq; *(LAS f32x4*)(GL + qq * 12 + 4 * w3) = *(const GAS f32x4*)(NSA_P(const float, WS_GATES) + ((size_t)b * 2048 + 64 * qb + qq) * 32 + h * 12 + 4 * w3); }
        bf16x8 qf[4];
#pragma unroll
        for (int s = 0; s < 4; ++s) qf[s] = *(const GAS bf16x8*)(NSA_P(const bf16_t, WS_Q) + m * 512 + hq * 64 + 16 * s + 8 * hh);
        f32x16 OT[2];
        const bf16_t* Ksb = NSA_P(const bf16_t, WS_KS) + (size_t)bh * 2048 * 64; const bf16_t* Vsb = NSA_P(const bf16_t, WS_VST) + (size_t)bh * 64 * 2048;
        const bf16_t* Kwb = NSA_P(const bf16_t, WS_KW) + (size_t)bh * 2048 * 64; const bf16_t* Vwb = NSA_P(const bf16_t, WS_VWT) + (size_t)bh * 64 * 2048;
        { const bf16_t* Kc = NSA_P(const bf16_t, WS_KCC) + (size_t)bh * 128 * 64; const bf16_t* Vc = NSA_P(const bf16_t, WS_VCT) + (size_t)bh * 64 * 128;
          v4u ck[2], cv[2];
#pragma unroll
          for (int u = 0; u < 2; ++u) { const int idx = tid + u * NTHREADS; ck[u] = *(const GAS v4u*)(Kc + (idx >> 3) * 64 + (idx & 7) * 8); cv[u] = *(const GAS v4u*)(Vc + (idx >> 4) * 128 + (idx & 15) * 8); }
          const Stage s0 = stage_load(Ksb, Vsb, 2048, tid); const Stage w0 = stage_load(Kwb + (size_t)qb * 64 * 64, Vwb + qb * 64, 2048, tid);
#pragma unroll
          for (int u = 0; u < 2; ++u) { const int idx = tid + u * NTHREADS, r = idx >> 3, c = idx & 7, rv = idx >> 4, cvv = idx & 15; *(LAS v4u*)(lds + L_CK + r * KROW + c * 16) = ck[u];
              u32x2v a, bq; a.x = cv[u].x; a.y = cv[u].y; bq.x = cv[u].z; bq.y = cv[u].w; *(LAS u32x2v*)(lds + L_CV + rv * VROWC + (cvv >> 1) * 32 + (cvv & 1) * 8) = a; *(LAS u32x2v*)(lds + L_CV + rv * VROWC + (cvv >> 1) * 32 + (cvv & 1) * 8 + 16) = bq; }
          stage_store(lds + L_K, lds + L_V, s0, tid); stage_store(lds + L_WK, lds + L_WV, w0, tid);
          __syncthreads();
          f32x16 sc[4]; float mx = -1e30f;
#pragma unroll
          for (int kt = 0; kt < 4; ++kt) {
#pragma unroll
              for (int r = 0; r < 16; ++r) sc[kt][r] = 0.f;
#pragma unroll
              for (int s = 0; s < 4; ++s) sc[kt] = __builtin_amdgcn_mfma_f32_32x32x16_bf16(ld_b128(lds + L_CK + (32 * kt + r32) * KROW + (16 * s + 8 * hh) * 2), qf[s], sc[kt], 0, 0, 0);
#pragma unroll
              for (int r = 0; r < 16; ++r) { const int n = 32 * kt + (r & 3) + 8 * (r >> 2) + 4 * hh, dist = t - (16 * n + 31);
                  sc[kt][r] = dist >= 0 ? sc[kt][r] + lut_h[dist < 128 ? (dist < 0 ? 0 : dist) : 128] : -1e30f; mx = fmaxf(mx, sc[kt][r]); } }
          mx = fmaxf(mx, __shfl_xor(mx, 32)); const float meff = mx < -1e29f ? 1e30f : mx; float ps = 0.f;
#pragma unroll
          for (int kt = 0; kt < 4; ++kt)
#pragma unroll
              for (int r = 0; r < 16; ++r) { const float p = __builtin_amdgcn_exp2f(sc[kt][r] - meff); sc[kt][r] = p; ps += p; }
          ps += __shfl_xor(ps, 32); const float inv = ps > 0.f ? 1.0f / ps : 0.f;
#pragma unroll
          for (int kt = 0; kt < 4; ++kt)
#pragma unroll
              for (int r = 0; r < 16; ++r) sc[kt][r] *= inv;
          { float eprev = 0.f;
#pragma unroll
            for (int i = 0; i < 16; ++i) { const int kt = i >> 2, a = i & 3; const float Gs = (sc[kt][4 * a] + sc[kt][4 * a + 1]) + (sc[kt][4 * a + 2] + sc[kt][4 * a + 3]); const float e = __shfl_xor(sc[kt][4 * a + 3], 32);
                IMP[(g * 64 + 32 * qh + r32) * 33 + 2 * i + hh] = Gs + (hh ? e : eprev); eprev = e; asm volatile("" ::: "memory"); } }
#pragma unroll
          for (int dt = 0; dt < 2; ++dt)
#pragma unroll
              for (int r = 0; r < 16; ++r) OT[dt][r] = 0.f;
#pragma unroll
          for (int kt = 0; kt < 4; ++kt)
#pragma unroll
              for (int s2 = 0; s2 < 2; ++s2) { const bf16x8 pf = pk8(sc[kt], 8 * s2);
#pragma unroll
                  for (int dt = 0; dt < 2; ++dt) OT[dt] = __builtin_amdgcn_mfma_f32_32x32x16_bf16(ld_b128(lds + L_CV + (32 * dt + r32) * VROWC + 64 * kt + 32 * s2 + 16 * hh), pf, OT[dt], 0, 0, 0); }
          const float gate_c = GL[(32 * qh + r32) * 12 + g * 3];
#pragma unroll
          for (int dt = 0; dt < 2; ++dt)
#pragma unroll
              for (int r = 0; r < 16; ++r) OT[dt][r] *= gate_c;
        }
        __syncthreads();
        {
          const int ql = 8 * wave + (lane >> 3), cg4 = 4 * (lane & 7), tq = 64 * qb + ql, cur = qb; float sv[4];
#pragma unroll
          for (int c = 0; c < 4; ++c) { const int j = cg4 + c; const float imp = (IMP[(0 * 64 + ql) * 33 + j] + IMP[(1 * 64 + ql) * 33 + j]) + (IMP[(2 * 64 + ql) * 33 + j] + IMP[(3 * 64 + ql) * 33 + j]);
              const bool avail = 64 * j <= tq, forced = (j == 0) | (j == cur) | (j == cur - 1); sv[c] = avail ? imp + (forced ? 1e4f : 0.f) : -1e9f; }
          unsigned msk = 0u;
#pragma unroll
          for (int rr = 0; rr < 8; ++rr) { float best = sv[0]; int bi = cg4;
#pragma unroll
              for (int c = 1; c < 4; ++c) if (sv[c] > best) { best = sv[c]; bi = cg4 + c; }
#pragma unroll
              for (int o = 1; o < 8; o <<= 1) { const float ov = __shfl_xor(best, o); const int oi = __shfl_xor(bi, o); const bool take = ov > best || (ov == best && oi < bi); best = take ? ov : best; bi = take ? oi : bi; }
              if (best > -5e8f) msk |= 1u << bi;
#pragma unroll
              for (int c = 0; c < 4; ++c) sv[c] = (cg4 + c == bi) ? -3e38f : sv[c]; }
          if ((lane & 7) == 0) SELM[ql] = msk; }
        __syncthreads();
        const unsigned selm = SELM[32 * qh + r32];
        { float mrun = 0.f, lrun = 0.f; f32x16 O[2];
#pragma unroll
          for (int dt = 0; dt < 2; ++dt)
#pragma unroll
              for (int r = 0; r < 16; ++r) O[dt][r] = 0.f;
          const float bias_far = lut_h[128]; int cur = 0;
#pragma unroll 1
          for (int j = 0; j <= qb; ++j) {
              Stage nx; const bool more = j < qb; if (more) nx = stage_load(Ksb + (size_t)(j + 1) * 64 * 64, Vsb + (j + 1) * 64, 2048, tid);
#ifdef PROBE_NSA_GLD2
              if (more) { Stage n2 = stage_load(Ksb + (size_t)(j + 1) * 64 * 64 + 8 * 64, Vsb + (j + 1) * 64 + 2048 * 8, 2048, tid); asm volatile("" :: "v"(n2.k), "v"(n2.v)); }
#endif
#ifdef PROBE_NSA_BAR2
              __syncthreads();
#endif
              const LAS unsigned char* KL = lds + L_K + cur * 64 * KROW; const LAS unsigned char* VL = lds + L_V + cur * 64 * VROW; const bool sb = (selm >> j) & 1u;
              step(j + 3 <= qb ? 0 : (j < qb ? 4 : 1), KL, VL, lut_h, qf, lane, t, 64 * j, sb, bias_far, j == 0, mrun, lrun, O);
              if (more) stage_store(lds + L_K + (cur ^ 1) * 64 * KROW, lds + L_V + (cur ^ 1) * 64 * VROW, nx, tid);
              __syncthreads(); cur ^= 1; }
          lrun += __shfl_xor(lrun, 32); const float sc_ = lrun > 0.f ? GL[(32 * qh + (pg8::lane_id() & 31)) * 12 + g * 3 + 1] / lrun : 0.f;
#pragma unroll
          for (int dt = 0; dt < 2; ++dt)
#pragma unroll
              for (int r = 0; r < 16; ++r) OT[dt][r] += O[dt][r] * sc_; }
        { const int jlo = qb > 4 ? qb - 4 : 0;
          float mrun = 0.f, lrun = 0.f; f32x16 O[2];
#pragma unroll
          for (int dt = 0; dt < 2; ++dt)
#pragma unroll
              for (int r = 0; r < 16; ++r) O[dt][r] = 0.f;
          int cur = 0;
#pragma unroll 1
          for (int j = qb; j >= jlo; --j) {
              Stage nx; const bool more = j > jlo; if (more) nx = stage_load(Kwb + (size_t)(j - 1) * 64 * 64, Vwb + (j - 1) * 64, 2048, tid);
              { const int dl = qb - j; const LAS unsigned char* KL = dl == 0 ? lds + L_WK : lds + L_K + (cur ^ 1) * 64 * KROW; const LAS unsigned char* VL = dl == 0 ? lds + L_WV : lds + L_V + (cur ^ 1) * 64 * VROW;
                step(dl == 0 ? 1 : (dl <= 2 ? 4 : (dl == 3 ? 0 : 3)), KL, VL, lut_h, qf, lane, t, 64 * j, true, lut_h[128], dl == 0, mrun, lrun, O); }
              if (more) stage_store(lds + L_K + cur * 64 * KROW, lds + L_V + cur * 64 * VROW, nx, tid);
              __syncthreads(); cur ^= 1; }
          lrun += __shfl_xor(lrun, 32); const float sc_ = lrun > 0.f ? GL[(32 * qh + (pg8::lane_id() & 31)) * 12 + g * 3 + 2] / lrun : 0.f;
#pragma unroll
          for (int dt = 0; dt < 2; ++dt)
#pragma unroll
              for (int r = 0; r < 16; ++r) OT[dt][r] += O[dt][r] * sc_; }
        { LAS unsigned char* ost = lds + L_IMP + wave * 4096;
          const int l2 = pg8::lane_id(), q2 = l2 & 31, h2 = l2 >> 5;
#pragma unroll
          for (int dt = 0; dt < 2; ++dt)
#pragma unroll
              for (int r = 0; r < 16; r += 2) *(LAS unsigned*)(ost + q2 * 128 + (((32 * dt + 8 * (r >> 2) + 4 * h2 + (r & 3)) * 2) ^ ((q2 & 7) << 4))) = pg8::cvt_pk_bf16(OT[dt][r], OT[dt][r + 1]);
          asm volatile("s_waitcnt lgkmcnt(0)" ::: "memory");
          bf16_t* obase = NSA_P(bf16_t, WS_MIX) + ((size_t)b * 2048 + 64 * qb + 32 * qh) * D + 256 + hq * 64;
#pragma unroll
          for (int i = 0; i < 4; ++i) { const int idx = l2 + 64 * i, qq = idx >> 3, cc = idx & 7; *(v4u*)(obase + (size_t)qq * D + cc * 8) = *(const LAS v4u*)(ost + qq * 128 + ((cc ^ (qq & 7)) << 4)); }
        }
    }
}
#undef NSA_P
}

#ifndef MK_N_LAUNCHES
#define MK_N_LAUNCHES 1
#endif
#ifndef NSA_PAIRED
#define NSA_PAIRED 0
#endif
#ifndef FINAL_FUSED
#define FINAL_FUSED 0
#endif
#ifndef GLU_TAIL
#define GLU_TAIL 1
#endif
#ifndef EN_MASK
#define EN_MASK 0xffff
#endif
#ifdef PROBE_RT_MASK
#define EN(b) (((EN_MASK >> (b)) & 1) && ((args.pad >> (b)) & 1))
#else
#define EN(b) ((EN_MASK >> (b)) & 1)
#endif
#ifndef DUP_MASK
#define DUP_MASK 0
#endif
#define REP(b) for (int rep_ = 0; rep_ < 1 + ((DUP_MASK >> (b)) & 1); ++rep_)
#ifndef NSA_REF
#define NSA_REF 0
#endif
#ifndef PG8_ALIGN_
#define PG8_ALIGN_ true
#endif
#ifndef PG8_SP2_
#define PG8_SP2_ true
#endif
constexpr int N_PHASES = 18;
__global__ void __launch_bounds__(NTHREADS, 2) mk_fwd(Args args) {
    extern __shared__ __attribute__((aligned(16))) unsigned char lds_raw[];
    LAS unsigned char* lds = (LAS unsigned char*)lds_raw;
    volatile LAS unsigned* MISC = (volatile LAS unsigned*)(lds + MISC_OFF);
    const int wave = __builtin_amdgcn_readfirstlane((int)threadIdx.x >> 6), bid = blockIdx.x, G = gridDim.x;
#define tid (wave * 64 + pg8::lane_id())
#define gw (bid * NWAVES + wave)
#define NGW (G * NWAVES)
#define NT (G * NTHREADS)
    const int lo = (MK_N_LAUNCHES == 1) ? 0 : args.ph_lo, hi_all = (MK_N_LAUNCHES == 1) ? N_PHASES : args.ph_hi;
    unsigned char* ws = args.ws;
    for (int u = tid; u < (LDS_BYTES - RING_BYTES) / 4; u += NTHREADS) ((LAS unsigned*)(lds + RING_BYTES))[u] = 0u;
    __syncthreads();
    const int bli = (MK_N_LAUNCHES == 1) ? 0 : args.li;
    XcdBarrier bar; bar.bar = (unsigned*)(ws + WS_CTL) + CW_BAR + bli * XCD_BAR_WORDS; bar.x = 0; bar.st = nullptr;
    if (hi_all - lo > 1) bar = xcd_barrier_post((unsigned*)(ws + WS_CTL) + CW_BAR + bli * XCD_BAR_WORDS, MISC + 8);
#define PH(k) (lo <= (k) && (k) < hi)
#define SEAM(k) do { if (PH(k) && PH((k) + 1)) xcd_barrier(bar); } while (0)
    typedef const float* kptr_t; typedef const __attribute__((address_space(4))) kptr_t* kargs_t;
#define OPQ_WS() unsigned char* w = ws; int bid_p = bid; asm volatile("" : "+s"(w), "+s"(bid_p))
#define OPQ_IN() kargs_t inp = (kargs_t)__builtin_amdgcn_kernarg_segment_ptr(); asm volatile("" : "+s"(inp))
#define WP(T, off) ((T*)(w + (off)))
#define OPQ_TID() int tid_p = tid; asm volatile("" : "+v"(tid_p)); const int lane_p = tid_p & 63, gtid_p = bid * NTHREADS + tid_p; (void)lane_p; (void)gtid_p

#ifndef PREFIX_DUP
#define PREFIX_DUP 0
#endif
#pragma unroll 1
    for (int pass_ = (PREFIX_DUP > 0 && lo == 0 && hi_all == N_PHASES) ? 0 : 1; pass_ < 2; ++pass_) {
    const int hi = pass_ == 0 ? PREFIX_DUP : hi_all;
    if (PH(0) && EN(0)) REP(0) { OPQ_TID(); p0_prologue(args, lds, tid_p, lane_p, wave, bid, G, 3); VM_WAIT(); __syncthreads(); }
    if (PH(0) && ((DUP_MASK >> 16) & 1)) { OPQ_TID(); p0_prologue(args, lds, tid_p, lane_p, wave, bid, G, 1); VM_WAIT(); __syncthreads(); }
    if (PH(0) && ((DUP_MASK >> 17) & 1)) { OPQ_TID(); p0_prologue(args, lds, tid_p, lane_p, wave, bid, G, 2); VM_WAIT(); __syncthreads(); }
    SEAM(0);
#pragma unroll 1
    for (int l = 0; l < NLAYER; ++l) {
        const int pb = 1 + 8 * l;
        if (PH(pb + 0) && EN(1)) REP(1) {
            OPQ_WS();
            pg8::Gemm g{WP(bf16_t, WS_XN), WP(bf16_t, WS_WIN + l * SZ_WIN), D, D}; pg8::StaticOrder S; S.init(M, 2048, G, bid_p);
            { OPQ_TID(); rsl_fill(WP(float, WS_RS), S, lds, tid_p); }
            EpiInProj E{w, lds, 0};
            pg8::gemm_phase<EpiInProj, pg8::StaticOrder, PG8_ALIGN_, PG8_SP2_>(lds, g, S, E, wave);
        }
        SEAM(pb + 0);
#ifdef EXTRA_BARS
        for (int xb_ = 0; xb_ < EXTRA_BARS; ++xb_) xcd_barrier(bar);
#endif
        if (PH(pb + 1)) {
            if (EN(5)) REP(5) { OPQ_WS(); OPQ_IN(); OPQ_TID();
              pg8::Gemm g{WP(bf16_t, WS_XC), WP(bf16_t, WS_WLRU + l * SZ_WLRU), 256, 256}; pg8::StaticOrder S; S.init(M, 512, G > 64 ? G - 32 : G, G > 64 ? (bid_p >= 32 ? bid_p - 32 : 1 << 20) : bid_p);
              { Unit u0; for (int i = 0; S.next(i, u0); ++i) lru_conv_tile(WP(bf16_t, WS_LX), inp[20] + l * 4 * 256, inp[21] + l * 256, WP(bf16_t, WS_XC), u0.pm * BM, tid_p); }
              VM_WAIT(); __syncthreads();
              EpiLruGates E{WP(bf16_t, WS_XC), inp[23] + l * 256, inp[25] + l * 256, WP(float, WS_TAB + l * SZ_TAB) + TB_SP, WP(bf16_t, WS_LA), WP(bf16_t, WS_LB)}; pg8::gemm_phase<EpiLruGates, pg8::StaticOrder, PG8_ALIGN_, PG8_SP2_>(lds, g, S, E, wave); }
            if (EN(2)) REP(2) { OPQ_WS(); OPQ_IN(); pg8::Gemm g{WP(bf16_t, WS_KC), WP(bf16_t, WS_W1 + l * SZ_W1), 1024, 2048}; pg8::GroupOrder S; S.init(2, 16, 1, 1, G, bid_p, 0);
              EpiCompress2 E{WP(float, WS_TAB + l * SZ_TAB) + TB_BIAS1, inp[16] + l * 4096, inp[19] + l * 4096, WP(bf16_t, WS_KCC), WP(bf16_t, WS_VCT)}; pg8::gemm_phase<EpiCompress2, pg8::GroupOrder, false, PG8_SP2_>(lds, g, S, E, wave); }
            if (EN(3)) REP(3) { OPQ_WS(); pg8::Gemm g{WP(bf16_t, WS_AS5), WP(bf16_t, WS_MOP + l * SZ_MOP), KS5, NS5}; pg8::GroupOrder S; S.init(16, 4, 1, 1, G, bid_p, 64);
              EpiS5StateScan E{WP(float, WS_TAB + l * SZ_TAB) + TB_A32, WP(bf16_t, WS_AS5)}; pg8::gemm_phase<EpiS5StateScan, pg8::GroupOrder, false, PG8_SP2_>(lds, g, S, E, wave); }
            if (EN(1)) REP(1) { OPQ_WS(); pg8::Gemm g{WP(bf16_t, WS_XN), WP(bf16_t, WS_WIN + l * SZ_WIN) + (size_t)2048 * D, D, D}; pg8::GroupOrder S; S.init(1, 128, 1, 1, G, bid_p, 128);
              EpiGates E{w}; pg8::gemm_phase<EpiGates, pg8::GroupOrder, true, PG8_SP2_>(lds, g, S, E, wave); }
        }
        SEAM(pb + 1);
        if (PH(pb + 3)) {
            if (EN(8)) REP(8) { OPQ_WS(); OPQ_IN(); OPQ_TID(); pg8::Gemm g{WP(bf16_t, WS_AS5), WP(bf16_t, WS_TOP + l * SZ_TOP), KS5, KS5}; pg8::GroupOrder S; S.init(16, 4, 2, 2, G, bid_p, 0);
              EpiS5Main E{WP(bf16_t, WS_AS5), inp[12] + l * 256, WP(bf16_t, WS_YS)}; pg8::gemm_phase<EpiS5Main, pg8::GroupOrder, true, PG8_SP2_>(lds, g, S, E, wave);
              int nun = 0; { Unit uu; while (S.next(nun, uu)) ++nun; }
              VM_WAIT(); __syncthreads();
              if (tid_p == 0) { __builtin_amdgcn_fence(__ATOMIC_RELEASE, "agent"); VM_WAIT(); __hip_atomic_fetch_add((unsigned*)(w + WS_CTL) + CW_CNT + 64 * l, (unsigned)nun, __ATOMIC_RELAXED, __HIP_MEMORY_SCOPE_AGENT); } }
            __syncthreads();
            if (EN(9)) REP(9) { OPQ_WS(); OPQ_TID(); lru_scan_job(WP(bf16_t, WS_LA), WP(bf16_t, WS_LB), WP(bf16_t, WS_LG), WP(bf16_t, WS_MIX), lds, tid_p, bid >= G / 2 ? bid - G / 2 : NB * 8, G - G / 2); }
            __syncthreads();
#if NSA_REF
            if (EN(10)) REP(10) { OPQ_WS(); OPQ_TID(); nsa_ref_job(WP(bf16_t, WS_Q), WP(bf16_t, WS_KCC), WP(bf16_t, WS_VCT), WP(bf16_t, WS_KS), WP(bf16_t, WS_VST), WP(bf16_t, WS_KW), WP(bf16_t, WS_VWT), WP(float, WS_GATES), WP(float, WS_LUT), WP(bf16_t, WS_MIX), lds, lane_p, wave, gw, NGW); }
#else
#if NSA_PAIRED
            if (EN(10)) REP(10) { OPQ_WS(); OPQ_TID(); nsa2::job(w, lds, tid_p, wave, bid, G); }
#else
            if (EN(10)) REP(10) { OPQ_WS(); OPQ_TID(); nsa::job(w, lds, tid_p, wave, bid, G); }
#endif
#endif
#if GLU_TAIL
            if (EN(11)) REP(11) {
                OPQ_WS(); OPQ_TID();
                if (tid_p == 0) { unsigned sp = 0; while (__hip_atomic_load((unsigned*)(w + WS_CTL) + CW_CNT + 64 * l, __ATOMIC_RELAXED, __HIP_MEMORY_SCOPE_AGENT) < 128u * (1u + rep_)) { __builtin_amdgcn_s_sleep(2); if (++sp > (1u << 22)) break; }
                                  __builtin_amdgcn_fence(__ATOMIC_ACQUIRE, "agent"); VM_WAIT(); }
                __syncthreads();
                pg8::Gemm g{WP(bf16_t, WS_YS), WP(bf16_t, WS_WGLU + l * SZ_WGLU), 256, 256}; pg8::StaticOrder S; S.init(M, 512, G, bid_p);
                EpiGlu E{WP(bf16_t, WS_MIX)}; pg8::gemm_phase<EpiGlu, pg8::StaticOrder, PG8_ALIGN_, PG8_SP2_>(lds, g, S, E, wave); }
#endif
        }
        SEAM(pb + 3);
#if !GLU_TAIL
        if (PH(pb + 4) && EN(11)) REP(11) {
            OPQ_WS(); pg8::Gemm g{WP(bf16_t, WS_YS), WP(bf16_t, WS_WGLU + l * SZ_WGLU), 256, 256}; pg8::StaticOrder S; S.init(M, 512, G, bid_p);
            EpiGlu E{WP(bf16_t, WS_MIX)}; pg8::gemm_phase<EpiGlu, pg8::StaticOrder, PG8_ALIGN_, PG8_SP2_>(lds, g, S, E, wave);
        }
        SEAM(pb + 4);
#endif
        if (PH(pb + 5) && EN(12)) {
            OPQ_WS();
            pg8::Gemm g{WP(bf16_t, WS_MIX), WP(bf16_t, WS_WOUT + l * SZ_WOUT), D, D}; pg8::StaticOrder S; S.init(M, D, G, bid_p);
            EpiResid E{WP(bf16_t, WS_XN), WP(float, WS_RS)}; pg8::gemm_phase<EpiResid, pg8::StaticOrder, PG8_ALIGN_, PG8_SP2_>(lds, g, S, E, wave);
        }
        SEAM(pb + 5);
        if (PH(pb + 6) && EN(13)) REP(13) {
            OPQ_WS(); pg8::Gemm g{WP(bf16_t, WS_XN), WP(bf16_t, WS_WGU + l * SZ_WGU), D, D}; pg8::StaticOrder S; S.init(M, NGU, G, bid_p);
            { OPQ_TID(); rsl_fill(WP(float, WS_RS), S, lds, tid_p); }
            EpiGateUp E{lds, WP(bf16_t, WS_HMID), 0}; pg8::gemm_phase<EpiGateUp, pg8::StaticOrder, PG8_ALIGN_, PG8_SP2_>(lds, g, S, E, wave);
        }
#ifdef PROBE_GU_RAW
        if (PH(pb + 6)) {
            OPQ_WS(); pg8::Gemm g{WP(bf16_t, WS_XN), WP(bf16_t, WS_WGU + l * SZ_WGU), D, D}; pg8::StaticOrder S; S.init(M, NGU, G, bid_p);
            EpiProbeRaw E{WP(bf16_t, WS_MIXR + 180 * MiB)}; pg8::gemm_phase<EpiProbeRaw, pg8::StaticOrder, PG8_ALIGN_, PG8_SP2_>(lds, g, S, E, wave);
        }
#endif
        SEAM(pb + 6);
        if (PH(pb + 7) && EN(14)) {
            OPQ_WS();
            pg8::Gemm g{WP(bf16_t, WS_HMID), WP(bf16_t, WS_WD + l * SZ_WD), DFF, DFF}; pg8::StaticOrder S; S.init(M, D, G, bid_p);
            EpiResid E{WP(bf16_t, WS_XN), WP(float, WS_RS)}; pg8::gemm_phase<EpiResid, pg8::StaticOrder, PG8_ALIGN_, PG8_SP2_>(lds, g, S, E, wave);
#if FINAL_FUSED
            if (l == NLAYER - 1) {
                OPQ_IN(); OPQ_TID(); float* Hres = args.out; asm volatile("" : "+s"(Hres));
                Unit uu;
#pragma unroll 1
                for (int i = 0; S.next(i, uu); ++i) {
                    VM_WAIT(); __syncthreads();
                    if (tid_p == 0) { __builtin_amdgcn_fence(__ATOMIC_RELEASE, "agent"); VM_WAIT();
                                      MISC[16] = __hip_atomic_fetch_add((unsigned*)(w + WS_CTL) + CW_PANEL + uu.pm, 1u, __ATOMIC_RELAXED, __HIP_MEMORY_SCOPE_AGENT); }
                    __syncthreads();
                    const bool last = MISC[16] == 3u;
                    if (last) { if (tid_p == 0) { __builtin_amdgcn_fence(__ATOMIC_ACQUIRE, "agent"); VM_WAIT(); }
                                __syncthreads();
                                final_norm_panel(WP(bf16_t, WS_XN), Hres, WP(float, WS_RS), inp[31], uu.pm * BM, wave, lane_p); }
                    __syncthreads(); }
            }
#endif
        }
        SEAM(pb + 7);
    }
    if (PH(17) && EN(15) && !FINAL_FUSED) { OPQ_WS(); OPQ_IN(); float* Hres = args.out; asm volatile("" : "+s"(Hres)); OPQ_TID(); final_norm_job(WP(bf16_t, WS_XN), Hres, WP(float, WS_RS), inp[31], gw, NGW, lane_p); }
    if (pass_ == 0) xcd_barrier(bar);
    }
#undef PH
#undef tid
#undef gw
#undef NGW
#undef NT
#undef SEAM
}

extern "C" void kernel_launch(void* const* d_in, const int* in_sizes, int n_in, void* d_out, int out_size, void* d_ws, size_t ws_size, hipStream_t stream) {
    static int grid = 0;
    if (grid == 0) {
        if (n_in != 32 || in_sizes[0] != M * D || out_size != M * D || ws_size < WS_END) { fprintf(stderr, "kernel_launch: shape/workspace mismatch (n_in %d, in0 %d, out %d, ws %zu, need %zu)\n", n_in, n_in > 0 ? in_sizes[0] : -1, out_size, ws_size, (size_t)WS_END); grid = -1; return; }
        int dev = 0, cus = 0, per_cu = 0;
        if (hipGetDevice(&dev) != hipSuccess || hipDeviceGetAttribute(&cus, hipDeviceAttributeMultiprocessorCount, dev) != hipSuccess) { grid = -1; return; }
        if (hipFuncSetAttribute((const void*)mk_fwd, hipFuncAttributeMaxDynamicSharedMemorySize, LDS_BYTES) != hipSuccess) { fprintf(stderr, "kernel_launch: hipFuncSetAttribute failed\n"); grid = -1; return; }
        if (hipOccupancyMaxActiveBlocksPerMultiprocessor(&per_cu, (const void*)mk_fwd, NTHREADS, LDS_BYTES) != hipSuccess || per_cu < 1) { fprintf(stderr, "kernel_launch: occupancy query says %d blocks per CU\n", per_cu); (void)hipGetLastError(); grid = -1; return; }
        grid = cus;
    }
    if (grid < 0) return;
    (void)hipMemsetAsync((char*)d_ws + WS_CTL, 0, CTL_ZERO_BYTES, stream);
    Args a{};
    for (int i = 0; i < 32; ++i) a.in[i] = (const float*)d_in[i];
    a.out = (float*)d_out; a.ws = (unsigned char*)d_ws;
    if (MK_N_LAUNCHES == 1) { a.ph_lo = 0; a.ph_hi = N_PHASES; hipLaunchKernelGGL(mk_fwd, dim3(grid), dim3(NTHREADS), LDS_BYTES, stream, a); }
#ifdef HOST_EXTRA_LO
    else if (MK_N_LAUNCHES == 2) {
        a.ph_lo = 0; a.ph_hi = N_PHASES; a.li = 0; a.pad = 0xffff; hipLaunchKernelGGL(mk_fwd, dim3(grid), dim3(NTHREADS), LDS_BYTES, stream, a);
        a.ph_lo = HOST_EXTRA_LO; a.ph_hi = HOST_EXTRA_HI; a.li = 1; a.pad = HOST_EXTRA_MASK; hipLaunchKernelGGL(mk_fwd, dim3(grid), dim3(NTHREADS), LDS_BYTES, stream, a); }
#endif
#ifdef HOST_PREFIX_DUP
    else if (MK_N_LAUNCHES == 2) {
        a.ph_lo = 0; a.ph_hi = HOST_PREFIX_DUP; a.li = 0; hipLaunchKernelGGL(mk_fwd, dim3(grid), dim3(NTHREADS), LDS_BYTES, stream, a);
        a.ph_lo = 0; a.ph_hi = N_PHASES; a.li = 1; hipLaunchKernelGGL(mk_fwd, dim3(grid), dim3(NTHREADS), LDS_BYTES, stream, a); }
#endif
    else for (int p = 0; p < N_PHASES; ++p) { a.ph_lo = p; a.ph_hi = p + 1; hipLaunchKernelGGL(mk_fwd, dim3(grid), dim3(NTHREADS), LDS_BYTES, stream, a); }
}
```

```cpp
#include <hip/hip_runtime.h>
#include <cstdio>
#include <cstdint>
namespace pg8 {
#define PG8_LAS __attribute__((address_space(3)))
typedef unsigned short bf16_t;
typedef short bf16x8 __attribute__((ext_vector_type(8)));
typedef float f32x4 __attribute__((ext_vector_type(4)));
typedef unsigned u32x4 __attribute__((ext_vector_type(4)));
constexpr int BM = 256, BK = 64, HALF = 128, HTB = HALF * BK * 2  , STAGE_BYTES = 8 * HTB, NXCD = 8, WGM = 8;

__host__ __device__ __forceinline__ int lds_byte(int r, int c) { const int st = (r >> 4) * 2 + (c >> 5), rr = r & 15, cc = c & 31, ob = rr * 64 + cc * 2; return st * 1024 + (ob ^ (((ob >> 9) & 1) << 5)); }
__host__ __device__ __forceinline__ void stage_rc(int b, int& R, int& C) { const int st = b / 1024, sb = b % 1024, swz = sb ^ (((sb >> 9) & 1) << 5); R = (st >> 1) * 16 + swz / 64; C = (st & 1) * 32 + (swz % 64) / 2; }
__host__ __device__ __forceinline__ int perm32(int rho) { const int n = rho >> 4, i = rho & 15; return 8 * (i >> 2) + 4 * n + (i & 3); }


struct Unit { int pm, pn; };
struct Gemm { const bf16_t* A; const bf16_t* Bt; int lda, K; };

struct StaticOrder {
    int nM, nN, nwg, G, c;
    __host__ __device__ __forceinline__ void init(int M, int N, int G_, int c_) { nM = M / BM; nN = N / BM; nwg = nM * nN; G = G_; c = c_; }
    __host__ __device__ __forceinline__ bool next(int i, Unit& u) const {
        const long L = (long)i * G + c; if (L >= nwg) return false;
        int wgid = (int)L; { const int q = nwg / NXCD, r = nwg % NXCD, xcd = wgid % NXCD, off = wgid / NXCD; wgid = (xcd < r ? xcd * (q + 1) : r * (q + 1) + (xcd - r) * q) + off; }
        const int nig = WGM * nN, gid = wgid / nig, fm = gid * WGM, gsz = (nM - fm) < WGM ? (nM - fm) : WGM;
        u.pm = fm + ((wgid % nig) % gsz); u.pn = (wgid % nig) / gsz; return true;
    }
    __device__ __forceinline__ void a_ready(const Unit&) const {}
    __device__ __forceinline__ void done(const Unit&) const {}
};
struct GroupOrder {
    int mt, nt, ntb, total, G, c;
    __host__ __device__ __forceinline__ void init(int ng, int mt_, int nt_, int ntb_, int G_, int blk, int off) { mt = mt_; nt = nt_; ntb = ntb_; total = ng * mt_ * nt_; G = G_; c = (blk + G_ - (off % G_)) % G_; }
    __host__ __device__ __forceinline__ bool next(int i, Unit& u) const {
        const long L = (long)i * G + c; if (L >= total) return false;
        const int per = mt * nt, grp = (int)L / per, r = (int)L % per; u.pm = grp * mt + r / nt; u.pn = grp * ntb + r % nt; return true;
    }
    __device__ __forceinline__ void a_ready(const Unit&) const {}
    __device__ __forceinline__ void done(const Unit&) const {}
};
typedef float f32x2_cv __attribute__((ext_vector_type(2))); typedef __bf16 bf16x2_cv __attribute__((ext_vector_type(2)));
__device__ __forceinline__ unsigned cvt_pk_bf16(float lo, float hi) { const f32x2_cv v = {lo, hi}; const bf16x2_cv b = __builtin_convertvector(v, bf16x2_cv); return __builtin_bit_cast(unsigned, b); }
__device__ __forceinline__ int lane_id() { int l; asm volatile("v_mbcnt_lo_u32_b32 %0, -1, 0\n\tv_mbcnt_hi_u32_b32 %0, -1, %0" : "=v"(l)); return l; }
template <class Epi, class Sched, bool ALIGN_EPI = false, bool SP2 = false>
__device__ __forceinline__ void gemm_phase(PG8_LAS unsigned char* lds, const Gemm g, const Sched& S, const Epi& E, const int wave_in) {
    int tid_o = wave_in * 64 + lane_id(); asm volatile("" : "+v"(tid_o));
    const int tid = tid_o, wid = __builtin_amdgcn_readfirstlane(tid >> 6), lane = tid & 63, wr = wid >> 2, wc = wid & 3, fr = lane & 15, fq = lane >> 4;
    const int K = g.K, lda = g.lda, nt = K / BK;
    unsigned voffA[2], voffB[2];
#pragma unroll
    for (int i = 0; i < 2; ++i) { int R, C; stage_rc(tid * 16 + i * 8192, R, C); const int Rb = Epi::PERM ? ((R & ~31) + perm32(R & 31)) : R;
        voffA[i] = (unsigned)(R * lda + C) * 2u; voffB[i] = (unsigned)(Rb * K + C) * 2u; }
    const size_t kstep = (size_t)(BK * 2);
    const size_t hstep = (size_t)HALF * K * 2;
    const size_t tstep = 2 * hstep; const size_t hstepA = (size_t)HALF * lda * 2, tstepA = 2 * hstepA;
    const unsigned ldsw = (unsigned)wid * 1024u;
    const int aoff = lds_byte(wr * 64 + fr, fq * 8), boff = lds_byte(wc * 32 + fr, fq * 8);
#define PG8_SA(b, h) (((b) * 2 + (h)) * HTB)
#define PG8_SB(b, h) ((4 + (b) * 2 + (h)) * HTB)
#define PG8_STAGE(bufoff, gbase, voff) do { _Pragma("unroll") for (int _i = 0; _i < 2; ++_i) \
        __builtin_amdgcn_global_load_lds((const unsigned*)((const char*)(gbase) + (voff)[_i]), (PG8_LAS unsigned*)(lds + (bufoff) + ldsw + _i * 8192), 16, 0, 0); } while (0)
#define PG8_LDA(dst, b, h) do { _Pragma("unroll") for (int m = 0; m < 4; ++m) _Pragma("unroll") for (int k = 0; k < 2; ++k) dst[m][k] = *(const PG8_LAS bf16x8*)(lds + PG8_SA(b, h) + aoff + m * 2048 + k * 1024); } while (0)
#define PG8_LDB(dst, b, h) do { _Pragma("unroll") for (int n = 0; n < 2; ++n) _Pragma("unroll") for (int k = 0; k < 2; ++k) dst[n][k] = *(const PG8_LAS bf16x8*)(lds + PG8_SB(b, h) + boff + n * 2048 + k * 1024); } while (0)
#define PG8_MMA(ai, bj, At, Bt) do { __builtin_amdgcn_s_setprio(1); _Pragma("unroll") for (int m = 0; m < 4; ++m) _Pragma("unroll") for (int n = 0; n < 2; ++n) _Pragma("unroll") for (int k = 0; k < 2; ++k) \
        acc[ai][bj][m][n] = __builtin_amdgcn_mfma_f32_16x16x32_bf16(Bt[n][k], At[m][k], acc[ai][bj][m][n], 0, 0, 0); __builtin_amdgcn_s_setprio(0); } while (0)
#define PG8_WAIT_V(n) asm volatile("s_waitcnt vmcnt(" #n ")" ::: "memory")
#define PG8_WAIT_L(n) asm volatile("s_waitcnt lgkmcnt(" #n ")" ::: "memory")
#define PG8_BAR __builtin_amdgcn_s_barrier()
#define PG8_SCHED __builtin_amdgcn_sched_barrier(0)
    Unit cur, nxt; int ui = 0;
    if (!S.next(0, cur)) return;
    f32x4 acc[2][2][4][2];
#pragma unroll
    for (int a = 0; a < 2; ++a)
#pragma unroll
        for (int b = 0; b < 2; ++b)
#pragma unroll
            for (int m = 0; m < 4; ++m)
#pragma unroll
                for (int n = 0; n < 2; ++n) acc[a][b][m][n] = (f32x4){0.f, 0.f, 0.f, 0.f};
    bf16x8 At[4][2], B0[2][2], B1[2][2];
    const char* cA = (const char*)g.A + (size_t)cur.pm * tstepA; const char* cB = (const char*)g.Bt + (size_t)cur.pn * tstep;
    S.a_ready(cur);
    if constexpr (SP2) {
        PG8_STAGE(PG8_SB(0, 0), cB, voffB); PG8_STAGE(PG8_SB(0, 1), cB + hstep, voffB); PG8_STAGE(PG8_SA(0, 0), cA, voffA); PG8_STAGE(PG8_SA(0, 1), cA + hstepA, voffA);
        if (wr == 1) PG8_BAR;
        PG8_WAIT_V(2); PG8_BAR;
        PG8_STAGE(PG8_SB(1, 0), cB + kstep, voffB); PG8_STAGE(PG8_SA(1, 0), cA + kstep, voffA); PG8_STAGE(PG8_SB(1, 1), cB + hstep + kstep, voffB);
        PG8_WAIT_V(6); PG8_BAR;
    } else {
        PG8_STAGE(PG8_SB(0, 0), cB, voffB); PG8_STAGE(PG8_SA(0, 0), cA, voffA); PG8_STAGE(PG8_SB(0, 1), cB + hstep, voffB); PG8_STAGE(PG8_SA(0, 1), cA + hstepA, voffA);
        if (wr == 1) PG8_BAR;
        PG8_WAIT_V(4); PG8_BAR;
        PG8_STAGE(PG8_SB(1, 0), cB + kstep, voffB); PG8_STAGE(PG8_SA(1, 0), cA + kstep, voffA); PG8_STAGE(PG8_SB(1, 1), cB + hstep + kstep, voffB);
        PG8_WAIT_V(6); PG8_BAR;
    }
    for (;;) {
        const bool has_next = S.next(ui + 1, nxt);
        const char* nA = has_next ? (const char*)g.A + (size_t)nxt.pm * tstepA : cA; const char* nB = has_next ? (const char*)g.Bt + (size_t)nxt.pn * tstep : cB;
        _Pragma("unroll 1") for (int t = 0; t < nt; t += 2) {
            const bool last = (t == nt - 2);
            const char* a1 = cA + (size_t)(t + 1) * kstep;
            const char* a2 = last ? nA : cA + (size_t)(t + 2) * kstep; const char* b2 = last ? nB : cB + (size_t)(t + 2) * kstep;
            const char* a3 = a2 + kstep; const char* b3 = b2 + kstep;
            if (last && has_next) S.a_ready(nxt);
            if constexpr (SP2) {
            PG8_LDB(B0, 0, 0); PG8_LDB(B1, 0, 1); PG8_SCHED; PG8_LDA(At, 0, 0); PG8_STAGE(PG8_SA(1, 1), a1 + hstepA, voffA);
            PG8_WAIT_V(8); PG8_WAIT_L(0); PG8_BAR; PG8_MMA(0, 0, At, B0); PG8_MMA(0, 1, At, B1); PG8_BAR; PG8_SCHED;
            PG8_LDA(At, 0, 1); PG8_STAGE(PG8_SB(0, 0), b2, voffB); PG8_STAGE(PG8_SB(0, 1), b2 + hstep, voffB); PG8_STAGE(PG8_SA(0, 0), a2, voffA);
            PG8_WAIT_V(8); PG8_WAIT_L(0); PG8_BAR; PG8_MMA(1, 0, At, B0); PG8_MMA(1, 1, At, B1); PG8_BAR; PG8_SCHED;
            PG8_LDB(B0, 1, 0); PG8_LDB(B1, 1, 1); PG8_SCHED; PG8_LDA(At, 1, 0); PG8_STAGE(PG8_SA(0, 1), a2 + hstepA, voffA);
            PG8_WAIT_V(8); PG8_WAIT_L(0); PG8_BAR; PG8_MMA(0, 0, At, B0); PG8_MMA(0, 1, At, B1); PG8_BAR; PG8_SCHED;
            PG8_LDA(At, 1, 1); PG8_STAGE(PG8_SB(1, 0), b3, voffB); PG8_STAGE(PG8_SB(1, 1), b3 + hstep, voffB); PG8_STAGE(PG8_SA(1, 0), a3, voffA);
            PG8_WAIT_V(8); PG8_WAIT_L(0); PG8_BAR; PG8_MMA(1, 0, At, B0); PG8_MMA(1, 1, At, B1); PG8_BAR; PG8_SCHED;
            } else {
            PG8_LDB(B0, 0, 0); PG8_SCHED; PG8_LDA(At, 0, 0); PG8_STAGE(PG8_SA(1, 1), a1 + hstepA, voffA);
            PG8_WAIT_L(8); PG8_BAR; PG8_WAIT_L(0); PG8_MMA(0, 0, At, B0); PG8_BAR; PG8_SCHED;
            PG8_LDB(B1, 0, 1); PG8_STAGE(PG8_SB(0, 0), b2, voffB);
            PG8_BAR; PG8_WAIT_L(0); PG8_MMA(0, 1, At, B1); PG8_BAR;
            PG8_LDA(At, 0, 1); PG8_STAGE(PG8_SA(0, 0), a2, voffA);
            PG8_BAR; PG8_WAIT_L(0); PG8_MMA(1, 0, At, B0); PG8_BAR; PG8_SCHED;
            PG8_STAGE(PG8_SB(0, 1), b2 + hstep, voffB);
            PG8_WAIT_V(6); PG8_BAR; PG8_MMA(1, 1, At, B1); PG8_BAR;
            PG8_LDB(B0, 1, 0); PG8_SCHED; PG8_LDA(At, 1, 0); PG8_STAGE(PG8_SA(0, 1), a2 + hstepA, voffA);
            PG8_WAIT_L(8); PG8_BAR; PG8_WAIT_L(0); PG8_MMA(0, 0, At, B0); PG8_BAR; PG8_SCHED;
            PG8_LDB(B1, 1, 1); PG8_STAGE(PG8_SB(1, 0), b3, voffB);
            PG8_BAR; PG8_WAIT_L(0); PG8_MMA(0, 1, At, B1); PG8_BAR;
            PG8_LDA(At, 1, 1); PG8_STAGE(PG8_SA(1, 0), a3, voffA);
            PG8_BAR; PG8_WAIT_L(0); PG8_MMA(1, 0, At, B0); PG8_BAR; PG8_SCHED;
            PG8_STAGE(PG8_SB(1, 1), b3 + hstep, voffB);
            PG8_WAIT_V(6); PG8_BAR; PG8_MMA(1, 1, At, B1); PG8_BAR;
            }
        }
        if constexpr (ALIGN_EPI) { if (wr == 0) PG8_BAR; }
        if constexpr (!Epi::AFTER_DRAIN) { { const int l2_ = lane_id(); E(acc, cur, wr, wc, l2_ & 15, l2_ >> 4); } S.done(cur); }
        if (!has_next) break;
#pragma unroll
        for (int a = 0; a < 2; ++a)
#pragma unroll
            for (int b = 0; b < 2; ++b)
#pragma unroll
                for (int m = 0; m < 4; ++m)
#pragma unroll
                    for (int n = 0; n < 2; ++n) acc[a][b][m][n] = (f32x4){0.f, 0.f, 0.f, 0.f};
        cur = nxt; cA = nA; cB = nB; ++ui;
        if constexpr (ALIGN_EPI) { if (wr == 1) PG8_BAR; }
    }
    PG8_WAIT_V(0);
    if constexpr (!ALIGN_EPI) { if (wr == 0) PG8_BAR; }
    PG8_BAR;
    if constexpr (Epi::AFTER_DRAIN) { E.fused(acc, cur, wr, wc, fr, fq, lds, wid, lane); S.done(cur); }
#undef PG8_SA
#undef PG8_SB
#undef PG8_STAGE
#undef PG8_LDA
#undef PG8_LDB
#undef PG8_MMA
#undef PG8_WAIT_V
#undef PG8_WAIT_L
#undef PG8_BAR
#undef PG8_SCHED
}
}
#define GAS __attribute__((address_space(1)))
#define LAS __attribute__((address_space(3)))
typedef unsigned short bf16;
typedef unsigned v4u __attribute__((ext_vector_type(4)));
typedef float f32x4 __attribute__((ext_vector_type(4)));
typedef short bf16x8 __attribute__((ext_vector_type(8)));
typedef GAS unsigned gu32;
typedef GAS unsigned long long gu64;
#define RLX_AGENT __ATOMIC_RELAXED, __HIP_MEMORY_SCOPE_AGENT
#define LDS_WAIT() asm volatile("s_waitcnt lgkmcnt(0)" ::: "memory")
#define VM_WAIT() asm volatile("s_waitcnt vmcnt(0)" ::: "memory")
__device__ __forceinline__ unsigned long long rt() { return __builtin_amdgcn_s_memrealtime(); }
__device__ __forceinline__ unsigned f2bf(float f) { unsigned u = __builtin_bit_cast(unsigned, f); return (u + 0x7fffu + ((u >> 16) & 1u)) >> 16; }
__device__ __forceinline__ unsigned pk2(float lo, float hi) { return f2bf(lo) | (f2bf(hi) << 16); }

#define XB_TMO      128
#define XB_XCNT(j)  (256  + 64 * (j))
#define XB_XSUB(j)  (1280 + 64 * (j))
#define XB_XGEN(j)  (2304 + 64 * (j))
#define XB_TOP      3328
#define XB_TOPGEN   3392
#define XCD_BAR_WORDS 3456
#define XB_SPIN_CAP (1u << 18)

__device__ __forceinline__ unsigned xb_ld(unsigned* p)              { return __hip_atomic_load(p, __ATOMIC_RELAXED, __HIP_MEMORY_SCOPE_AGENT); }
__device__ __forceinline__ unsigned xb_add(unsigned* p, unsigned v) { return __hip_atomic_fetch_add(p, v, __ATOMIC_RELAXED, __HIP_MEMORY_SCOPE_AGENT); }
__device__ __forceinline__ unsigned xb_xcc_id() { return (unsigned)__builtin_amdgcn_s_getreg((3 << 11) | 20) & 0xFu; }
#define XB_SPIN(cond, bar) do { unsigned _sp = 0; while (cond) { __builtin_amdgcn_s_sleep(1); \
    if ((++_sp & 255u) == 0u) { if (xb_ld(&(bar)[XB_TMO])) break; if (_sp > XB_SPIN_CAP) { atomicAdd(&(bar)[XB_TMO], 1u); break; } } } } while (0)

struct XcdBarrier {
    unsigned* bar; unsigned x;
    volatile LAS unsigned* st;
};

__device__ __forceinline__ XcdBarrier xcd_barrier_post(unsigned* bar, volatile LAS unsigned* st) {
    XcdBarrier b; b.bar = bar; b.x = xb_xcc_id(); b.st = st;
    if (threadIdx.x == 0) (void)xb_add(&bar[XB_XCNT(b.x)], 1u);
    return b;
}
__device__ __forceinline__ void xcd_barrier_complete(unsigned* bar, unsigned x, unsigned& nloc, unsigned& nx) {
    const unsigned G = gridDim.x * gridDim.y * gridDim.z;
    unsigned sum, cnt, mine, sp = 0u;
    for (;;) {
        sum = 0u; cnt = 0u; mine = 0u;
#pragma unroll
        for (unsigned j = 0; j < 16; ++j) { const unsigned c = xb_ld(&bar[XB_XCNT(j)]); sum += c; cnt += (c > 0u) ? 1u : 0u; mine = (j == x) ? c : mine; }
        if (sum == G) break;
        __builtin_amdgcn_s_sleep(1);
        if ((++sp & 255u) == 0u) { if (xb_ld(&bar[XB_TMO])) break; if (sp > XB_SPIN_CAP) { atomicAdd(&bar[XB_TMO], 1u); break; } }
    }
    nloc = mine > 0u ? mine : 1u; nx = cnt > 0u ? cnt : 1u;
}

__device__ __forceinline__ void xcd_barrier(const XcdBarrier& b) {
    asm volatile("s_waitcnt vmcnt(0)" ::: "memory");
    __syncthreads();
    if (threadIdx.x == 0) {
        unsigned* bar = b.bar;
        __builtin_amdgcn_s_waitcnt(0);
        unsigned nloc = b.st[0], nx = b.st[1];
        if (nloc == 0u) { xcd_barrier_complete(bar, b.x, nloc, nx); b.st[0] = nloc; b.st[1] = nx; }
        const unsigned old = xb_add(&bar[XB_XSUB(b.x)], 1u);
        const unsigned gen = old / nloc;
        if (old + 1u == (gen + 1u) * nloc) {
            __builtin_amdgcn_fence(__ATOMIC_RELEASE, "agent");
            asm volatile("s_waitcnt vmcnt(0)" ::: "memory");
            const unsigned og = xb_add(&bar[XB_TOP], 1u);
            const unsigned tg = og / nx;
            if (og + 1u == (tg + 1u) * nx) xb_add(&bar[XB_TOPGEN], 1u);
            else XB_SPIN(xb_ld(&bar[XB_TOPGEN]) == tg, bar);
            __builtin_amdgcn_fence(__ATOMIC_ACQUIRE, "agent");
            xb_add(&bar[XB_XGEN(b.x)], 1u);
            asm volatile("s_waitcnt vmcnt(0)" ::: "memory");
        } else {
            XB_SPIN(xb_ld(&bar[XB_XGEN(b.x)]) == gen, bar);
            __builtin_amdgcn_fence(__ATOMIC_ACQUIRE, "agent");
            asm volatile("s_waitcnt vmcnt(0)" ::: "memory");
        }
    }
    __syncthreads();
}

using pg8::bf16_t; using pg8::Unit; using pg8::BM; using pg8::HALF;
typedef unsigned u32x2v __attribute__((ext_vector_type(2)));
constexpr int NB = 16, SEQ = 2048, M = NB * SEQ, D = 1024, NIN = 2304, NINV = 2072, DFF = 2816, NGU = 2 * DFF, NLAYER = 2;
constexpr int L5 = 32, NCH = SEQ / L5, NS5 = 16 * L5, KS5 = NS5 + 128;
constexpr float LOG2E = 1.4426950408889634f, QSCALE = 0.125f * LOG2E;
constexpr int NWAVES = 8, NTHREADS = 512;
constexpr size_t MiB = 1u << 20;
constexpr size_t WS_CTL = 0, CTL_ZERO_BYTES = 64 * 1024;
constexpr size_t WS_WIN  = 1 * MiB;                                   constexpr size_t SZ_WIN  = (size_t)NIN * D * 2;
constexpr size_t WS_WOUT = WS_WIN  + NLAYER * SZ_WIN;                 constexpr size_t SZ_WOUT = (size_t)D * D * 2;
constexpr size_t WS_WGU  = WS_WOUT + NLAYER * SZ_WOUT;                constexpr size_t SZ_WGU  = (size_t)NGU * D * 2;
constexpr size_t WS_WD   = WS_WGU  + NLAYER * SZ_WGU;                 constexpr size_t SZ_WD   = (size_t)D * DFF * 2;
constexpr size_t WS_WGLU = WS_WD   + NLAYER * SZ_WD;                  constexpr size_t SZ_WGLU = (size_t)512 * 256 * 2;
constexpr size_t WS_WLRU = WS_WGLU + NLAYER * SZ_WGLU;                constexpr size_t SZ_WLRU = (size_t)512 * 256 * 2;
constexpr size_t WS_W1   = WS_WLRU + NLAYER * SZ_WLRU;                constexpr size_t SZ_W1   = (size_t)2 * 256 * 2048 * 2;
constexpr size_t WS_TOP  = WS_W1   + NLAYER * SZ_W1;                  constexpr size_t SZ_TOP  = (size_t)16 * NS5 * KS5 * 2;
constexpr size_t WS_MOP  = WS_TOP  + NLAYER * SZ_TOP;                 constexpr size_t SZ_MOP  = (size_t)16 * 256 * NS5 * 2;
constexpr size_t WS_TAB  = WS_MOP  + NLAYER * SZ_MOP;                 constexpr size_t SZ_TAB  = 16384;
constexpr size_t WS_LUT  = WS_TAB  + NLAYER * SZ_TAB;
constexpr size_t WS_RS   = (WS_LUT + 8192 + 255) & ~(size_t)255;
constexpr size_t WS_XN   = (WS_RS + (size_t)M * 16 * 4 + MiB - 1) & ~(MiB - 1);
constexpr size_t WS_MIXR = WS_XN + (size_t)M * D * 2;
constexpr size_t WS_Q    = WS_MIXR;
constexpr size_t WS_KC   = WS_Q   + (size_t)M * 512 * 2;
constexpr size_t WS_VC   = WS_KC  + (size_t)M * 128 * 2;
constexpr size_t WS_KS   = WS_VC  + (size_t)M * 128 * 2 + 65536;
constexpr size_t WS_KW   = WS_KS  + (size_t)M * 128 * 2;
constexpr size_t WS_VST  = WS_KW  + (size_t)M * 128 * 2;
constexpr size_t WS_VWT  = WS_VST + (size_t)M * 128 * 2;
constexpr size_t WS_AS5  = WS_VWT + (size_t)M * 128 * 2;
constexpr size_t WS_SLOC = WS_AS5 + (size_t)16 * 1024 * KS5 * 2;
constexpr size_t WS_YS   = WS_SLOC + (size_t)16 * 1024 * 128 * 4;
constexpr size_t WS_LX   = WS_YS  + (size_t)M * 256 * 2;
constexpr size_t WS_LG   = WS_LX  + (size_t)M * 256 * 2;
constexpr size_t WS_XC   = WS_LG  + (size_t)M * 256 * 2;
constexpr size_t WS_LA   = WS_XC  + (size_t)M * 256 * 2;
constexpr size_t WS_LB   = WS_LA  + (size_t)M * 256 * 4;
constexpr size_t WS_GATES= WS_LB  + (size_t)M * 256 * 4;
constexpr size_t WS_H1C  = WS_GATES + (size_t)M * 32 * 4;
constexpr size_t WS_KCC  = WS_H1C + (size_t)2 * 32 * 128 * 64 * 4;
constexpr size_t WS_VCT  = WS_KCC + (size_t)32 * 128 * 64 * 2;
constexpr size_t WS_MIX  = WS_VCT + (size_t)32 * 128 * 64 * 2;
constexpr size_t WS_END  = WS_MIX + (size_t)M * D * 2;
constexpr size_t WS_HMID = WS_MIXR;
static_assert(WS_HMID + (size_t)M * DFF * 2 <= WS_MIX, "HMID overlay must end before MIX");
constexpr int TB_BIAS1 = 0;
constexpr int TB_SP    = 128;
constexpr int TB_A32   = 512;
constexpr int CW_BAR = 4096;
constexpr int CW_PANEL = 1024;
constexpr int CW_CNT = 2048;

constexpr int RING_BYTES = 131072, MISC_OFF = RING_BYTES + 320, LDS_BYTES = 147456;

__device__ __forceinline__ float bf2f(unsigned h) { return __uint_as_float(h << 16); }
__device__ __forceinline__ float sigmoidf_(float x) { return __builtin_amdgcn_rcpf(1.0f + __expf(-x)); }
__device__ __forceinline__ float gelu_tanh(float x) { const float u = 1.5957691216057308f * (x + 0.044715f * x * x * x); return x * __builtin_amdgcn_rcpf(1.0f + __expf(-u)); }
__device__ __forceinline__ v4u pack8(const float (&v)[8]) { v4u w; w.x = pg8::cvt_pk_bf16(v[0], v[1]); w.y = pg8::cvt_pk_bf16(v[2], v[3]); w.z = pg8::cvt_pk_bf16(v[4], v[5]); w.w = pg8::cvt_pk_bf16(v[6], v[7]); return w; }
__device__ __forceinline__ void unpack8(const v4u w, float (&v)[8]) { v[0] = bf2f(w.x & 0xffffu); v[1] = bf2f(w.x >> 16); v[2] = bf2f(w.y & 0xffffu); v[3] = bf2f(w.y >> 16); v[4] = bf2f(w.z & 0xffffu); v[5] = bf2f(w.z >> 16); v[6] = bf2f(w.w & 0xffffu); v[7] = bf2f(w.w >> 16); }
__device__ __forceinline__ float row_rstd(const float* RS, int row, int fq) {
    const f32x4 v = *(const f32x4*)(RS + (size_t)row * 16 + 4 * fq);
    float s = (v.x + v.y) + (v.z + v.w); s += __shfl_xor(s, 16); s += __shfl_xor(s, 32);
    return rsqrtf(s * (1.0f / 1024.0f) + 1e-6f);
}
typedef const pg8::f32x4 (&AccRef)[2][2][4][2];
constexpr int RSL_OFF = RING_BYTES + 1024, RSL_MAX_UNITS = 12;
static_assert(RSL_OFF + RSL_MAX_UNITS * 256 * 4 <= LDS_BYTES, "row-scale table fits the spare LDS");
template <class Sched>
__device__ __forceinline__ void rsl_fill(const float* RS, const Sched& S, LAS unsigned char* lds, int tid) {
    LAS float* RL = (LAS float*)(lds + RSL_OFF); const int r = tid >> 1, hf = tid & 1;
    Unit u; f32x4 a[RSL_MAX_UNITS], b[RSL_MAX_UNITS];
#pragma unroll
    for (int i = 0; i < RSL_MAX_UNITS; ++i) if (S.next(i, u)) { const float* p = RS + (size_t)(u.pm * BM + r) * 16 + 8 * hf; a[i] = *(const f32x4*)p; b[i] = *(const f32x4*)(p + 4); }
#pragma unroll
    for (int i = 0; i < RSL_MAX_UNITS; ++i) if (S.next(i, u)) { float s = ((a[i].x + a[i].y) + (a[i].z + a[i].w)) + ((b[i].x + b[i].y) + (b[i].z + b[i].w)); s += __shfl_xor(s, 1);
        if (hf == 0) RL[i * 256 + r] = rsqrtf(s * (1.0f / 1024.0f) + 1e-6f); }
    __syncthreads();
}
__device__ __forceinline__ void rsl_read8(const LAS unsigned char* lds, int ui, int wr, int fr, float (&rs)[2][4]) {
    const LAS float* RL = (const LAS float*)(lds + RSL_OFF) + ui * 256 + wr * 64 + fr;
#pragma unroll
    for (int ai = 0; ai < 2; ++ai)
#pragma unroll
        for (int m = 0; m < 4; ++m) rs[ai][m] = RL[ai * HALF + m * 16];
}
__device__ __forceinline__ void row_rstd8(const float* RS, int row0, int fq, float (&rs)[2][4]) {
    f32x4 v[2][4];
#pragma unroll
    for (int ai = 0; ai < 2; ++ai)
#pragma unroll
        for (int m = 0; m < 4; ++m) v[ai][m] = *(const f32x4*)(RS + (size_t)(row0 + ai * HALF + m * 16) * 16 + 4 * fq);
#pragma unroll
    for (int ai = 0; ai < 2; ++ai)
#pragma unroll
        for (int m = 0; m < 4; ++m) { float s = (v[ai][m].x + v[ai][m].y) + (v[ai][m].z + v[ai][m].w); s += __shfl_xor(s, 16); s += __shfl_xor(s, 32); rs[ai][m] = rsqrtf(s * (1.0f / 1024.0f) + 1e-6f); }
}

struct EpiInProj {
    static constexpr bool PERM = true, AFTER_DRAIN = false;
    unsigned char* w; const LAS unsigned char* lds; mutable int ui;
    __device__ __forceinline__ void operator()(AccRef acc, const Unit& u, int wr, int wc, int fr, int fq) const {
        const int pn = u.pn;
        float rs8[2][4]; rsl_read8(lds, ui, wr, fr, rs8); ++ui;
        const float* RS = (const float*)(w + WS_RS); (void)RS; bf16_t* Q = (bf16_t*)(w + WS_Q); bf16_t* KC = (bf16_t*)(w + WS_KC); bf16_t* VC = (bf16_t*)(w + WS_VC); bf16_t* KS = (bf16_t*)(w + WS_KS); bf16_t* KW = (bf16_t*)(w + WS_KW);
        bf16_t* VST = (bf16_t*)(w + WS_VST); bf16_t* VWT = (bf16_t*)(w + WS_VWT); bf16_t* AS5 = (bf16_t*)(w + WS_AS5); bf16_t* LX = (bf16_t*)(w + WS_LX); bf16_t* LG = (bf16_t*)(w + WS_LG); float* GATES = (float*)(w + WS_GATES);
#pragma unroll
        for (int ai = 0; ai < 2; ++ai)
#pragma unroll
            for (int m = 0; m < 4; ++m) {
                const int row = u.pm * BM + ai * HALF + wr * 64 + m * 16 + fr;
                const float rs = rs8[ai][m];
                const int b = row >> 11, t = row & 2047;
#pragma unroll
                for (int bj = 0; bj < 2; ++bj) {
                    const int c8 = bj * HALF + wc * 32 + 8 * fq;
                    float v[8];
#pragma unroll
                    for (int j = 0; j < 4; ++j) { v[j] = acc[ai][bj][m][0][j] * rs; v[4 + j] = acc[ai][bj][m][1][j] * rs; }
                    if (pn == 0) {
                        const int g = c8 >> 4, co = c8 & 15;
                        *(v4u*)(AS5 + ((size_t)(g * 1024 + b * 64 + (t >> 5)) * KS5 + (t & 31) * 16 + co)) = pack8(v);
                    } else if (pn <= 2) {
#pragma unroll
                        for (int j = 0; j < 8; ++j) v[j] *= QSCALE;
                        *(v4u*)(Q + (size_t)row * 512 + (pn - 1) * 256 + c8) = pack8(v);
                    } else if (pn <= 5) {
                        const int c = c8 & 127, h = c >> 6, d = c & 63;
                        const size_t kvrow = (size_t)(b * 2 + h) * 2048 + t;
                        if (bj == 0) { bf16_t* base = pn == 3 ? KC : (pn == 4 ? KS : KW); *(v4u*)(base + kvrow * 64 + d) = pack8(v); }
                        else if (pn == 3) { *(v4u*)(VC + kvrow * 64 + d) = pack8(v); }
                        else { bf16_t* base = pn == 4 ? VST : VWT;
#pragma unroll
                            for (int j = 0; j < 8; ++j) base[((size_t)(b * 2 + h) * 64 + d + j) * 2048 + t] = (bf16_t)f2bf(v[j]); }
                    } else if (pn == 6) {
                        *(v4u*)(LX + (size_t)row * 256 + c8) = pack8(v);
                    } else if (pn == 7) {
#pragma unroll
                        for (int j = 0; j < 8; ++j) v[j] = gelu_tanh(v[j]);
                        *(v4u*)(LG + (size_t)row * 256 + c8) = pack8(v);
                    } else {
                        if (bj == 0 && wc == 0 && fq < 3) {
                            f32x4 a, c; a.x = sigmoidf_(v[0]); a.y = sigmoidf_(v[1]); a.z = sigmoidf_(v[2]); a.w = sigmoidf_(v[3]);
                            c.x = sigmoidf_(v[4]); c.y = sigmoidf_(v[5]); c.z = sigmoidf_(v[6]); c.w = sigmoidf_(v[7]);
                            *(f32x4*)(GATES + (size_t)row * 32 + 8 * fq) = a; *(f32x4*)(GATES + (size_t)row * 32 + 8 * fq + 4) = c; }
                    }
                }
            }
    }
};
struct EpiGates {
    static constexpr bool PERM = true, AFTER_DRAIN = false;
    unsigned char* w;
    __device__ __forceinline__ void operator()(AccRef acc, const Unit& u, int wr, int wc, int fr, int fq) const {
        if (wc != 0) return;
        float* GATES = (float*)(w + WS_GATES);
        float rs8[2][4]; row_rstd8((const float*)(w + WS_RS), u.pm * BM + wr * 64 + fr, fq, rs8);
#pragma unroll
        for (int ai = 0; ai < 2; ++ai)
#pragma unroll
            for (int m = 0; m < 4; ++m) {
                const int row = u.pm * BM + ai * HALF + wr * 64 + m * 16 + fr;
                const float rs = rs8[ai][m];
                if (fq < 3) { f32x4 a, c;
#pragma unroll
                    for (int j = 0; j < 4; ++j) { a[j] = sigmoidf_(acc[ai][0][m][0][j] * rs); c[j] = sigmoidf_(acc[ai][0][m][1][j] * rs); }
                    *(f32x4*)(GATES + (size_t)row * 32 + 8 * fq) = a; *(f32x4*)(GATES + (size_t)row * 32 + 8 * fq + 4) = c; }
            }
    }
};
struct EpiResid {
    static constexpr bool PERM = true, AFTER_DRAIN = false;
    bf16_t* XN; float* RS;
    __device__ __forceinline__ void operator()(AccRef acc, const Unit& u, int wr, int wc, int fr, int fq) const {
        const int row0 = u.pm * BM + wr * 64 + fr, col0 = u.pn * BM + wc * 32 + 8 * fq;
        v4u hv[4][2];
#pragma unroll
        for (int g = 0; g < 4; ++g)
#pragma unroll
            for (int bj = 0; bj < 2; ++bj) hv[g][bj] = *(const v4u*)(XN + (size_t)(row0 + (g & 3) * 16) * D + col0 + bj * HALF);
#pragma unroll
        for (int g = 0; g < 8; ++g) { const int ai = g >> 2, m = g & 3; const int row = row0 + ai * HALF + m * 16; float ss = 0.f;
            v4u cur0 = hv[g & 3][0], cur1 = hv[g & 3][1];
            if (g < 4) {
#pragma unroll
                for (int bj = 0; bj < 2; ++bj) hv[g & 3][bj] = *(const v4u*)(XN + (size_t)(row0 + HALF + (g & 3) * 16) * D + col0 + bj * HALF); }
#pragma unroll
            for (int bj = 0; bj < 2; ++bj) { float h[8]; unpack8(bj == 0 ? cur0 : cur1, h);
#pragma unroll
                for (int j = 0; j < 4; ++j) { h[j] += acc[ai][bj][m][0][j]; h[4 + j] += acc[ai][bj][m][1][j]; }
#pragma unroll
                for (int j = 0; j < 8; ++j) ss += h[j] * h[j];
                *(v4u*)(XN + (size_t)row * D + col0 + bj * HALF) = pack8(h); }
            ss += __shfl_xor(ss, 16); ss += __shfl_xor(ss, 32);
            if (fq == 0) RS[(size_t)row * 16 + u.pn * 4 + wc] = ss; }
    }
};
struct EpiGateUp {
    static constexpr bool PERM = true, AFTER_DRAIN = false;
    const LAS unsigned char* lds; bf16_t* HM; mutable int ui;
    __device__ __forceinline__ void operator()(AccRef acc, const Unit& u, int wr, int wc, int fr, int fq) const {
        typedef float f32x2 __attribute__((ext_vector_type(2)));
        float rs8[2][4]; rsl_read8(lds, ui, wr, fr, rs8); ++ui;
#pragma unroll
        for (int ai = 0; ai < 2; ++ai)
#pragma unroll
            for (int m = 0; m < 4; ++m) {
                const int row = u.pm * BM + ai * HALF + wr * 64 + m * 16 + fr;
                const float rs = rs8[ai][m], k1 = -rs * LOG2E, k2 = rs * rs;
                float v[8];
#pragma unroll
                for (int n = 0; n < 2; ++n)
#pragma unroll
                    for (int jp = 0; jp < 2; ++jp) {
                        const f32x2 g = {acc[ai][0][m][n][2 * jp], acc[ai][0][m][n][2 * jp + 1]}, up = {acc[ai][1][m][n][2 * jp], acc[ai][1][m][n][2 * jp + 1]};
                        const f32x2 x = g * k1; f32x2 e; e.x = __builtin_amdgcn_exp2f(x.x); e.y = __builtin_amdgcn_exp2f(x.y);
                        const f32x2 d = e + 1.0f; f32x2 r; r.x = __builtin_amdgcn_rcpf(d.x); r.y = __builtin_amdgcn_rcpf(d.y);
                        const f32x2 o = ((g * up) * k2) * r; v[4 * n + 2 * jp] = o.x; v[4 * n + 2 * jp + 1] = o.y; }
                *(v4u*)(HM + (size_t)row * DFF + u.pn * 128 + wc * 32 + 8 * fq) = pack8(v);
                asm volatile("" ::: "memory");
            }
    }
};
struct EpiProbeRaw {
    static constexpr bool PERM = true, AFTER_DRAIN = false;
    bf16_t* HM;
    __device__ __forceinline__ void operator()(AccRef acc, const Unit& u, int wr, int wc, int fr, int fq) const {
#pragma unroll
        for (int ai = 0; ai < 2; ++ai)
#pragma unroll
            for (int m = 0; m < 4; ++m) { const int row = u.pm * BM + ai * HALF + wr * 64 + m * 16 + fr; float v[8];
#pragma unroll
                for (int n = 0; n < 2; ++n)
#pragma unroll
                    for (int j = 0; j < 4; ++j) v[4 * n + j] = acc[ai][0][m][n][j] + acc[ai][1][m][n][j];
                *(v4u*)(HM + (size_t)row * DFF + u.pn * 128 + wc * 32 + 8 * fq) = pack8(v); }
    }
};
struct EpiS5StateScan {
    static constexpr bool PERM = false, AFTER_DRAIN = true;
    const float* a32; bf16_t* AS5;
    __device__ __forceinline__ void fused(AccRef acc, const Unit& u, int wr, int wc, int fr, int fq, PG8_LAS unsigned char* lds, int wid, int lane) const {
        LAS float* S = (LAS float*)lds;
#pragma unroll
        for (int ai = 0; ai < 2; ++ai)
#pragma unroll
            for (int m = 0; m < 4; ++m) { const int rowl = ai * HALF + wr * 64 + m * 16 + fr;
#pragma unroll
                for (int n = 0; n < 2; ++n) *(LAS f32x4*)(S + rowl * 128 + wc * 32 + 16 * n + 4 * fq) = acc[ai][0][m][n]; }
        asm volatile("s_waitcnt lgkmcnt(0)" ::: "memory"); __builtin_amdgcn_s_barrier(); asm volatile("" ::: "memory");
        const int tid = wid * 64 + lane;
        if (tid < 256) { const int bl = tid >> 6, p = tid & 63, g = u.pm >> 2;
            const float ar = a32[2 * (g * 64 + p)], aI = a32[2 * (g * 64 + p) + 1]; float hr = 0.f, hi = 0.f;
#pragma unroll 4
            for (int ch = 0; ch < NCH; ++ch) { const size_t R = (size_t)u.pm * BM + bl * 64 + ch;
                AS5[R * KS5 + NS5 + p] = (bf16_t)f2bf(hr); AS5[R * KS5 + NS5 + 64 + p] = (bf16_t)f2bf(hi);
                const float sr = S[(bl * 64 + ch) * 128 + p], si = S[(bl * 64 + ch) * 128 + 64 + p];
                const float nr = ar * hr - aI * hi + sr, ni = ar * hi + aI * hr + si; hr = nr; hi = ni; } }
        asm volatile("s_waitcnt lgkmcnt(0)" ::: "memory"); __builtin_amdgcn_s_barrier(); asm volatile("" ::: "memory");
    }
};
struct EpiS5Main {
    static constexpr bool PERM = true, AFTER_DRAIN = false;
    const bf16_t* AS5; const float* dskip; bf16_t* YS;
    __device__ __forceinline__ void operator()(AccRef acc, const Unit& u, int wr, int wc, int fr, int fq) const {
#pragma unroll
        for (int ai = 0; ai < 2; ++ai)
#pragma unroll
            for (int m = 0; m < 4; ++m) {
                const int R = u.pm * BM + ai * HALF + wr * 64 + m * 16 + fr;
                const int g = R >> 10, b = (R >> 6) & 15, ch = R & 63;
#pragma unroll
                for (int bj = 0; bj < 2; ++bj) {
                    const int cg = (u.pn & 1) * 256 + bj * HALF + wc * 32 + 8 * fq, t = cg >> 4, co = cg & 15;
                    float uu[8], v[8]; unpack8(*(const v4u*)(AS5 + (size_t)R * KS5 + cg), uu);
                    const f32x4 d0 = *(const f32x4*)(dskip + 16 * g + co), d1 = *(const f32x4*)(dskip + 16 * g + co + 4);
#pragma unroll
                    for (int j = 0; j < 4; ++j) { v[j] = gelu_tanh(acc[ai][bj][m][0][j] + d0[j] * uu[j]); v[4 + j] = gelu_tanh(acc[ai][bj][m][1][j] + d1[j] * uu[4 + j]); }
                    *(v4u*)(YS + (size_t)(b * 2048 + ch * 32 + t) * 256 + 16 * g + co) = pack8(v);
                }
            }
    }
};
struct EpiGlu {
    static constexpr bool PERM = true, AFTER_DRAIN = false;
    bf16_t* MIX;
    __device__ __forceinline__ void operator()(AccRef acc, const Unit& u, int wr, int wc, int fr, int fq) const {
#pragma unroll
        for (int ai = 0; ai < 2; ++ai)
#pragma unroll
            for (int m = 0; m < 4; ++m) {
                const int row = u.pm * BM + ai * HALF + wr * 64 + m * 16 + fr;
                float v[8];
#pragma unroll
                for (int n = 0; n < 2; ++n)
#pragma unroll
                    for (int j = 0; j < 4; ++j) v[4 * n + j] = acc[ai][0][m][n][j] * sigmoidf_(acc[ai][1][m][n][j]);
                *(v4u*)(MIX + (size_t)row * D + u.pn * 128 + wc * 32 + 8 * fq) = pack8(v);
                asm volatile("" ::: "memory");
            }
    }
};
struct EpiLruGates {
    static constexpr bool PERM = true, AFTER_DRAIN = false;
    const bf16_t* XC; const float *b_a, *b_x, *sp; bf16_t *LA, *LB;
    __device__ __forceinline__ void operator()(AccRef acc, const Unit& u, int wr, int wc, int fr, int fq) const {
        const int ch = u.pn * 128 + wc * 32 + 8 * fq;
        float ba[8], bx[8], s8[8];
#pragma unroll
        for (int j = 0; j < 8; ++j) { ba[j] = b_a[ch + j]; bx[j] = b_x[ch + j]; s8[j] = sp[ch + j]; }
#pragma unroll
        for (int ai = 0; ai < 2; ++ai)
#pragma unroll
            for (int m = 0; m < 4; ++m) {
                const int row = u.pm * BM + ai * HALF + wr * 64 + m * 16 + fr;
                float xc[8], oa[8], ob[8]; unpack8(*(const v4u*)(XC + (size_t)row * 256 + ch), xc);
#pragma unroll
                for (int j = 0; j < 8; ++j) { const float ar = acc[ai][0][m][j >> 2][j & 3], ai_ = acc[ai][1][m][j >> 2][j & 3];
                    const float r = sigmoidf_(ar + ba[j]), ig = sigmoidf_(ai_ + bx[j]);
                    const float la = -8.0f * r * s8[j]; const float av = __expf(la);
                    oa[j] = 1.0f - av; ob[j] = sqrtf(fmaxf(1.0f - av * av, 0.f)) * ig * xc[j]; }
                *(v4u*)(LA + (size_t)row * 256 + ch) = pack8(oa); *(v4u*)(LB + (size_t)row * 256 + ch) = pack8(ob);
                asm volatile("" ::: "memory");
            }
    }
};
struct EpiCompress2 {
    static constexpr bool PERM = false, AFTER_DRAIN = true;
    const float* bias1; const float* w2k; const float* w2v; bf16_t* KCC; bf16_t* VCT;
    __device__ __forceinline__ void fused(AccRef acc, const Unit& u, int wr, int wc, int fr, int fq, PG8_LAS unsigned char* lds, int wid, int lane) const {
        LAS float* Hs = (LAS float*)lds; LAS float* W2s = (LAS float*)(lds + 256 * 65 * 4 + 64);
        const int kv = u.pn, tid = wid * 64 + lane; const float* w2 = kv ? w2v : w2k;
        for (int i = tid; i < 4096; i += NTHREADS) W2s[i] = w2[i];
        if (wc < 2) {
#pragma unroll
            for (int n = 0; n < 2; ++n) { const int j0 = wc * 32 + 16 * n + 4 * fq; const f32x4 bv = *(const f32x4*)(bias1 + kv * 64 + j0);
#pragma unroll
                for (int ai = 0; ai < 2; ++ai)
#pragma unroll
                    for (int m = 0; m < 4; ++m) { const int rowl = ai * HALF + wr * 64 + m * 16 + fr; const f32x4 h = acc[ai][0][m][n] + bv;
                        Hs[rowl * 65 + j0] = gelu_tanh(h.x); Hs[rowl * 65 + j0 + 1] = gelu_tanh(h.y); Hs[rowl * 65 + j0 + 2] = gelu_tanh(h.z); Hs[rowl * 65 + j0 + 3] = gelu_tanh(h.w); } } }
        asm volatile("s_waitcnt vmcnt(0) lgkmcnt(0)" ::: "memory"); __builtin_amdgcn_s_barrier(); asm volatile("" ::: "memory");
        const int rowl = tid >> 1, jh = tid & 1, rr = u.pm * BM + rowl - kv * 4096, bh = rr >> 7, n = rr & 127;
        float o[32];
#pragma unroll
        for (int j = 0; j < 32; ++j) o[j] = 0.f;
        if (n < 127) {
#pragma unroll 2
            for (int k = 0; k < 64; ++k) { const float hk = Hs[rowl * 65 + k];
#pragma unroll
                for (int j4 = 0; j4 < 8; ++j4) { const f32x4 wv = *(const LAS f32x4*)(W2s + k * 64 + jh * 32 + 4 * j4); o[4 * j4] += hk * wv.x; o[4 * j4 + 1] += hk * wv.y; o[4 * j4 + 2] += hk * wv.z; o[4 * j4 + 3] += hk * wv.w; } } }
        if (kv == 0) { bf16_t* dst = KCC + ((size_t)bh * 128 + n) * 64 + jh * 32;
#pragma unroll
            for (int j8 = 0; j8 < 4; ++j8) { float v8[8];
#pragma unroll
                for (int j = 0; j < 8; ++j) v8[j] = o[8 * j8 + j];
                *(v4u*)(dst + 8 * j8) = pack8(v8); } }
        else {
#pragma unroll
            for (int j = 0; j < 32; ++j) VCT[((size_t)bh * 64 + jh * 32 + j) * 128 + n] = (bf16_t)f2bf(o[j]); }
        asm volatile("s_waitcnt lgkmcnt(0)" ::: "memory"); __builtin_amdgcn_s_barrier(); asm volatile("" ::: "memory");
    }
};

__device__ __forceinline__ float wave_sum(float v) {
#pragma unroll
    for (int o = 1; o < 64; o <<= 1) v += __shfl_xor(v, o);
    return v;
}
struct RmIdent { __device__ __forceinline__ int operator()(int n) const { return n; } };
struct RmWin   { __device__ __forceinline__ int operator()(int n) const { return n < 1536 ? n : (n < 1560 ? 2048 + (n - 1536) : n - 24); } };
struct RmPair  { int half, split; __device__ __forceinline__ int operator()(int n) const { const int c = n - split; return 256 * (c >> 7) + half * 128 + (c & 127); } };
struct RmGlu   { __device__ __forceinline__ int operator()(int n) const { const int hf = n >= 256, c = n - 256 * hf; return 256 * (c >> 7) + hf * 128 + (c & 127); } };
template <class RowMap>
__device__ __forceinline__ void tr_item(const float* W, int ldw, int ncols, int K, const float* kscale, bf16_t* WT, const RowMap rm, LAS float* scr, int item, int lane) {
    const int nblk = (ncols + 31) >> 5, kb = item / nblk, nb = item - kb * nblk, k0 = 64 * kb, n0 = 32 * nb;
    const int nn = n0 + (lane & 31);
    float wv[32];
#pragma unroll
    for (int i = 0; i < 32; ++i) { const int kk = 2 * i + (lane >> 5); wv[i] = nn < ncols ? W[(size_t)(k0 + kk) * ldw + nn] : 0.f; }
#pragma unroll
    for (int i = 0; i < 32; ++i) { const int kk = 2 * i + (lane >> 5); float v = wv[i]; if (kscale) v *= kscale[k0 + kk]; scr[kk * 33 + (lane & 31)] = v; }
    LDS_WAIT(); asm volatile("" ::: "memory");
    const int c = lane & 7;
#pragma unroll
    for (int j = 0; j < 4; ++j) { const int nl = (lane >> 3) + 8 * j, n = n0 + nl; const LAS float* s = scr + (8 * c) * 33 + nl;
        v4u o; o.x = pk2(s[0 * 33], s[1 * 33]); o.y = pk2(s[2 * 33], s[3 * 33]); o.z = pk2(s[4 * 33], s[5 * 33]); o.w = pk2(s[6 * 33], s[7 * 33]);
        if (n < ncols) *(v4u*)(WT + (size_t)rm(n) * K + k0 + 8 * c) = o; }
    LDS_WAIT(); asm volatile("" ::: "memory");
}
template <class RowMap>
__device__ __forceinline__ void tr_job(const float* W, int ldw, int ncols, int K, const float* kscale, bf16_t* WT, const RowMap rm, LAS float* scr, int gw, int NGW, int lane, int rot) {
    const int nitems = (K >> 6) * ((ncols + 31) >> 5);
    for (int it = (gw + rot) % NGW; it < nitems; it += NGW) tr_item(W, ldw, ncols, K, kscale, WT, rm, scr, it, lane);
}
template <class RowMap>
__device__ __forceinline__ void trb_job(const float* W, int ldw, int ncols, int K, const float* kscale, bf16_t* WT, const RowMap rm, LAS unsigned char* lds, int bid, int G, int tid, int rot) {
    LAS bf16_t* T = (LAS bf16_t*)lds; constexpr int TP = 258;
    const int nblk = (ncols + 255) >> 8, nitems = (K >> 6) * nblk;
    for (int it = ((bid - rot) % G + G) % G; it < nitems; it += G) {
        const int kb = it / nblk, nb = it - kb * nblk, k0 = 64 * kb, n0 = 256 * nb, c4 = (tid & 63) * 4, kr = tid >> 6;
        f32x4 v[8];
#pragma unroll
        for (int p = 0; p < 8; ++p) { const f32x4 z = {0.f, 0.f, 0.f, 0.f}; v[p] = (n0 + c4 < ncols) ? *(const GAS f32x4*)(W + (size_t)(k0 + p * 8 + kr) * ldw + n0 + c4) : z; }
#pragma unroll
        for (int p = 0; p < 8; ++p) { const int kk = p * 8 + kr; const float sc = kscale ? kscale[k0 + kk] : 1.0f;
            LAS unsigned* d = (LAS unsigned*)(T + kk * TP + c4); d[0] = pk2(v[p].x * sc, v[p].y * sc); d[1] = pk2(v[p].z * sc, v[p].w * sc); }
        __syncthreads();
#pragma unroll
        for (int q = 0; q < 4; ++q) { const int idx = tid + q * NTHREADS, n = idx >> 3, c = idx & 7; const LAS bf16_t* src = T + (8 * c) * TP + n;
            v4u o; o.x = (unsigned)src[0] | ((unsigned)src[TP] << 16); o.y = (unsigned)src[2 * TP] | ((unsigned)src[3 * TP] << 16); o.z = (unsigned)src[4 * TP] | ((unsigned)src[5 * TP] << 16); o.w = (unsigned)src[6 * TP] | ((unsigned)src[7 * TP] << 16);
            if (n0 + n < ncols) *(v4u*)(WT + (size_t)rm(n0 + n) * K + k0 + 8 * c) = o; }
        __syncthreads();
    }
}
__device__ __forceinline__ void zero_job(void* p, size_t n16, int gtid, int NT) { v4u z = {0u, 0u, 0u, 0u}; for (size_t i = gtid; i < n16; i += NT) ((v4u*)p)[i] = z; }

struct S5Coef { float lr, li, dt; };
__device__ __forceinline__ S5Coef s5_coef(const float* lam_re, const float* lam_im, const float* log_dt, int l, int g, int p) {
    S5Coef c; c.lr = lam_re[(l * 16 + g) * 64 + p]; c.li = lam_im[(l * 16 + g) * 64 + p]; c.dt = expf(log_dt[l * 16 + g]); return c; }
__device__ __forceinline__ void s5_apow(const S5Coef& c, float tau, float& re, float& im) { const float mag = expf(c.lr * c.dt * tau), ang = c.li * c.dt * tau; re = mag * cosf(ang); im = mag * sinf(ang); }
__device__ __forceinline__ void s5_apow_fast(const S5Coef& c, float tau, float& re, float& im) { const float mag = __expf(c.lr * c.dt * tau), ang = c.li * c.dt * tau; re = mag * __cosf(ang); im = mag * __sinf(ang); }
__device__ __forceinline__ void s5_f_fast(const S5Coef& c, float& fre, float& fim) {
    float are, aim; s5_apow_fast(c, 1.0f, are, aim); const float rden = __builtin_amdgcn_rcpf(c.lr * c.lr + c.li * c.li);
    fre = ((are - 1.0f) * c.lr + aim * c.li) * rden; fim = (aim * c.lr - (are - 1.0f) * c.li) * rden; }
__device__ __forceinline__ void s5_f(const S5Coef& c, float& fre, float& fim) {
    float are, aim; s5_apow(c, 1.0f, are, aim); const float den = c.lr * c.lr + c.li * c.li;
    fre = ((are - 1.0f) * c.lr + aim * c.li) / den; fim = (aim * c.lr - (are - 1.0f) * c.li) / den; }

struct Args { const float* in[32]; float* out; unsigned char* ws; int ph_lo, ph_hi, li, pad; };

__device__ __forceinline__ int t5_bucket(int n) { if (n < 16) return n; const int lg = 16 + (int)(logf((float)n * (1.0f / 16.0f)) / 2.0794415416798357f * 16.0f); return lg < 31 ? lg : 31; }

__device__ __forceinline__ void p0_prologue(const Args& P, LAS unsigned char* lds, int tid, int lane, int wave, int bid, int G, const int which) {
    LAS float* scr = (LAS float*)(lds + wave * 16384);
    const int gw = bid * NWAVES + wave, NGW = G * NWAVES, gtid = bid * NTHREADS + tid, NT = G * NTHREADS;
    unsigned char* ws = P.ws;
    if (which & 1) {
    { const float* x = P.in[0]; bf16_t* XN = (bf16_t*)(ws + WS_XN); float* RS = (float*)(ws + WS_RS);
      for (int m0 = gw * 4; m0 < M; m0 += NGW * 4) {
          f32x4 v[4][4]; float s[4];
#pragma unroll
          for (int q = 0; q < 4; ++q) { const f32x4* xr = (const f32x4*)(x + (size_t)(m0 + q) * D) + lane;
#pragma unroll
              for (int j = 0; j < 4; ++j) v[q][j] = xr[64 * j]; }
#pragma unroll
          for (int q = 0; q < 4; ++q) { s[q] = 0.f;
#pragma unroll
              for (int j = 0; j < 4; ++j) s[q] += (v[q][j].x * v[q][j].x + v[q][j].y * v[q][j].y) + (v[q][j].z * v[q][j].z + v[q][j].w * v[q][j].w);
              s[q] = wave_sum(s[q]); }
#pragma unroll
          for (int q = 0; q < 4; ++q) { const int m = m0 + q;
#pragma unroll
              for (int j = 0; j < 4; ++j) { u32x2v w; w.x = pg8::cvt_pk_bf16(v[q][j].x, v[q][j].y); w.y = pg8::cvt_pk_bf16(v[q][j].z, v[q][j].w); *(u32x2v*)(XN + (size_t)m * D + (64 * j + lane) * 4) = w; }
              if (lane < 16) RS[(size_t)m * 16 + lane] = lane == 0 ? s[q] : 0.f; }
      } }
    }
    if (!(which & 2)) return;
    for (int l = 0; l < NLAYER; ++l) {
        bf16_t* WinT = (bf16_t*)(ws + WS_WIN + l * SZ_WIN); bf16_t* WoutT = (bf16_t*)(ws + WS_WOUT + l * SZ_WOUT); bf16_t* WguT = (bf16_t*)(ws + WS_WGU + l * SZ_WGU);
        bf16_t* WdT = (bf16_t*)(ws + WS_WD + l * SZ_WD); bf16_t* WgluT = (bf16_t*)(ws + WS_WGLU + l * SZ_WGLU); bf16_t* W1T = (bf16_t*)(ws + WS_W1 + l * SZ_W1);
        __syncthreads();
        trb_job(P.in[3] + (size_t)l * D * NINV, NINV, NINV, D, P.in[2] + l * D, WinT, RmWin(), lds, bid, G, tid, 736 * l + 0);
        trb_job(P.in[4] + (size_t)l * D * D, D, D, D, (const float*)nullptr, WoutT, RmIdent(), lds, bid, G, tid, 736 * l + 144);
        trb_job(P.in[28] + (size_t)l * D * DFF, DFF, DFF, D, P.in[27] + l * D, WguT, RmPair{0, 0}, lds, bid, G, tid, 736 * l + 208);
        trb_job(P.in[29] + (size_t)l * D * DFF, DFF, DFF, D, P.in[27] + l * D, WguT, RmPair{1, 0}, lds, bid, G, tid, 736 * l + 384);
        trb_job(P.in[30] + (size_t)l * DFF * D, D, D, DFF, (const float*)nullptr, WdT, RmIdent(), lds, bid, G, tid, 736 * l + 560);
    }
    { const int l = gw & 1;
      const int gw_all = gw, NGW_all = NGW, gtid_all = gtid, NT_all = NT; (void)gw_all; (void)NGW_all; (void)gtid_all; (void)NT_all;
      const int gw2 = gw >> 1, NGW2 = NGW >> 1, gtid2 = gw2 * 64 + lane, NT2 = NT >> 1;
#define gw gw2
#define NGW NGW2
#define gtid gtid2
#define NT NT2
        bf16_t* WinT = (bf16_t*)(ws + WS_WIN + l * SZ_WIN); bf16_t* WoutT = (bf16_t*)(ws + WS_WOUT + l * SZ_WOUT); bf16_t* WguT = (bf16_t*)(ws + WS_WGU + l * SZ_WGU);
        bf16_t* WdT = (bf16_t*)(ws + WS_WD + l * SZ_WD); bf16_t* WgluT = (bf16_t*)(ws + WS_WGLU + l * SZ_WGLU); bf16_t* W1T = (bf16_t*)(ws + WS_W1 + l * SZ_W1);
        tr_job(P.in[13] + (size_t)l * 256 * 512, 512, 512, 256, (const float*)nullptr, WgluT, RmGlu(), scr, gw, NGW, lane, 1680);
        tr_job(P.in[15] + (size_t)l * 2048 * 64, 64, 64, 2048, (const float*)nullptr, W1T, RmIdent(), scr, gw, NGW, lane, 1744);
        tr_job(P.in[18] + (size_t)l * 2048 * 64, 64, 64, 2048, (const float*)nullptr, W1T + 256 * 2048, RmIdent(), scr, gw, NGW, lane, 1808);
        zero_job(WinT + (size_t)NINV * D, (size_t)(NIN - NINV) * D * 2 / 16, gtid, NT);
        zero_job(W1T + 64 * 2048, (size_t)192 * 2048 * 2 / 16, gtid, NT);
        zero_job(W1T + 256 * 2048 + 64 * 2048, (size_t)192 * 2048 * 2 / 16, gtid, NT);
        { bf16_t* WlT = (bf16_t*)(ws + WS_WLRU + l * SZ_WLRU); const float* wa = P.in[22] + (size_t)l * 4 * 64 * 64; const float* wx = P.in[24] + (size_t)l * 4 * 64 * 64;
          for (int i = gtid; i < 512 * 256; i += NT) { const int r = i >> 8, k = i & 255, pn = r >> 8, hf = (r >> 7) & 1, ch = pn * 128 + (r & 127), h = ch >> 6, j = ch & 63;
              float v = 0.f; if ((k >> 6) == h) v = (hf ? wx : wa)[(h * 64 + (k & 63)) * 64 + j]; WlT[i] = (bf16_t)f2bf(v); } }
        { float* TB = (float*)(ws + WS_TAB + l * SZ_TAB);
          for (int i = (gw + 96) % NGW; i < 128; i += NGW) { const int kv = i >> 6, j = i & 63; const float* pe = P.in[kv ? 17 : 14] + (size_t)l * 2048; const float* w1 = P.in[kv ? 18 : 15] + (size_t)l * 2048 * 64;
              float s = 0.f;
#pragma unroll 8
              for (int q = 0; q < 32; ++q) { const int k = lane + 64 * q; s += pe[k] * w1[(size_t)k * 64 + j]; }
              s = wave_sum(s); if (lane == 0) TB[TB_BIAS1 + i] = s; }
          for (int i = gtid; i < 256; i += NT) { const float lam = P.in[26][l * 256 + i]; TB[TB_SP + i] = lam > 15.f ? expf(-lam) : log1pf(expf(-lam)); }
          for (int i = gtid; i < 1024; i += NT) { const S5Coef c = s5_coef(P.in[5], P.in[6], P.in[7], l, i >> 6, i & 63); float re, im; s5_apow(c, (float)L5, re, im); TB[TB_A32 + 2 * i] = re; TB[TB_A32 + 2 * i + 1] = im; } }
        { bf16_t* TOP = (bf16_t*)(ws + WS_TOP + l * SZ_TOP); bf16_t* MOP = (bf16_t*)(ws + WS_MOP + l * SZ_MOP);
          const float *bre = P.in[8] + (size_t)l * 16384, *bim = P.in[9] + (size_t)l * 16384, *cre = P.in[10] + (size_t)l * 16384, *cim = P.in[11] + (size_t)l * 16384;
          for (int it = (gw + 64) % NGW; it < 16 * L5; it += NGW) {
              const int g = it >> 5, tau = it & 31, co = lane >> 2, ci0 = 4 * (lane & 3);
              float k4[4] = {0.f, 0.f, 0.f, 0.f};
              float pa_re, pa_im, pf_re, pf_im;
              { const S5Coef c = s5_coef(P.in[5], P.in[6], P.in[7], l, g, lane); s5_apow_fast(c, (float)tau, pa_re, pa_im); s5_f_fast(c, pf_re, pf_im); }
#pragma unroll 8
              for (int p = 0; p < 64; ++p) {
                  const float are = __shfl(pa_re, p), aim = __shfl(pa_im, p), fre = __shfl(pf_re, p), fim = __shfl(pf_im, p);
                  const float cr = cre[(g * 16 + co) * 64 + p], cI = cim[(g * 16 + co) * 64 + p];
                  const float wr_ = cr * are - cI * aim, wi_ = cr * aim + cI * are;
#pragma unroll
                  for (int j = 0; j < 4; ++j) { const float br = bre[(g * 64 + p) * 16 + ci0 + j], bi = bim[(g * 64 + p) * 16 + ci0 + j];
                      const float bbr = fre * br - fim * bi, bbi = fre * bi + fim * br; k4[j] += wr_ * bbr - wi_ * bbi; }
              }
              u32x2v kw; kw.x = pk2(k4[0], k4[1]); kw.y = pk2(k4[2], k4[3]); const u32x2v zw = {0u, 0u};
              bf16_t* Tg = TOP + (size_t)g * NS5 * KS5;
              for (int t = tau; t < L5; ++t) { const int s = t - tau;
                  *(u32x2v*)(Tg + (size_t)(t * 16 + co) * KS5 + s * 16 + ci0) = kw;
                  if (tau) *(u32x2v*)(Tg + (size_t)(s * 16 + co) * KS5 + t * 16 + ci0) = zw; }
          }
#pragma unroll 4
          for (int i = gtid; i < 16 * L5 * 16 * 64; i += NT) { const int p = i & 63, co = (i >> 6) & 15, t = (i >> 10) & 31, g = i >> 15;
              const S5Coef c = s5_coef(P.in[5], P.in[6], P.in[7], l, g, p); float are, aim; s5_apow_fast(c, (float)(t + 1), are, aim);
              const float cr = cre[(g * 16 + co) * 64 + p], cI = cim[(g * 16 + co) * 64 + p];
              bf16_t* row = TOP + ((size_t)g * NS5 + t * 16 + co) * KS5 + NS5;
              row[p] = (bf16_t)f2bf(cr * are - cI * aim); row[64 + p] = (bf16_t)f2bf(-(cr * aim + cI * are)); }
#pragma unroll 4
          for (int i = gtid; i < 16 * 64 * L5 * 16; i += NT) { const int ci = i & 15, s = (i >> 4) & 31, p = (i >> 9) & 63, g = i >> 15;
              const S5Coef c = s5_coef(P.in[5], P.in[6], P.in[7], l, g, p); float are, aim, fre, fim; s5_apow_fast(c, (float)(L5 - 1 - s), are, aim); s5_f_fast(c, fre, fim);
              const float br = bre[(g * 64 + p) * 16 + ci], bi = bim[(g * 64 + p) * 16 + ci]; const float bbr = fre * br - fim * bi, bbi = fre * bi + fim * br;
              bf16_t* base = MOP + (size_t)g * 256 * NS5 + s * 16 + ci;
              base[(size_t)p * NS5] = (bf16_t)f2bf(are * bbr - aim * bbi); base[(size_t)(64 + p) * NS5] = (bf16_t)f2bf(are * bbi + aim * bbr); }
          for (int g = 0; g < 16; ++g) zero_job(MOP + (size_t)g * 256 * NS5 + 128 * NS5, (size_t)128 * NS5 * 2 / 16, gtid, NT);
        }
#undef gw
#undef NGW
#undef gtid
#undef NT
    }
    { float* LUT = (float*)(ws + WS_LUT); const float* tab = P.in[1];
      for (int i = gtid; i < 8 * 132; i += NT) { const int hq = i / 132, dd = i - hq * 132; LUT[i] = tab[t5_bucket(dd < 128 ? dd : 128) * 8 + hq] * LOG2E; } }
}

__device__ __forceinline__ void lru_conv_job(const bf16_t* LX, const float* cw, const float* cb, bf16_t* XC, int gtid, int NT) {
    for (int i = gtid; i < M * 32; i += NT) { const int row = i >> 5, c8 = (i & 31) * 8, t = row & 2047;
        float acc[8];
#pragma unroll
        for (int j = 0; j < 8; ++j) acc[j] = cb[c8 + j];
#pragma unroll
        for (int k = 0; k < 4; ++k) { const int dt = k - 3; if (t + dt >= 0) { float xv[8]; unpack8(*(const v4u*)(LX + (size_t)(row + dt) * 256 + c8), xv);
#pragma unroll
            for (int j = 0; j < 8; ++j) acc[j] += cw[k * 256 + c8 + j] * xv[j]; } }
        *(v4u*)(XC + (size_t)row * 256 + c8) = pack8(acc); }
}
__device__ __forceinline__ void lru_conv_tile(const bf16_t* LX, const float* cw, const float* cb, bf16_t* XC, int row0, int tid) {
    const int c8 = (tid & 31) * 8, r0 = row0 + (tid >> 5) * 16; const bool halo = (r0 & 2047) != 0;
    v4u xr[19];
#pragma unroll
    for (int i = 0; i < 19; ++i) { const v4u z = {0u, 0u, 0u, 0u}; xr[i] = (i >= 3 || halo) ? *(const GAS v4u*)(LX + (size_t)(r0 + i - 3) * 256 + c8) : z; }
    float w[4][8], bias[8];
#pragma unroll
    for (int k = 0; k < 4; ++k)
#pragma unroll
        for (int j = 0; j < 8; ++j) w[k][j] = cw[k * 256 + c8 + j];
#pragma unroll
    for (int j = 0; j < 8; ++j) bias[j] = cb[c8 + j];
#pragma unroll
    for (int i = 0; i < 16; ++i) { float acc[8];
#pragma unroll
        for (int j = 0; j < 8; ++j) acc[j] = bias[j];
#pragma unroll
        for (int k = 0; k < 4; ++k) { float xv[8]; unpack8(xr[i + k], xv);
#pragma unroll
            for (int j = 0; j < 8; ++j) acc[j] += w[k][j] * xv[j]; }
        *(v4u*)(XC + (size_t)(r0 + i) * 256 + c8) = pack8(acc); }
}
__device__ __forceinline__ void s5_scan_job(const float* SLOC, const float* a32, bf16_t* AS5, int gtid, int NT) {
    for (int i = gtid; i < 16 * 16 * 64; i += NT) { const int p = i & 63, gb = i >> 6, g = gb >> 4;
        const float ar = a32[2 * (g * 64 + p)], aI = a32[2 * (g * 64 + p) + 1]; float hr = 0.f, hi = 0.f;
#pragma unroll 1
        for (int c0 = 0; c0 < NCH; c0 += 16) { float sr[16], si[16];
#pragma unroll
            for (int k = 0; k < 16; ++k) { const size_t R = (size_t)gb * 64 + c0 + k; sr[k] = SLOC[R * 128 + p]; si[k] = SLOC[R * 128 + 64 + p]; }
#pragma unroll
            for (int k = 0; k < 16; ++k) { const size_t R = (size_t)gb * 64 + c0 + k;
                AS5[R * KS5 + NS5 + p] = (bf16_t)f2bf(hr); AS5[R * KS5 + NS5 + 64 + p] = (bf16_t)f2bf(hi);
                const float nr = ar * hr - aI * hi + sr[k], ni = ar * hi + aI * hr + si[k]; hr = nr; hi = ni; } } }
}
__device__ __forceinline__ void compress2_job(const float* H1C, const float* w2k, const float* w2v, bf16_t* KCC, bf16_t* VCT, int gtid, int NT) {
    for (int i = gtid; i < 2 * 32 * 128 * 64; i += NT) { const int j = i & 63, n = (i >> 6) & 127, bh = (i >> 13) & 31, kv = i >> 18;
        const float* h = H1C + ((size_t)(kv * 32 + bh) * 128 + n) * 64; const float* w2 = kv ? w2v : w2k; float s = 0.f;
        if (n < 127) {
#pragma unroll 32
            for (int k = 0; k < 64; ++k) s += h[k] * w2[k * 64 + j]; }
        if (kv == 0) KCC[((size_t)bh * 128 + n) * 64 + j] = (bf16_t)f2bf(s); else VCT[((size_t)bh * 64 + j) * 128 + n] = (bf16_t)f2bf(s); }
}
__device__ __forceinline__ void lru_scan_job(const bf16_t* LA, const bf16_t* LB, const bf16_t* LG, bf16_t* MIX, LAS unsigned char* lds, int tid, int vb, int nvb) {
    LAS float* sP = (LAS float*)lds; LAS float* sH = sP + 128 * 32; LAS float* sC = sH + 128 * 32; LAS float* gP = sC + 128 * 32; LAS float* gH = gP + 256; LAS float* gC = gH + 256;
    const int k = tid >> 2, q = tid & 3;
    for (int it = vb; it < NB * 8; it += nvb) { const int b = it >> 3, ch0 = (it & 7) * 32 + q * 8;
        const size_t base = ((size_t)b * 2048 + k * 16) * 256 + ch0;
        float Pp[8], Hh[8];
#pragma unroll
        for (int j = 0; j < 8; ++j) { Pp[j] = 1.f; Hh[j] = 0.f; }
#pragma unroll 1
        for (int hfp = 0; hfp < 2; ++hfp) {
            v4u la[8], lb[8];
#pragma unroll
            for (int i = 0; i < 8; ++i) { la[i] = *(const GAS v4u*)(LA + base + (size_t)(8 * hfp + i) * 256); lb[i] = *(const GAS v4u*)(LB + base + (size_t)(8 * hfp + i) * 256); }
#pragma unroll
            for (int i = 0; i < 8; ++i) { float av[8], bv[8]; unpack8(la[i], av); unpack8(lb[i], bv);
#pragma unroll
                for (int j = 0; j < 8; ++j) { const float a = 1.0f - av[j]; Hh[j] = a * Hh[j] + bv[j]; Pp[j] *= a; } } }
#pragma unroll
        for (int j = 0; j < 8; ++j) { sP[k * 32 + q * 8 + j] = Pp[j]; sH[k * 32 + q * 8 + j] = Hh[j]; }
        __syncthreads();
        if (tid < 256) { const int c = tid & 31, sg = tid >> 5; float p = 1.f, h = 0.f;
#pragma unroll
            for (int kk = 0; kk < 16; ++kk) { const float pp = sP[(sg * 16 + kk) * 32 + c], hh = sH[(sg * 16 + kk) * 32 + c]; h = pp * h + hh; p *= pp; }
            gP[sg * 32 + c] = p; gH[sg * 32 + c] = h; }
        __syncthreads();
        if (tid < 32) { float h = 0.f;
#pragma unroll
            for (int sg = 0; sg < 8; ++sg) { gC[sg * 32 + tid] = h; h = gP[sg * 32 + tid] * h + gH[sg * 32 + tid]; } }
        __syncthreads();
        if (tid < 256) { const int c = tid & 31, sg = tid >> 5; float h = gC[sg * 32 + c];
#pragma unroll
            for (int kk = 0; kk < 16; ++kk) { sC[(sg * 16 + kk) * 32 + c] = h; h = sP[(sg * 16 + kk) * 32 + c] * h + sH[(sg * 16 + kk) * 32 + c]; } }
        __syncthreads();
#pragma unroll
        for (int j = 0; j < 8; ++j) Hh[j] = sC[k * 32 + q * 8 + j];
#pragma unroll 1
        for (int hfp = 0; hfp < 2; ++hfp) {
            v4u la[8], lb[8], lg[8];
#pragma unroll
            for (int i = 0; i < 8; ++i) { const size_t o = base + (size_t)(8 * hfp + i) * 256; la[i] = *(const GAS v4u*)(LA + o); lb[i] = *(const GAS v4u*)(LB + o); lg[i] = *(const GAS v4u*)(LG + o); }
#pragma unroll
            for (int i = 0; i < 8; ++i) { float av[8], bv[8], gv[8], y[8]; unpack8(la[i], av); unpack8(lb[i], bv); unpack8(lg[i], gv);
#pragma unroll
                for (int j = 0; j < 8; ++j) { Hh[j] = (1.0f - av[j]) * Hh[j] + bv[j]; y[j] = Hh[j] * gv[j]; }
                *(v4u*)(MIX + ((size_t)b * 2048 + k * 16 + 8 * hfp + i) * D + 768 + ch0) = pack8(y); } }
        __syncthreads(); }
}
__device__ __forceinline__ void final_norm_job(const bf16_t* XN, float* OUT, const float* RS, const float* gain, int gw, int NGW, int lane) {
    f32x4 gv[4];
#pragma unroll
    for (int j = 0; j < 4; ++j) gv[j] = ((const f32x4*)gain)[64 * j + lane];
    for (int m0 = gw * 4; m0 < M; m0 += NGW * 4) { u32x2v v[4][4]; float s[4];
#pragma unroll
        for (int q = 0; q < 4; ++q) { s[q] = lane < 16 ? RS[(size_t)(m0 + q) * 16 + lane] : 0.f; const u32x2v* hr = (const u32x2v*)(XN + (size_t)(m0 + q) * D) + lane;
#pragma unroll
            for (int j = 0; j < 4; ++j) v[q][j] = hr[64 * j]; }
#pragma unroll
        for (int q = 0; q < 4; ++q) { const float rs = rsqrtf(wave_sum(s[q]) * (1.0f / 1024.0f) + 1e-6f); f32x4* orow = (f32x4*)(OUT + (size_t)(m0 + q) * D) + lane;
#pragma unroll
            for (int j = 0; j < 4; ++j) { f32x4 o; o.x = bf2f(v[q][j].x & 0xffffu); o.y = bf2f(v[q][j].x >> 16); o.z = bf2f(v[q][j].y & 0xffffu); o.w = bf2f(v[q][j].y >> 16); o = o * rs; o = o * gv[j]; orow[64 * j] = o; } } }
}

__device__ __forceinline__ void final_norm_panel(const bf16_t* XN, float* OUT, const float* RS, const float* gain, int m_lo, int wave, int lane) {
    f32x4 gv[4];
#pragma unroll
    for (int j = 0; j < 4; ++j) gv[j] = ((const f32x4*)gain)[64 * j + lane];
    for (int m0 = m_lo + wave * 4; m0 < m_lo + 256; m0 += NWAVES * 4) { u32x2v v[4][4]; float s[4];
#pragma unroll
        for (int q = 0; q < 4; ++q) { s[q] = lane < 16 ? RS[(size_t)(m0 + q) * 16 + lane] : 0.f; const u32x2v* hr = (const u32x2v*)(XN + (size_t)(m0 + q) * D) + lane;
#pragma unroll
            for (int j = 0; j < 4; ++j) v[q][j] = hr[64 * j]; }
#pragma unroll
        for (int q = 0; q < 4; ++q) { const float rs = rsqrtf(wave_sum(s[q]) * (1.0f / 1024.0f) + 1e-6f); f32x4* orow = (f32x4*)(OUT + (size_t)(m0 + q) * D) + lane;
#pragma unroll
            for (int j = 0; j < 4; ++j) { f32x4 o; o.x = bf2f(v[q][j].x & 0xffffu); o.y = bf2f(v[q][j].x >> 16); o.z = bf2f(v[q][j].y & 0xffffu); o.w = bf2f(v[q][j].y >> 16); o = o * rs; o = o * gv[j]; orow[64 * j] = o; } } }
}

__device__ __forceinline__ float wave_max(float v) {
#pragma unroll
    for (int o = 1; o < 64; o <<= 1) v = fmaxf(v, __shfl_xor(v, o));
    return v;
}
struct MbCmp { int t; __device__ __forceinline__ int operator()(int, int n) const { return t - (16 * n + 31); }
               __device__ __forceinline__ int tp(int i) const { return 64 * i; } };
struct MbSel { int t; unsigned ok; unsigned long long selp;
               __device__ __forceinline__ int operator()(int i, int pos) const { return ((ok >> i) & 1u) ? t - pos : -1; }
               __device__ __forceinline__ int tp(int i) const { return 64 * (int)((selp >> (5 * i)) & 31ull); } };
struct MbWin { int t, first; __device__ __forceinline__ int operator()(int, int pos) const { const int d = t - pos; return d < 256 ? d : -1; }
               __device__ __forceinline__ int tp(int i) const { return 64 * (first + i); } };
template <class MB>
__device__ __forceinline__ void nsa_branch(const int ntiles, const bf16_t* Kb, const bf16_t* VTb, const int vpitch, const MB mb, const int hq0,
                                           const LAS float* q_lds, LAS float* P_lds, const LAS float* lut, const int lane, float (&o)[4], float (&inv)[4]) {
    float mx[4] = {-1e30f, -1e30f, -1e30f, -1e30f};
#pragma unroll 1
    for (int i = 0; i < ntiles; ++i) {
        const int pos = mb.tp(i) + lane; const int dist = mb(i, pos);
        const bf16_t* kp = Kb + (size_t)pos * 64; float a0 = 0.f, a1 = 0.f, a2 = 0.f, a3 = 0.f;
#pragma unroll 1
        for (int c = 0; c < 8; ++c) { float kd[8]; unpack8(*(const v4u*)(kp + 8 * c), kd);
#pragma unroll
            for (int j = 0; j < 8; ++j) { const f32x4 q4 = *(const LAS f32x4*)(q_lds + (8 * c + j) * 4); a0 += q4.x * kd[j]; a1 += q4.y * kd[j]; a2 += q4.z * kd[j]; a3 += q4.w * kd[j]; } }
        f32x4 sv = {-1e30f, -1e30f, -1e30f, -1e30f};
        if (dist >= 0) { const int dd = dist < 128 ? dist : 128;
            sv.x = a0 + lut[(hq0 + 0) * 132 + dd]; sv.y = a1 + lut[(hq0 + 1) * 132 + dd]; sv.z = a2 + lut[(hq0 + 2) * 132 + dd]; sv.w = a3 + lut[(hq0 + 3) * 132 + dd];
            mx[0] = fmaxf(mx[0], sv.x); mx[1] = fmaxf(mx[1], sv.y); mx[2] = fmaxf(mx[2], sv.z); mx[3] = fmaxf(mx[3], sv.w); }
        *(LAS f32x4*)(P_lds + (i * 64 + lane) * 4) = sv;
    }
    float sum[4] = {0.f, 0.f, 0.f, 0.f};
#pragma unroll
    for (int g = 0; g < 4; ++g) mx[g] = wave_max(mx[g]);
    asm volatile("s_waitcnt lgkmcnt(0)" ::: "memory");
#pragma unroll 1
    for (int i = 0; i < ntiles; ++i) { f32x4 sv = *(LAS f32x4*)(P_lds + (i * 64 + lane) * 4);
        sv.x = sv.x > -1e29f ? exp2f(sv.x - mx[0]) : 0.f; sv.y = sv.y > -1e29f ? exp2f(sv.y - mx[1]) : 0.f; sv.z = sv.z > -1e29f ? exp2f(sv.z - mx[2]) : 0.f; sv.w = sv.w > -1e29f ? exp2f(sv.w - mx[3]) : 0.f;
        sum[0] += sv.x; sum[1] += sv.y; sum[2] += sv.z; sum[3] += sv.w; *(LAS f32x4*)(P_lds + (i * 64 + lane) * 4) = sv; }
#pragma unroll
    for (int g = 0; g < 4; ++g) { sum[g] = wave_sum(sum[g]); inv[g] = sum[g] > 0.f ? 1.0f / sum[g] : 0.f; }
    asm volatile("s_waitcnt lgkmcnt(0)" ::: "memory");
    const bf16_t* vp = VTb + (size_t)lane * vpitch; float t0 = 0.f, t1 = 0.f, t2 = 0.f, t3 = 0.f;
#pragma unroll 1
    for (int i = 0; i < ntiles; ++i) { const int tp = mb.tp(i);
#pragma unroll 1
        for (int kk = 0; kk < 8; ++kk) { float vv[8]; unpack8(*(const v4u*)(vp + tp + 8 * kk), vv);
#pragma unroll
            for (int j = 0; j < 8; ++j) { const f32x4 p4 = *(const LAS f32x4*)(P_lds + (i * 64 + 8 * kk + j) * 4); t0 += p4.x * vv[j]; t1 += p4.y * vv[j]; t2 += p4.z * vv[j]; t3 += p4.w * vv[j]; } } }
    o[0] += t0 * inv[0]; o[1] += t1 * inv[1]; o[2] += t2 * inv[2]; o[3] += t3 * inv[3];
    asm volatile("s_waitcnt lgkmcnt(0)" ::: "memory");
}
__device__ __forceinline__ void nsa_ref_job(const bf16_t* Q, const bf16_t* KCC, const bf16_t* VCT, const bf16_t* KS, const bf16_t* VST, const bf16_t* KW, const bf16_t* VWT,
                                            const float* GATES, const float* LUT, bf16_t* MIX, LAS unsigned char* lds, int lane, int wave, int gw, int NGW) {
    LAS float* q_lds = (LAS float*)(lds + wave * 16384); LAS float* P_lds = q_lds + 256; LAS float* lut = P_lds + 2048;
    for (int i = lane; i < 8 * 132; i += 64) lut[i] = LUT[i];
    asm volatile("s_waitcnt vmcnt(0) lgkmcnt(0)" ::: "memory");
#pragma unroll 1
    for (int it = gw; it < NB * 2 * SEQ; it += NGW) {
        const int t = it & 2047, bh = it >> 11, b = bh >> 1, h = bh & 1, cur = t >> 6; const size_t m = (size_t)b * 2048 + t;
        { const u32x2v qw = *(const u32x2v*)(Q + m * 512 + h * 256 + lane * 4); const int g = lane >> 4, d0 = (lane & 15) * 4;
          q_lds[(d0 + 0) * 4 + g] = bf2f(qw.x & 0xffffu); q_lds[(d0 + 1) * 4 + g] = bf2f(qw.x >> 16); q_lds[(d0 + 2) * 4 + g] = bf2f(qw.y & 0xffffu); q_lds[(d0 + 3) * 4 + g] = bf2f(qw.y >> 16); }
        const float gate = lane < 12 ? GATES[m * 32 + h * 12 + lane] : 0.f;
        asm volatile("s_waitcnt lgkmcnt(0)" ::: "memory");
        float oc[4] = {0.f, 0.f, 0.f, 0.f}, os[4] = {0.f, 0.f, 0.f, 0.f}, ow[4] = {0.f, 0.f, 0.f, 0.f}, inv[4];
        nsa_branch(2, KCC + (size_t)bh * 128 * 64, VCT + (size_t)bh * 64 * 128, 128, MbCmp{t}, h * 4, q_lds, P_lds, lut, lane, oc, inv);
        float sc = -3e38f;
        if (lane < 32) { float imp = 0.f;
#pragma unroll
            for (int k = -1; k <= 3; ++k) { const int n = 4 * lane + k; if (n >= 0) { const f32x4 p4 = *(const LAS f32x4*)(P_lds + n * 4); imp += (p4.x * inv[0] + p4.y * inv[1]) + (p4.z * inv[2] + p4.w * inv[3]); } }
            const bool avail = 64 * lane <= t, forced = (lane == 0) | (lane == cur) | (lane == cur - 1);
            sc = avail ? imp + (forced ? 1e4f : 0.f) : -1e9f; }
        unsigned long long selp = 0ull; unsigned okm = 0u;
#pragma unroll
        for (int r = 0; r < 8; ++r) { const float mv = wave_max(sc); const unsigned long long bal = __ballot(sc == mv); const int idx = __builtin_amdgcn_readfirstlane(__ffsll((long long)bal) - 1);
            selp |= (unsigned long long)(idx & 31) << (5 * r); if (mv > -5e8f) okm |= 1u << r; if (lane == idx) sc = -3e38f; }
        asm volatile("s_waitcnt lgkmcnt(0)" ::: "memory");
        nsa_branch(8, KS + (size_t)bh * 2048 * 64, VST + (size_t)bh * 64 * 2048, 2048, MbSel{t, okm, selp}, h * 4, q_lds, P_lds, lut, lane, os, inv);
        { const int first = (t > 255 ? t - 255 : 0) >> 6;
          nsa_branch(cur - first + 1, KW + (size_t)bh * 2048 * 64, VWT + (size_t)bh * 64 * 2048, 2048, MbWin{t, first}, h * 4, q_lds, P_lds, lut, lane, ow, inv); }
#pragma unroll
        for (int g = 0; g < 4; ++g) { const float r = __shfl(gate, 3 * g) * oc[g] + __shfl(gate, 3 * g + 1) * os[g] + __shfl(gate, 3 * g + 2) * ow[g];
            MIX[m * D + 256 + (h * 4 + g) * 64 + lane] = (bf16_t)f2bf(r); }
    }
}

namespace nsa {
typedef short bf16x8 __attribute__((ext_vector_type(8)));
typedef float f32x16 __attribute__((ext_vector_type(16)));
constexpr int KROW = 144, VROW = 144, VROWC = 272;
constexpr int L_K = 0, L_V = 2 * 64 * KROW, L_CK = L_V + 2 * 64 * VROW, L_CV = L_CK + 128 * KROW, L_WK = L_CV + 64 * VROWC, L_WV = L_WK + 64 * KROW, L_LUT = L_WV + 64 * VROW, L_IMP = L_LUT + 8 * 132 * 4, L_END = L_IMP + 4 * 64 * 33 * 4;
constexpr int L_SEL = RING_BYTES + 1024, L_GATE = L_SEL + 256, L_END2 = L_GATE + 2 * 64 * 12 * 4;
static_assert(8 * 4096 <= 4 * 64 * 33 * 4 && L_END <= RING_BYTES && L_END2 <= LDS_BYTES && (L_LUT % 16) == 0 && (L_IMP % 16) == 0 && (L_CK % 16) == 0 && (L_CV % 16) == 0 && (L_WK % 16) == 0 && (L_WV % 16) == 0, "nsa LDS map");
__device__ __forceinline__ bf16x8 pk8(const f32x16& p, int o) {
    v4u w; w.x = pg8::cvt_pk_bf16(p[o], p[o + 1]); w.y = pg8::cvt_pk_bf16(p[o + 2], p[o + 3]); w.z = pg8::cvt_pk_bf16(p[o + 4], p[o + 5]); w.w = pg8::cvt_pk_bf16(p[o + 6], p[o + 7]);
    return __builtin_bit_cast(bf16x8, w); }
__device__ __forceinline__ bf16x8 ld_b128(const LAS unsigned char* p) { return *(const LAS bf16x8*)p; }
__device__ __forceinline__ bf16x8 ld_2b64(const LAS unsigned char* p) { u32x2v a = *(const LAS u32x2v*)p, b = *(const LAS u32x2v*)(p + 16); v4u w; w.x = a.x; w.y = a.y; w.z = b.x; w.w = b.y; return __builtin_bit_cast(bf16x8, w); }

__device__ __forceinline__ void step(const int MODE, const LAS unsigned char* KL, const LAS unsigned char* VL, const LAS float* lut_h, const bf16x8 (&qf)[4], const int lane, const int t, const int pos0, const bool selbit, const float bias_far,
                                     const bool first, float& mrun, float& lrun, f32x16 (&O)[2]) {
    const int r32 = lane & 31, hh = lane >> 5;
    const float c0 = (MODE != 3 && !selbit) ? -1e30f : ((MODE == 0 || MODE == 3) ? bias_far - mrun : -mrun);
    f32x16 sc[2];
    { bf16x8 kf[2][4];
#pragma unroll
      for (int kt = 0; kt < 2; ++kt)
#pragma unroll
          for (int s = 0; s < 4; ++s) kf[kt][s] = ld_b128(KL + (32 * kt + r32) * KROW + (16 * s + 8 * hh) * 2);
#ifdef PROBE_NSA_LDS2
      { bf16x8 k2[2][4];
#pragma unroll
        for (int kt = 0; kt < 2; ++kt)
#pragma unroll
            for (int s = 0; s < 4; ++s) { k2[kt][s] = ld_b128(KL + (32 * kt + (r32 ^ 1)) * KROW + (16 * s + 8 * hh) * 2); asm volatile("" :: "v"(k2[kt][s])); } }
#endif
#pragma unroll
      for (int kt = 0; kt < 2; ++kt) {
#pragma unroll
          for (int r = 0; r < 16; ++r) sc[kt][r] = c0; }
      __builtin_amdgcn_s_setprio(1);
#pragma unroll
      for (int kt = 0; kt < 2; ++kt) {
#pragma unroll
          for (int s = 0; s < 4; ++s) sc[kt] = __builtin_amdgcn_mfma_f32_32x32x16_bf16(kf[kt][s], qf[s], sc[kt], 0, 0, 0);
      }
      __builtin_amdgcn_s_setprio(0);
#ifdef PROBE_NSA_MFMA2
      { f32x16 d2[2];
#pragma unroll
        for (int kt = 0; kt < 2; ++kt) {
#pragma unroll
            for (int r = 0; r < 16; ++r) d2[kt][r] = c0;
#pragma unroll
            for (int s = 0; s < 4; ++s) d2[kt] = __builtin_amdgcn_mfma_f32_32x32x16_bf16(kf[kt][s], qf[3 - s], d2[kt], 0, 0, 0);
            asm volatile("" :: "v"(d2[kt][0])); } }
#endif
    }
    bf16x8 vf0[2][2], vf1[2][2];
#pragma unroll
    for (int s2 = 0; s2 < 2; ++s2)
#pragma unroll
        for (int dt = 0; dt < 2; ++dt) vf0[s2][dt] = ld_b128(VL + (32 * dt + r32) * VROW + 32 * s2 + 16 * hh);
    __builtin_amdgcn_sched_barrier(0);
    if (MODE == 1) {
#pragma unroll
        for (int kt = 0; kt < 2; ++kt)
#pragma unroll
            for (int r = 0; r < 16; ++r) { const int dist = t - (pos0 + 32 * kt + (r & 3) + 8 * (r >> 2) + 4 * hh); sc[kt][r] = dist >= 0 ? sc[kt][r] + lut_h[dist < 0 ? 0 : dist] : -1e30f; }
    } else if (MODE == 4) {
#pragma unroll
        for (int kt = 0; kt < 2; ++kt)
#pragma unroll
            for (int r = 0; r < 16; ++r) { const int dist = t - (pos0 + 32 * kt + (r & 3) + 8 * (r >> 2) + 4 * hh); sc[kt][r] += lut_h[dist < 128 ? dist : 128]; }
    } else if (MODE == 3) {
#pragma unroll
        for (int kt = 0; kt < 2; ++kt)
#pragma unroll
            for (int r = 0; r < 16; ++r) { const int dist = t - (pos0 + 32 * kt + (r & 3) + 8 * (r >> 2) + 4 * hh); sc[kt][r] = dist < 256 ? sc[kt][r] : -1e30f; }
    }
    float tm = -1e30f;
#pragma unroll
    for (int kt = 0; kt < 2; ++kt)
#pragma unroll
        for (int r = 0; r < 16; ++r) tm = fmaxf(tm, sc[kt][r]);
    tm = fmaxf(tm, __shfl_xor(tm, 32));
    const float delta = (tm > 8.0f || (first && tm > -1e29f)) ? tm : 0.f;
    if (__any(delta != 0.f)) {
#pragma unroll
        for (int kt = 0; kt < 2; ++kt)
#pragma unroll
            for (int r = 0; r < 16; ++r) sc[kt][r] -= delta; }
    const float alpha = __builtin_amdgcn_exp2f(-delta); mrun += delta; lrun *= alpha;
#pragma unroll
    for (int dt = 0; dt < 2; ++dt) O[dt] = O[dt] * alpha;
    f32x16 pacc;
#pragma unroll
    for (int r = 0; r < 16; ++r) { sc[0][r] = __builtin_amdgcn_exp2f(sc[0][r]); }
    __builtin_amdgcn_sched_barrier(0);
#pragma unroll
    for (int s2 = 0; s2 < 2; ++s2)
#pragma unroll
        for (int dt = 0; dt < 2; ++dt) vf1[s2][dt] = ld_b128(VL + (32 * dt + r32) * VROW + 64 + 32 * s2 + 16 * hh);
    __builtin_amdgcn_sched_barrier(0);
#pragma unroll
    for (int r = 0; r < 16; ++r) { sc[1][r] = __builtin_amdgcn_exp2f(sc[1][r]); }
#ifdef PROBE_NSA_EXP2
#pragma unroll
    for (int r = 0; r < 16; ++r) { float e0 = __builtin_amdgcn_exp2f(sc[0][r] * 0.5f), e1 = __builtin_amdgcn_exp2f(sc[1][r] * 0.5f); asm volatile("" :: "v"(e0), "v"(e1)); }
#endif
    pacc = sc[0] + sc[1];
    lrun += ((pacc[0] + pacc[1]) + (pacc[2] + pacc[3])) + ((pacc[4] + pacc[5]) + (pacc[6] + pacc[7])) + (((pacc[8] + pacc[9]) + (pacc[10] + pacc[11])) + ((pacc[12] + pacc[13]) + (pacc[14] + pacc[15])));
#pragma unroll
    for (int s2 = 0; s2 < 2; ++s2) { const bf16x8 pf = pk8(sc[0], 8 * s2);
#pragma unroll
        for (int dt = 0; dt < 2; ++dt) O[dt] = __builtin_amdgcn_mfma_f32_32x32x16_bf16(vf0[s2][dt], pf, O[dt], 0, 0, 0); }
#pragma unroll
    for (int s2 = 0; s2 < 2; ++s2) { const bf16x8 pf = pk8(sc[1], 8 * s2);
#pragma unroll
        for (int dt = 0; dt < 2; ++dt) O[dt] = __builtin_amdgcn_mfma_f32_32x32x16_bf16(vf1[s2][dt], pf, O[dt], 0, 0, 0); }
}
struct Stage { v4u k, v; };
__device__ __forceinline__ Stage stage_load(const bf16_t* Ksrc, const bf16_t* VTsrc, int vpitch, int tid) { Stage s; const int r = tid >> 3, c = tid & 7;
    s.k = *(const GAS v4u*)(Ksrc + r * 64 + c * 8); s.v = *(const GAS v4u*)(VTsrc + (size_t)r * vpitch + c * 8); return s; }
__device__ __forceinline__ void stage_store(LAS unsigned char* KL, LAS unsigned char* VL, const Stage& s, int tid) { const int r = tid >> 3, c = tid & 7;
    *(LAS v4u*)(KL + r * KROW + c * 16) = s.k; u32x2v a, b; a.x = s.v.x; a.y = s.v.y; b.x = s.v.z; b.y = s.v.w; *(LAS u32x2v*)(VL + r * VROW + (c >> 1) * 32 + (c & 1) * 8) = a; *(LAS u32x2v*)(VL + r * VROW + (c >> 1) * 32 + (c & 1) * 8 + 16) = b; }

__device__ __forceinline__ void job(unsigned char* w, LAS unsigned char* lds, const int tid0, const int wave, const int bid, const int G) {
#define NSA_P(T, off) ((T*)(w + (off)))
    const int g = wave & 3, qh = wave >> 2;
    LAS float* lut = (LAS float*)(lds + L_LUT); LAS float* IMP = (LAS float*)(lds + L_IMP); LAS unsigned* SELM = (LAS unsigned*)(lds + L_SEL);
    for (int i = tid0; i < 8 * 132; i += NTHREADS) lut[i] = NSA_P(const float, WS_LUT)[i];
    __syncthreads();
#pragma unroll 1
    for (int rnd = 0; rnd * G + bid < NB * 2 * 32; ++rnd) {
        const int tid = wave * 64 + pg8::lane_id();
        const int lane = tid & 63, r32 = lane & 31, hh = lane >> 5;
        const int vcu = (G & 7) == 0 ? (bid & 7) * (G >> 3) + (bid >> 3) : bid;
        const int itr = rnd * G + vcu, bh = itr >> 5, qb0 = itr & 31, qb = (rnd & 1) ? 31 - qb0 : qb0, b = bh >> 1, h = bh & 1, hq = h * 4 + g;
        const int t = 64 * qb + 32 * qh + r32; const size_t m = (size_t)b * 2048 + t;
        const LAS float* lut_h = lut + hq * 132;
        LAS float* GL = (LAS float*)(lds + L_GATE + (rnd & 1) * 64 * 12 * 4);
        if (tid < 192) { const int qq = tid / 3, w3 = tid - 3 * qq; *(LAS f32x4*)(GL + qq * 12 + 4 * w3) = *(const GAS f32x4*)(NSA_P(const float, WS_GATES) + ((size_t)b * 2048 + 64 * qb + qq) * 32 + h * 12 + 4 * w3); }
        bf16x8 qf[4];
#pragma unroll
        for (int s = 0; s < 4; ++s) qf[s] = *(const GAS bf16x8*)(NSA_P(const bf16_t, WS_Q) + m * 512 + hq * 64 + 16 * s + 8 * hh);
        f32x16 OT[2];
        const bf16_t* Ksb = NSA_P(const bf16_t, WS_KS) + (size_t)bh * 2048 * 64; const bf16_t* Vsb = NSA_P(const bf16_t, WS_VST) + (size_t)bh * 64 * 2048;
        const bf16_t* Kwb = NSA_P(const bf16_t, WS_KW) + (size_t)bh * 2048 * 64; const bf16_t* Vwb = NSA_P(const bf16_t, WS_VWT) + (size_t)bh * 64 * 2048;
        { const bf16_t* Kc = NSA_P(const bf16_t, WS_KCC) + (size_t)bh * 128 * 64; const bf16_t* Vc = NSA_P(const bf16_t, WS_VCT) + (size_t)bh * 64 * 128;
          v4u ck[2], cv[2];
#pragma unroll
          for (int u = 0; u < 2; ++u) { const int idx = tid + u * NTHREADS; ck[u] = *(const GAS v4u*)(Kc + (idx >> 3) * 64 + (idx & 7) * 8); cv[u] = *(const GAS v4u*)(Vc + (idx >> 4) * 128 + (idx & 15) * 8); }
          const Stage s0 = stage_load(Ksb, Vsb, 2048, tid); const Stage w0 = stage_load(Kwb + (size_t)qb * 64 * 64, Vwb + qb * 64, 2048, tid);
#pragma unroll
          for (int u = 0; u < 2; ++u) { const int idx = tid + u * NTHREADS, r = idx >> 3, c = idx & 7, rv = idx >> 4, cvv = idx & 15; *(LAS v4u*)(lds + L_CK + r * KROW + c * 16) = ck[u];
              u32x2v a, bq; a.x = cv[u].x; a.y = cv[u].y; bq.x = cv[u].z; bq.y = cv[u].w; *(LAS u32x2v*)(lds + L_CV + rv * VROWC + (cvv >> 1) * 32 + (cvv & 1) * 8) = a; *(LAS u32x2v*)(lds + L_CV + rv * VROWC + (cvv >> 1) * 32 + (cvv & 1) * 8 + 16) = bq; }
          stage_store(lds + L_K, lds + L_V, s0, tid); stage_store(lds + L_WK, lds + L_WV, w0, tid);
          __syncthreads();
          f32x16 sc[4]; float mx = -1e30f;
#pragma unroll
          for (int kt = 0; kt < 4; ++kt) {
#pragma unroll
              for (int r = 0; r < 16; ++r) sc[kt][r] = -1e30f;
              if (512 * kt + 31 <= 64 * qb + 63) {
#pragma unroll
              for (int r = 0; r < 16; ++r) sc[kt][r] = 0.f;
#pragma unroll
              for (int s = 0; s < 4; ++s) sc[kt] = __builtin_amdgcn_mfma_f32_32x32x16_bf16(ld_b128(lds + L_CK + (32 * kt + r32) * KROW + (16 * s + 8 * hh) * 2), qf[s], sc[kt], 0, 0, 0);
#pragma unroll
              for (int r = 0; r < 16; ++r) { const int n = 32 * kt + (r & 3) + 8 * (r >> 2) + 4 * hh, dist = t - (16 * n + 31);
                  sc[kt][r] = dist >= 0 ? sc[kt][r] + lut_h[dist < 128 ? (dist < 0 ? 0 : dist) : 128] : -1e30f; mx = fmaxf(mx, sc[kt][r]); } } }
          mx = fmaxf(mx, __shfl_xor(mx, 32)); const float meff = mx < -1e29f ? 1e30f : mx; float ps = 0.f;
#pragma unroll
          for (int kt = 0; kt < 4; ++kt)
#pragma unroll
              for (int r = 0; r < 16; ++r) { const float p = __builtin_amdgcn_exp2f(sc[kt][r] - meff); sc[kt][r] = p; ps += p; }
          ps += __shfl_xor(ps, 32); const float inv = ps > 0.f ? 1.0f / ps : 0.f;
#pragma unroll
          for (int kt = 0; kt < 4; ++kt)
#pragma unroll
              for (int r = 0; r < 16; ++r) sc[kt][r] *= inv;
          { float eprev = 0.f;
#pragma unroll
            for (int i = 0; i < 16; ++i) { const int kt = i >> 2, a = i & 3; const float Gs = (sc[kt][4 * a] + sc[kt][4 * a + 1]) + (sc[kt][4 * a + 2] + sc[kt][4 * a + 3]); const float e = __shfl_xor(sc[kt][4 * a + 3], 32);
                IMP[(g * 64 + 32 * qh + r32) * 33 + 2 * i + hh] = Gs + (hh ? e : eprev); eprev = e; asm volatile("" ::: "memory"); } }
#pragma unroll
          for (int dt = 0; dt < 2; ++dt)
#pragma unroll
              for (int r = 0; r < 16; ++r) OT[dt][r] = 0.f;
#pragma unroll
          for (int kt = 0; kt < 4; ++kt) if (512 * kt + 31 <= 64 * qb + 63)
#pragma unroll
              for (int s2 = 0; s2 < 2; ++s2) { const bf16x8 pf = pk8(sc[kt], 8 * s2);
#pragma unroll
                  for (int dt = 0; dt < 2; ++dt) OT[dt] = __builtin_amdgcn_mfma_f32_32x32x16_bf16(ld_b128(lds + L_CV + (32 * dt + r32) * VROWC + 64 * kt + 32 * s2 + 16 * hh), pf, OT[dt], 0, 0, 0); }
          const float gate_c = GL[(32 * qh + r32) * 12 + g * 3];
#pragma unroll
          for (int dt = 0; dt < 2; ++dt)
#pragma unroll
              for (int r = 0; r < 16; ++r) OT[dt][r] *= gate_c;
        }
        __syncthreads();
        {
          const int ql = 8 * wave + (lane >> 3), cg4 = 4 * (lane & 7), tq = 64 * qb + ql, cur = qb; float sv[4];
#pragma unroll
          for (int c = 0; c < 4; ++c) { const int j = cg4 + c; const float imp = (IMP[(0 * 64 + ql) * 33 + j] + IMP[(1 * 64 + ql) * 33 + j]) + (IMP[(2 * 64 + ql) * 33 + j] + IMP[(3 * 64 + ql) * 33 + j]);
              const bool avail = 64 * j <= tq, forced = (j == 0) | (j == cur) | (j == cur - 1); sv[c] = avail ? imp + (forced ? 1e4f : 0.f) : -1e9f; }
          unsigned msk = 0u;
#pragma unroll
          for (int rr = 0; rr < 8; ++rr) { float best = sv[0]; int bi = cg4;
#pragma unroll
              for (int c = 1; c < 4; ++c) if (sv[c] > best) { best = sv[c]; bi = cg4 + c; }
#pragma unroll
              for (int o = 1; o < 8; o <<= 1) { const float ov = __shfl_xor(best, o); const int oi = __shfl_xor(bi, o); const bool take = ov > best || (ov == best && oi < bi); best = take ? ov : best; bi = take ? oi : bi; }
              if (best > -5e8f) msk |= 1u << bi;
#pragma unroll
              for (int c = 0; c < 4; ++c) sv[c] = (cg4 + c == bi) ? -3e38f : sv[c]; }
          if ((lane & 7) == 0) SELM[ql] = msk; }
        __syncthreads();
        const unsigned selm = SELM[32 * qh + r32];
        { float mrun = 0.f, lrun = 0.f; f32x16 O[2];
#pragma unroll
          for (int dt = 0; dt < 2; ++dt)
#pragma unroll
              for (int r = 0; r < 16; ++r) O[dt][r] = 0.f;
          const float bias_far = lut_h[128]; int cur = 0;
#pragma unroll 1
          for (int j = 0; j <= qb; ++j) {
              Stage nx; const bool more = j < qb; if (more) nx = stage_load(Ksb + (size_t)(j + 1) * 64 * 64, Vsb + (j + 1) * 64, 2048, tid);
#ifdef PROBE_NSA_GLD2
              if (more) { Stage n2 = stage_load(Ksb + (size_t)(j + 1) * 64 * 64 + 8 * 64, Vsb + (j + 1) * 64 + 2048 * 8, 2048, tid); asm volatile("" :: "v"(n2.k), "v"(n2.v)); }
#endif
#ifdef PROBE_NSA_BAR2
              __syncthreads();
#endif
              const LAS unsigned char* KL = lds + L_K + cur * 64 * KROW; const LAS unsigned char* VL = lds + L_V + cur * 64 * VROW; const bool sb = (selm >> j) & 1u;
              step(j + 3 <= qb ? 0 : (j < qb ? 4 : 1), KL, VL, lut_h, qf, lane, t, 64 * j, sb, bias_far, j == 0, mrun, lrun, O);
              if (more) stage_store(lds + L_K + (cur ^ 1) * 64 * KROW, lds + L_V + (cur ^ 1) * 64 * VROW, nx, tid);
              __syncthreads(); cur ^= 1; }
          lrun += __shfl_xor(lrun, 32); const float sc_ = lrun > 0.f ? GL[(32 * qh + (pg8::lane_id() & 31)) * 12 + g * 3 + 1] / lrun : 0.f;
#pragma unroll
          for (int dt = 0; dt < 2; ++dt)
#pragma unroll
              for (int r = 0; r < 16; ++r) OT[dt][r] += O[dt][r] * sc_; }
        { const int jlo = qb > 4 ? qb - 4 : 0;
          float mrun = 0.f, lrun = 0.f; f32x16 O[2];
#pragma unroll
          for (int dt = 0; dt < 2; ++dt)
#pragma unroll
              for (int r = 0; r < 16; ++r) O[dt][r] = 0.f;
          int cur = 0;
#pragma unroll 1
          for (int j = qb; j >= jlo; --j) {
              Stage nx; const bool more = j > jlo; if (more) nx = stage_load(Kwb + (size_t)(j - 1) * 64 * 64, Vwb + (j - 1) * 64, 2048, tid);
              { const int dl = qb - j; const LAS unsigned char* KL = dl == 0 ? lds + L_WK : lds + L_K + (cur ^ 1) * 64 * KROW; const LAS unsigned char* VL = dl == 0 ? lds + L_WV : lds + L_V + (cur ^ 1) * 64 * VROW;
                step(dl == 0 ? 1 : (dl <= 2 ? 4 : (dl == 3 ? 0 : 3)), KL, VL, lut_h, qf, lane, t, 64 * j, true, lut_h[128], dl == 0, mrun, lrun, O); }
              if (more) stage_store(lds + L_K + cur * 64 * KROW, lds + L_V + cur * 64 * VROW, nx, tid);
              __syncthreads(); cur ^= 1; }
          lrun += __shfl_xor(lrun, 32); const float sc_ = lrun > 0.f ? GL[(32 * qh + (pg8::lane_id() & 31)) * 12 + g * 3 + 2] / lrun : 0.f;
#pragma unroll
          for (int dt = 0; dt < 2; ++dt)
#pragma unroll
              for (int r = 0; r < 16; ++r) OT[dt][r] += O[dt][r] * sc_; }
        { LAS unsigned char* ost = lds + L_IMP + wave * 4096;
          const int l2 = pg8::lane_id(), q2 = l2 & 31, h2 = l2 >> 5;
#pragma unroll
          for (int dt = 0; dt < 2; ++dt)
#pragma unroll
              for (int r = 0; r < 16; r += 2) *(LAS unsigned*)(ost + q2 * 128 + (((32 * dt + 8 * (r >> 2) + 4 * h2 + (r & 3)) * 2) ^ ((q2 & 7) << 4))) = pg8::cvt_pk_bf16(OT[dt][r], OT[dt][r + 1]);
          asm volatile("s_waitcnt lgkmcnt(0)" ::: "memory");
          bf16_t* obase = NSA_P(bf16_t, WS_MIX) + ((size_t)b * 2048 + 64 * qb + 32 * qh) * D + 256 + hq * 64;
#pragma unroll
          for (int i = 0; i < 4; ++i) { const int idx = l2 + 64 * i, qq = idx >> 3, cc = idx & 7; *(v4u*)(obase + (size_t)qq * D + cc * 8) = *(const LAS v4u*)(ost + qq * 128 + ((cc ^ (qq & 7)) << 4)); }
        }
    }
}
#undef NSA_P
}

#ifndef MK_N_LAUNCHES
#define MK_N_LAUNCHES 1
#endif
#ifndef NSA_PAIRED
#define NSA_PAIRED 0
#endif
#ifndef FINAL_FUSED
#define FINAL_FUSED 0
#endif
#ifndef GLU_TAIL
#define GLU_TAIL 1
#endif
#ifndef EN_MASK
#define EN_MASK 0xffff
#endif
#ifdef PROBE_RT_MASK
#define EN(b) (((EN_MASK >> (b)) & 1) && ((args.pad >> (b)) & 1))
#else
#define EN(b) ((EN_MASK >> (b)) & 1)
#endif
#ifndef DUP_MASK
#define DUP_MASK 0
#endif
#define REP(b) for (int rep_ = 0; rep_ < 1 + ((DUP_MASK >> (b)) & 1); ++rep_)
#ifndef NSA_REF
#define NSA_REF 0
#endif
#ifndef PG8_ALIGN_
#define PG8_ALIGN_ true
#endif
#ifndef PG8_SP2_
#define PG8_SP2_ true
#endif
constexpr int N_PHASES = 18;
__global__ void __launch_bounds__(NTHREADS, 2) mk_fwd(Args args) {
    extern __shared__ __attribute__((aligned(16))) unsigned char lds_raw[];
    LAS unsigned char* lds = (LAS unsigned char*)lds_raw;
    volatile LAS unsigned* MISC = (volatile LAS unsigned*)(lds + MISC_OFF);
    const int wave = __builtin_amdgcn_readfirstlane((int)threadIdx.x >> 6), bid = blockIdx.x, G = gridDim.x;
#define tid (wave * 64 + pg8::lane_id())
#define gw (bid * NWAVES + wave)
#define NGW (G * NWAVES)
#define NT (G * NTHREADS)
    const int lo = (MK_N_LAUNCHES == 1) ? 0 : args.ph_lo, hi_all = (MK_N_LAUNCHES == 1) ? N_PHASES : args.ph_hi;
    unsigned char* ws = args.ws;
    for (int u = tid; u < (LDS_BYTES - RING_BYTES) / 4; u += NTHREADS) ((LAS unsigned*)(lds + RING_BYTES))[u] = 0u;
    __syncthreads();
    const int bli = (MK_N_LAUNCHES == 1) ? 0 : args.li;
    XcdBarrier bar; bar.bar = (unsigned*)(ws + WS_CTL) + CW_BAR + bli * XCD_BAR_WORDS; bar.x = 0; bar.st = nullptr;
    if (hi_all - lo > 1) bar = xcd_barrier_post((unsigned*)(ws + WS_CTL) + CW_BAR + bli * XCD_BAR_WORDS, MISC + 8);
#define PH(k) (lo <= (k) && (k) < hi)
#define SEAM(k) do { if (PH(k) && PH((k) + 1)) xcd_barrier(bar); } while (0)
    typedef const float* kptr_t; typedef const __attribute__((address_space(4))) kptr_t* kargs_t;
#define OPQ_WS() unsigned char* w = ws; int bid_p = bid; asm volatile("" : "+s"(w), "+s"(bid_p))
#define OPQ_IN() kargs_t inp = (kargs_t)__builtin_amdgcn_kernarg_segment_ptr(); asm volatile("" : "+s"(inp))
#define WP(T, off) ((T*)(w + (off)))
#define OPQ_TID() int tid_p = tid; asm volatile("" : "+v"(tid_p)); const int lane_p = tid_p & 63, gtid_p = bid * NTHREADS + tid_p; (void)lane_p; (void)gtid_p

#ifndef PREFIX_DUP
#define PREFIX_DUP 0
#endif
#pragma unroll 1
    for (int pass_ = (PREFIX_DUP > 0 && lo == 0 && hi_all == N_PHASES) ? 0 : 1; pass_ < 2; ++pass_) {
    const int hi = pass_ == 0 ? PREFIX_DUP : hi_all;
    if (PH(0) && EN(0)) REP(0) { OPQ_TID(); p0_prologue(args, lds, tid_p, lane_p, wave, bid, G, 3); VM_WAIT(); __syncthreads(); }
    if (PH(0) && ((DUP_MASK >> 16) & 1)) { OPQ_TID(); p0_prologue(args, lds, tid_p, lane_p, wave, bid, G, 1); VM_WAIT(); __syncthreads(); }
    if (PH(0) && ((DUP_MASK >> 17) & 1)) { OPQ_TID(); p0_prologue(args, lds, tid_p, lane_p, wave, bid, G, 2); VM_WAIT(); __syncthreads(); }
    SEAM(0);
#pragma unroll 1
    for (int l = 0; l < NLAYER; ++l) {
        const int pb = 1 + 8 * l;
        if (PH(pb + 0) && EN(1)) REP(1) {
            OPQ_WS();
            pg8::Gemm g{WP(bf16_t, WS_XN), WP(bf16_t, WS_WIN + l * SZ_WIN), D, D}; pg8::StaticOrder S; S.init(M, 2048, G, bid_p);
            { OPQ_TID(); rsl_fill(WP(float, WS_RS), S, lds, tid_p); }
            EpiInProj E{w, lds, 0};
            pg8::gemm_phase<EpiInProj, pg8::StaticOrder, PG8_ALIGN_, PG8_SP2_>(lds, g, S, E, wave);
        }
        SEAM(pb + 0);
#ifdef EXTRA_BARS
        for (int xb_ = 0; xb_ < EXTRA_BARS; ++xb_) xcd_barrier(bar);
#endif
        if (PH(pb + 1)) {
            if (EN(5)) REP(5) { OPQ_WS(); OPQ_IN(); OPQ_TID();
              pg8::Gemm g{WP(bf16_t, WS_XC), WP(bf16_t, WS_WLRU + l * SZ_WLRU), 256, 256}; pg8::StaticOrder S; S.init(M, 512, G > 64 ? G - 32 : G, G > 64 ? (bid_p >= 32 ? bid_p - 32 : 1 << 20) : bid_p);
              { Unit u0; for (int i = 0; S.next(i, u0); ++i) lru_conv_tile(WP(bf16_t, WS_LX), inp[20] + l * 4 * 256, inp[21] + l * 256, WP(bf16_t, WS_XC), u0.pm * BM, tid_p); }
              VM_WAIT(); __syncthreads();
              EpiLruGates E{WP(bf16_t, WS_XC), inp[23] + l * 256, inp[25] + l * 256, WP(float, WS_TAB + l * SZ_TAB) + TB_SP, WP(bf16_t, WS_LA), WP(bf16_t, WS_LB)}; pg8::gemm_phase<EpiLruGates, pg8::StaticOrder, PG8_ALIGN_, PG8_SP2_>(lds, g, S, E, wave); }
            if (EN(2)) REP(2) { OPQ_WS(); OPQ_IN(); pg8::Gemm g{WP(bf16_t, WS_KC), WP(bf16_t, WS_W1 + l * SZ_W1), 1024, 2048}; pg8::GroupOrder S; S.init(2, 16, 1, 1, G, bid_p, 0);
              EpiCompress2 E{WP(float, WS_TAB + l * SZ_TAB) + TB_BIAS1, inp[16] + l * 4096, inp[19] + l * 4096, WP(bf16_t, WS_KCC), WP(bf16_t, WS_VCT)}; pg8::gemm_phase<EpiCompress2, pg8::GroupOrder, false, PG8_SP2_>(lds, g, S, E, wave); }
            if (EN(3)) REP(3) { OPQ_WS(); pg8::Gemm g{WP(bf16_t, WS_AS5), WP(bf16_t, WS_MOP + l * SZ_MOP), KS5, NS5}; pg8::GroupOrder S; S.init(16, 4, 1, 1, G, bid_p, 32);
              EpiS5StateScan E{WP(float, WS_TAB + l * SZ_TAB) + TB_A32, WP(bf16_t, WS_AS5)}; pg8::gemm_phase<EpiS5StateScan, pg8::GroupOrder, false, PG8_SP2_>(lds, g, S, E, wave); }
            if (EN(1)) REP(1) { OPQ_WS(); pg8::Gemm g{WP(bf16_t, WS_XN), WP(bf16_t, WS_WIN + l * SZ_WIN) + (size_t)2048 * D, D, D}; pg8::GroupOrder S; S.init(1, 128, 1, 1, G, bid_p, 96);
              EpiGates E{w}; pg8::gemm_phase<EpiGates, pg8::GroupOrder, true, PG8_SP2_>(lds, g, S, E, wave); }
        }
        SEAM(pb + 1);
        if (PH(pb + 3)) {
            if (EN(8)) REP(8) { OPQ_WS(); OPQ_IN(); OPQ_TID(); pg8::Gemm g{WP(bf16_t, WS_AS5), WP(bf16_t, WS_TOP + l * SZ_TOP), KS5, KS5}; pg8::GroupOrder S; S.init(16, 4, 2, 2, G, bid_p, 0);
              EpiS5Main E{WP(bf16_t, WS_AS5), inp[12] + l * 256, WP(bf16_t, WS_YS)}; pg8::gemm_phase<EpiS5Main, pg8::GroupOrder, true, PG8_SP2_>(lds, g, S, E, wave);
              int nun = 0; { Unit uu; while (S.next(nun, uu)) ++nun; }
              VM_WAIT(); __syncthreads();
              if (tid_p == 0) { __builtin_amdgcn_fence(__ATOMIC_RELEASE, "agent"); VM_WAIT(); __hip_atomic_fetch_add((unsigned*)(w + WS_CTL) + CW_CNT + 64 * l, (unsigned)nun, __ATOMIC_RELAXED, __HIP_MEMORY_SCOPE_AGENT); } }
            __syncthreads();
            if (EN(9)) REP(9) { OPQ_WS(); OPQ_TID(); lru_scan_job(WP(bf16_t, WS_LA), WP(bf16_t, WS_LB), WP(bf16_t, WS_LG), WP(bf16_t, WS_MIX), lds, tid_p, bid >= G / 2 ? bid - G / 2 : NB * 8, G - G / 2); }
            __syncthreads();
#if NSA_REF
            if (EN(10)) REP(10) { OPQ_WS(); OPQ_TID(); nsa_ref_job(WP(bf16_t, WS_Q), WP(bf16_t, WS_KCC), WP(bf16_t, WS_VCT), WP(bf16_t, WS_KS), WP(bf16_t, WS_VST), WP(bf16_t, WS_KW), WP(bf16_t, WS_VWT), WP(float, WS_GATES), WP(float, WS_LUT), WP(bf16_t, WS_MIX), lds, lane_p, wave, gw, NGW); }
#else
#if NSA_PAIRED
            if (EN(10)) REP(10) { OPQ_WS(); OPQ_TID(); nsa2::job(w, lds, tid_p, wave, bid, G); }
#else
            if (EN(10)) REP(10) { OPQ_WS(); OPQ_TID(); nsa::job(w, lds, tid_p, wave, bid, G); }
#endif
#endif
#if GLU_TAIL
            if (EN(11)) REP(11) {
                OPQ_WS(); OPQ_TID();
                if (tid_p == 0) { unsigned sp = 0; while (__hip_atomic_load((unsigned*)(w + WS_CTL) + CW_CNT + 64 * l, __ATOMIC_RELAXED, __HIP_MEMORY_SCOPE_AGENT) < 128u * (1u + rep_)) { __builtin_amdgcn_s_sleep(2); if (++sp > (1u << 22)) break; }
                                  __builtin_amdgcn_fence(__ATOMIC_ACQUIRE, "agent"); VM_WAIT(); }
                __syncthreads();
                pg8::Gemm g{WP(bf16_t, WS_YS), WP(bf16_t, WS_WGLU + l * SZ_WGLU), 256, 256}; pg8::StaticOrder S; S.init(M, 512, G, bid_p);
                EpiGlu E{WP(bf16_t, WS_MIX)}; pg8::gemm_phase<EpiGlu, pg8::StaticOrder, PG8_ALIGN_, PG8_SP2_>(lds, g, S, E, wave); }
#endif
        }
        SEAM(pb + 3);
#if !GLU_TAIL
        if (PH(pb + 4) && EN(11)) REP(11) {
            OPQ_WS(); pg8::Gemm g{WP(bf16_t, WS_YS), WP(bf16_t, WS_WGLU + l * SZ_WGLU), 256, 256}; pg8::StaticOrder S; S.init(M, 512, G, bid_p);
            EpiGlu E{WP(bf16_t, WS_MIX)}; pg8::gemm_phase<EpiGlu, pg8::StaticOrder, PG8_ALIGN_, PG8_SP2_>(lds, g, S, E, wave);
        }
        SEAM(pb + 4);
#endif
        if (PH(pb + 5) && EN(12)) {
            OPQ_WS();
            pg8::Gemm g{WP(bf16_t, WS_MIX), WP(bf16_t, WS_WOUT + l * SZ_WOUT), D, D}; pg8::StaticOrder S; S.init(M, D, G, bid_p);
            EpiResid E{WP(bf16_t, WS_XN), WP(float, WS_RS)}; pg8::gemm_phase<EpiResid, pg8::StaticOrder, PG8_ALIGN_, PG8_SP2_>(lds, g, S, E, wave);
        }
        SEAM(pb + 5);
        if (PH(pb + 6) && EN(13)) REP(13) {
            OPQ_WS(); pg8::Gemm g{WP(bf16_t, WS_XN), WP(bf16_t, WS_WGU + l * SZ_WGU), D, D}; pg8::StaticOrder S; S.init(M, NGU, G, bid_p);
            { OPQ_TID(); rsl_fill(WP(float, WS_RS), S, lds, tid_p); }
            EpiGateUp E{lds, WP(bf16_t, WS_HMID), 0}; pg8::gemm_phase<EpiGateUp, pg8::StaticOrder, PG8_ALIGN_, PG8_SP2_>(lds, g, S, E, wave);
        }
#ifdef PROBE_GU_RAW
        if (PH(pb + 6)) {
            OPQ_WS(); pg8::Gemm g{WP(bf16_t, WS_XN), WP(bf16_t, WS_WGU + l * SZ_WGU), D, D}; pg8::StaticOrder S; S.init(M, NGU, G, bid_p);
            EpiProbeRaw E{WP(bf16_t, WS_MIXR + 180 * MiB)}; pg8::gemm_phase<EpiProbeRaw, pg8::StaticOrder, PG8_ALIGN_, PG8_SP2_>(lds, g, S, E, wave);
        }
#endif
        SEAM(pb + 6);
        if (PH(pb + 7) && EN(14)) {
            OPQ_WS();
            pg8::Gemm g{WP(bf16_t, WS_HMID), WP(bf16_t, WS_WD + l * SZ_WD), DFF, DFF}; pg8::StaticOrder S; S.init(M, D, G, bid_p);
            EpiResid E{WP(bf16_t, WS_XN), WP(float, WS_RS)}; pg8::gemm_phase<EpiResid, pg8::StaticOrder, PG8_ALIGN_, PG8_SP2_>(lds, g, S, E, wave);
#if FINAL_FUSED
            if (l == NLAYER - 1) {
                OPQ_IN(); OPQ_TID(); float* Hres = args.out; asm volatile("" : "+s"(Hres));
                Unit uu;
#pragma unroll 1
                for (int i = 0; S.next(i, uu); ++i) {
                    VM_WAIT(); __syncthreads();
                    if (tid_p == 0) { __builtin_amdgcn_fence(__ATOMIC_RELEASE, "agent"); VM_WAIT();
                                      MISC[16] = __hip_atomic_fetch_add((unsigned*)(w + WS_CTL) + CW_PANEL + uu.pm, 1u, __ATOMIC_RELAXED, __HIP_MEMORY_SCOPE_AGENT); }
                    __syncthreads();
                    const bool last = MISC[16] == 3u;
                    if (last) { if (tid_p == 0) { __builtin_amdgcn_fence(__ATOMIC_ACQUIRE, "agent"); VM_WAIT(); }
                                __syncthreads();
                                final_norm_panel(WP(bf16_t, WS_XN), Hres, WP(float, WS_RS), inp[31], uu.pm * BM, wave, lane_p); }
                    __syncthreads(); }
            }
#endif
        }
        SEAM(pb + 7);
    }
    if (PH(17) && EN(15) && !FINAL_FUSED) { OPQ_WS(); OPQ_IN(); float* Hres = args.out; asm volatile("" : "+s"(Hres)); OPQ_TID(); final_norm_job(WP(bf16_t, WS_XN), Hres, WP(float, WS_RS), inp[31], gw, NGW, lane_p); }
    if (pass_ == 0) xcd_barrier(bar);
    }
#undef PH
#undef tid
#undef gw
#undef NGW
#undef NT
#undef SEAM
}

extern "C" void kernel_launch(void* const* d_in, const int* in_sizes, int n_in, void* d_out, int out_size, void* d_ws, size_t ws_size, hipStream_t stream) {
    static int grid = 0;
    if (grid == 0) {
        if (n_in != 32 || in_sizes[0] != M * D || out_size != M * D || ws_size < WS_END) { fprintf(stderr, "kernel_launch: shape/workspace mismatch (n_in %d, in0 %d, out %d, ws %zu, need %zu)\n", n_in, n_in > 0 ? in_sizes[0] : -1, out_size, ws_size, (size_t)WS_END); grid = -1; return; }
        int dev = 0, cus = 0, per_cu = 0;
        if (hipGetDevice(&dev) != hipSuccess || hipDeviceGetAttribute(&cus, hipDeviceAttributeMultiprocessorCount, dev) != hipSuccess) { grid = -1; return; }
        if (hipFuncSetAttribute((const void*)mk_fwd, hipFuncAttributeMaxDynamicSharedMemorySize, LDS_BYTES) != hipSuccess) { fprintf(stderr, "kernel_launch: hipFuncSetAttribute failed\n"); grid = -1; return; }
        if (hipOccupancyMaxActiveBlocksPerMultiprocessor(&per_cu, (const void*)mk_fwd, NTHREADS, LDS_BYTES) != hipSuccess || per_cu < 1) { fprintf(stderr, "kernel_launch: occupancy query says %d blocks per CU\n", per_cu); (void)hipGetLastError(); grid = -1; return; }
        grid = cus;
    }
    if (grid < 0) return;
    (void)hipMemsetAsync((char*)d_ws + WS_CTL, 0, CTL_ZERO_BYTES, stream);
    Args a{};
    for (int i = 0; i < 32; ++i) a.in[i] = (const float*)d_in[i];
    a.out = (float*)d_out; a.ws = (unsigned char*)d_ws;
    if (MK_N_LAUNCHES == 1) { a.ph_lo = 0; a.ph_hi = N_PHASES; hipLaunchKernelGGL(mk_fwd, dim3(grid), dim3(NTHREADS), LDS_BYTES, stream, a); }
#ifdef HOST_EXTRA_LO
    else if (MK_N_LAUNCHES == 2) {
        a.ph_lo = 0; a.ph_hi = N_PHASES; a.li = 0; a.pad = 0xffff; hipLaunchKernelGGL(mk_fwd, dim3(grid), dim3(NTHREADS), LDS_BYTES, stream, a);
        a.ph_lo = HOST_EXTRA_LO; a.ph_hi = HOST_EXTRA_HI; a.li = 1; a.pad = HOST_EXTRA_MASK; hipLaunchKernelGGL(mk_fwd, dim3(grid), dim3(NTHREADS), LDS_BYTES, stream, a); }
#endif
#ifdef HOST_PREFIX_DUP
    else if (MK_N_LAUNCHES == 2) {
        a.ph_lo = 0; a.ph_hi = HOST_PREFIX_DUP; a.li = 0; hipLaunchKernelGGL(mk_fwd, dim3(grid), dim3(NTHREADS), LDS_BYTES, stream, a);
        a.ph_lo = 0; a.ph_hi = N_PHASES; a.li = 1; hipLaunchKernelGGL(mk_fwd, dim3(grid), dim3(NTHREADS), LDS_BYTES, stream, a); }
#endif
    else for (int p = 0; p < N_PHASES; ++p) { a.ph_lo = p; a.ph_hi = p + 1; hipLaunchKernelGGL(mk_fwd, dim3(grid), dim3(NTHREADS), LDS_BYTES, stream, a); }
}
```

```cpp
#include <hip/hip_runtime.h>
#include <cstdio>
#include <cstdint>
namespace pg8 {
#define PG8_LAS __attribute__((address_space(3)))
typedef unsigned short bf16_t;
typedef short bf16x8 __attribute__((ext_vector_type(8)));
typedef float f32x4 __attribute__((ext_vector_type(4)));
typedef unsigned u32x4 __attribute__((ext_vector_type(4)));
constexpr int BM = 256, BK = 64, HALF = 128, HTB = HALF * BK * 2  , STAGE_BYTES = 8 * HTB, NXCD = 8, WGM = 8;

__host__ __device__ __forceinline__ int lds_byte(int r, int c) { const int st = (r >> 4) * 2 + (c >> 5), rr = r & 15, cc = c & 31, ob = rr * 64 + cc * 2; return st * 1024 + (ob ^ (((ob >> 9) & 1) << 5)); }
__host__ __device__ __forceinline__ void stage_rc(int b, int& R, int& C) { const int st = b / 1024, sb = b % 1024, swz = sb ^ (((sb >> 9) & 1) << 5); R = (st >> 1) * 16 + swz / 64; C = (st & 1) * 32 + (swz % 64) / 2; }
__host__ __device__ __forceinline__ int perm32(int rho) { const int n = rho >> 4, i = rho & 15; return 8 * (i >> 2) + 4 * n + (i & 3); }


struct Unit { int pm, pn; };
struct Gemm { const bf16_t* A; const bf16_t* Bt; int lda, K; };

struct StaticOrder {
    int nM, nN, nwg, G, c;
    __host__ __device__ __forceinline__ void init(int M, int N, int G_, int c_) { nM = M / BM; nN = N / BM; nwg = nM * nN; G = G_; c = c_; }
    __host__ __device__ __forceinline__ bool next(int i, Unit& u) const {
        const long L = (long)i * G + c; if (L >= nwg) return false;
        int wgid = (int)L; { const int q = nwg / NXCD, r = nwg % NXCD, xcd = wgid % NXCD, off = wgid / NXCD; wgid = (xcd < r ? xcd * (q + 1) : r * (q + 1) + (xcd - r) * q) + off; }
        const int nig = WGM * nN, gid = wgid / nig, fm = gid * WGM, gsz = (nM - fm) < WGM ? (nM - fm) : WGM;
        u.pm = fm + ((wgid % nig) % gsz); u.pn = (wgid % nig) / gsz; return true;
    }
    __device__ __forceinline__ void a_ready(const Unit&) const {}
    __device__ __forceinline__ void done(const Unit&) const {}
};
struct GroupOrder {
    int mt, nt, ntb, total, G, c;
    __host__ __device__ __forceinline__ void init(int ng, int mt_, int nt_, int ntb_, int G_, int blk, int off) { mt = mt_; nt = nt_; ntb = ntb_; total = ng * mt_ * nt_; G = G_; c = (blk + G_ - (off % G_)) % G_; }
    __host__ __device__ __forceinline__ bool next(int i, Unit& u) const {
        const long L = (long)i * G + c; if (L >= total) return false;
        const int per = mt * nt, grp = (int)L / per, r = (int)L % per; u.pm = grp * mt + r / nt; u.pn = grp * ntb + r % nt; return true;
    }
    __device__ __forceinline__ void a_ready(const Unit&) const {}
    __device__ __forceinline__ void done(const Unit&) const {}
};
typedef float f32x2_cv __attribute__((ext_vector_type(2))); typedef __bf16 bf16x2_cv __attribute__((ext_vector_type(2)));
__device__ __forceinline__ unsigned cvt_pk_bf16(float lo, float hi) { const f32x2_cv v = {lo, hi}; const bf16x2_cv b = __builtin_convertvector(v, bf16x2_cv); return __builtin_bit_cast(unsigned, b); }
__device__ __forceinline__ int lane_id() { int l; asm volatile("v_mbcnt_lo_u32_b32 %0, -1, 0\n\tv_mbcnt_hi_u32_b32 %0, -1, %0" : "=v"(l)); return l; }
template <class Epi, class Sched, bool ALIGN_EPI = false, bool SP2 = false>
__device__ __forceinline__ void gemm_phase(PG8_LAS unsigned char* lds, const Gemm g, const Sched& S, const Epi& E, const int wave_in) {
    int tid_o = wave_in * 64 + lane_id(); asm volatile("" : "+v"(tid_o));
    const int tid = tid_o, wid = __builtin_amdgcn_readfirstlane(tid >> 6), lane = tid & 63, wr = wid >> 2, wc = wid & 3, fr = lane & 15, fq = lane >> 4;
    const int K = g.K, lda = g.lda, nt = K / BK;
    unsigned voffA[2], voffB[2];
#pragma unroll
    for (int i = 0; i < 2; ++i) { int R, C; stage_rc(tid * 16 + i * 8192, R, C); const int Rb = Epi::PERM ? ((R & ~31) + perm32(R & 31)) : R;
        voffA[i] = (unsigned)(R * lda + C) * 2u; voffB[i] = (unsigned)(Rb * K + C) * 2u; }
    const size_t kstep = (size_t)(BK * 2);
    const size_t hstep = (size_t)HALF * K * 2;
    const size_t tstep = 2 * hstep; const size_t hstepA = (size_t)HALF * lda * 2, tstepA = 2 * hstepA;
    const unsigned ldsw = (unsigned)wid * 1024u;
    const int aoff = lds_byte(wr * 64 + fr, fq * 8), boff = lds_byte(wc * 32 + fr, fq * 8);
#define PG8_SA(b, h) (((b) * 2 + (h)) * HTB)
#define PG8_SB(b, h) ((4 + (b) * 2 + (h)) * HTB)
#define PG8_STAGE(bufoff, gbase, voff) do { _Pragma("unroll") for (int _i = 0; _i < 2; ++_i) \
        __builtin_amdgcn_global_load_lds((const unsigned*)((const char*)(gbase) + (voff)[_i]), (PG8_LAS unsigned*)(lds + (bufoff) + ldsw + _i * 8192), 16, 0, 0); } while (0)
#define PG8_LDA(dst, b, h) do { _Pragma("unroll") for (int m = 0; m < 4; ++m) _Pragma("unroll") for (int k = 0; k < 2; ++k) dst[m][k] = *(const PG8_LAS bf16x8*)(lds + PG8_SA(b, h) + aoff + m * 2048 + k * 1024); } while (0)
#define PG8_LDB(dst, b, h) do { _Pragma("unroll") for (int n = 0; n < 2; ++n) _Pragma("unroll") for (int k = 0; k < 2; ++k) dst[n][k] = *(const PG8_LAS bf16x8*)(lds + PG8_SB(b, h) + boff + n * 2048 + k * 1024); } while (0)
#define PG8_MMA(ai, bj, At, Bt) do { __builtin_amdgcn_s_setprio(1); _Pragma("unroll") for (int m = 0; m < 4; ++m) _Pragma("unroll") for (int n = 0; n < 2; ++n) _Pragma("unroll") for (int k = 0; k < 2; ++k) \
        acc[ai][bj][m][n] = __builtin_amdgcn_mfma_f32_16x16x32_bf16(Bt[n][k], At[m][k], acc[ai][bj][m][n], 0, 0, 0); __builtin_amdgcn_s_setprio(0); } while (0)
#define PG8_WAIT_V(n) asm volatile("s_waitcnt vmcnt(" #n ")" ::: "memory")
#define PG8_WAIT_L(n) asm volatile("s_waitcnt lgkmcnt(" #n ")" ::: "memory")
#define PG8_BAR __builtin_amdgcn_s_barrier()
#define PG8_SCHED __builtin_amdgcn_sched_barrier(0)
    Unit cur, nxt; int ui = 0;
    if (!S.next(0, cur)) return;
    f32x4 acc[2][2][4][2];
#pragma unroll
    for (int a = 0; a < 2; ++a)
#pragma unroll
        for (int b = 0; b < 2; ++b)
#pragma unroll
            for (int m = 0; m < 4; ++m)
#pragma unroll
                for (int n = 0; n < 2; ++n) acc[a][b][m][n] = (f32x4){0.f, 0.f, 0.f, 0.f};
    bf16x8 At[4][2], B0[2][2], B1[2][2];
    const char* cA = (const char*)g.A + (size_t)cur.pm * tstepA; const char* cB = (const char*)g.Bt + (size_t)cur.pn * tstep;
    S.a_ready(cur);
    if constexpr (SP2) {
        PG8_STAGE(PG8_SB(0, 0), cB, voffB); PG8_STAGE(PG8_SB(0, 1), cB + hstep, voffB); PG8_STAGE(PG8_SA(0, 0), cA, voffA); PG8_STAGE(PG8_SA(0, 1), cA + hstepA, voffA);
        if (wr == 1) PG8_BAR;
        PG8_WAIT_V(2); PG8_BAR;
        PG8_STAGE(PG8_SB(1, 0), cB + kstep, voffB); PG8_STAGE(PG8_SA(1, 0), cA + kstep, voffA); PG8_STAGE(PG8_SB(1, 1), cB + hstep + kstep, voffB);
        PG8_WAIT_V(6); PG8_BAR;
    } else {
        PG8_STAGE(PG8_SB(0, 0), cB, voffB); PG8_STAGE(PG8_SA(0, 0), cA, voffA); PG8_STAGE(PG8_SB(0, 1), cB + hstep, voffB); PG8_STAGE(PG8_SA(0, 1), cA + hstepA, voffA);
        if (wr == 1) PG8_BAR;
        PG8_WAIT_V(4); PG8_BAR;
        PG8_STAGE(PG8_SB(1, 0), cB + kstep, voffB); PG8_STAGE(PG8_SA(1, 0), cA + kstep, voffA); PG8_STAGE(PG8_SB(1, 1), cB + hstep + kstep, voffB);
        PG8_WAIT_V(6); PG8_BAR;
    }
    for (;;) {
        const bool has_next = S.next(ui + 1, nxt);
        const char* nA = has_next ? (const char*)g.A + (size_t)nxt.pm * tstepA : cA; const char* nB = has_next ? (const char*)g.Bt + (size_t)nxt.pn * tstep : cB;
        _Pragma("unroll 1") for (int t = 0; t < nt; t += 2) {
            const bool last = (t == nt - 2);
            const char* a1 = cA + (size_t)(t + 1) * kstep;
            const char* a2 = last ? nA : cA + (size_t)(t + 2) * kstep; const char* b2 = last ? nB : cB + (size_t)(t + 2) * kstep;
            const char* a3 = a2 + kstep; const char* b3 = b2 + kstep;
            if (last && has_next) S.a_ready(nxt);
            if constexpr (SP2) {
            PG8_LDB(B0, 0, 0); PG8_LDB(B1, 0, 1); PG8_SCHED; PG8_LDA(At, 0, 0); PG8_STAGE(PG8_SA(1, 1), a1 + hstepA, voffA);
            PG8_WAIT_V(8); PG8_WAIT_L(0); PG8_BAR; PG8_MMA(0, 0, At, B0); PG8_MMA(0, 1, At, B1); PG8_BAR; PG8_SCHED;
            PG8_LDA(At, 0, 1); PG8_STAGE(PG8_SB(0, 0), b2, voffB); PG8_STAGE(PG8_SB(0, 1), b2 + hstep, voffB); PG8_STAGE(PG8_SA(0, 0), a2, voffA);
            PG8_WAIT_V(8); PG8_WAIT_L(0); PG8_BAR; PG8_MMA(1, 0, At, B0); PG8_MMA(1, 1, At, B1); PG8_BAR; PG8_SCHED;
            PG8_LDB(B0, 1, 0); PG8_LDB(B1, 1, 1); PG8_SCHED; PG8_LDA(At, 1, 0); PG8_STAGE(PG8_SA(0, 1), a2 + hstepA, voffA);
            PG8_WAIT_V(8); PG8_WAIT_L(0); PG8_BAR; PG8_MMA(0, 0, At, B0); PG8_MMA(0, 1, At, B1); PG8_BAR; PG8_SCHED;
            PG8_LDA(At, 1, 1); PG8_STAGE(PG8_SB(1, 0), b3, voffB); PG8_STAGE(PG8_SB(1, 1), b3 + hstep, voffB); PG8_STAGE(PG8_SA(1, 0), a3, voffA);
            PG8_WAIT_V(8); PG8_WAIT_L(0); PG8_BAR; PG8_MMA(1, 0, At, B0); PG8_MMA(1, 1, At, B1); PG8_BAR; PG8_SCHED;
            } else {
            PG8_LDB(B0, 0, 0); PG8_SCHED; PG8_LDA(At, 0, 0); PG8_STAGE(PG8_SA(1, 1), a1 + hstepA, voffA);
            PG8_WAIT_L(8); PG8_BAR; PG8_WAIT_L(0); PG8_MMA(0, 0, At, B0); PG8_BAR; PG8_SCHED;
            PG8_LDB(B1, 0, 1); PG8_STAGE(PG8_SB(0, 0), b2, voffB);
            PG8_BAR; PG8_WAIT_L(0); PG8_MMA(0, 1, At, B1); PG8_BAR;
            PG8_LDA(At, 0, 1); PG8_STAGE(PG8_SA(0, 0), a2, voffA);
            PG8_BAR; PG8_WAIT_L(0); PG8_MMA(1, 0, At, B0); PG8_BAR; PG8_SCHED;
            PG8_STAGE(PG8_SB(0, 1), b2 + hstep, voffB);
            PG8_WAIT_V(6); PG8_BAR; PG8_MMA(1, 1, At, B1); PG8_BAR;
            PG8_LDB(B0, 1, 0); PG8_SCHED; PG8_LDA(At, 1, 0); PG8_STAGE(PG8_SA(0, 1), a2 + hstepA, voffA);
            PG8_WAIT_L(8); PG8_BAR; PG8_WAIT_L(0); PG8_MMA(0, 0, At, B0); PG8_BAR; PG8_SCHED;
            PG8_LDB(B1, 1, 1); PG8_STAGE(PG8_SB(1, 0), b3, voffB);
            PG8_BAR; PG8_WAIT_L(0); PG8_MMA(0, 1, At, B1); PG8_BAR;
            PG8_LDA(At, 1, 1); PG8_STAGE(PG8_SA(1, 0), a3, voffA);
            PG8_BAR; PG8_WAIT_L(0); PG8_MMA(1, 0, At, B0); PG8_BAR; PG8_SCHED;
            PG8_STAGE(PG8_SB(1, 1), b3 + hstep, voffB);
            PG8_WAIT_V(6); PG8_BAR; PG8_MMA(1, 1, At, B1); PG8_BAR;
            }
        }
        if constexpr (ALIGN_EPI) { if (wr == 0) PG8_BAR; }
        if constexpr (!Epi::AFTER_DRAIN) { { const int l2_ = lane_id(); E(acc, cur, wr, wc, l2_ & 15, l2_ >> 4); } S.done(cur); }
        if (!has_next) break;
#pragma unroll
        for (int a = 0; a < 2; ++a)
#pragma unroll
            for (int b = 0; b < 2; ++b)
#pragma unroll
                for (int m = 0; m < 4; ++m)
#pragma unroll
                    for (int n = 0; n < 2; ++n) acc[a][b][m][n] = (f32x4){0.f, 0.f, 0.f, 0.f};
        cur = nxt; cA = nA; cB = nB; ++ui;
        if constexpr (ALIGN_EPI) { if (wr == 1) PG8_BAR; }
    }
    PG8_WAIT_V(0);
    if constexpr (!ALIGN_EPI) { if (wr == 0) PG8_BAR; }
    PG8_BAR;
    if constexpr (Epi::AFTER_DRAIN) { E.fused(acc, cur, wr, wc, fr, fq, lds, wid, lane); S.done(cur); }
#undef PG8_SA
#undef PG8_SB
#undef PG8_STAGE
#undef PG8_LDA
#undef PG8_LDB
#undef PG8_MMA
#undef PG8_WAIT_V
#undef PG8_WAIT_L
#undef PG8_BAR
#undef PG8_SCHED
}
}
#define GAS __attribute__((address_space(1)))
#define LAS __attribute__((address_space(3)))
typedef unsigned short bf16;
typedef unsigned v4u __attribute__((ext_vector_type(4)));
typedef float f32x4 __attribute__((ext_vector_type(4)));
typedef short bf16x8 __attribute__((ext_vector_type(8)));
typedef GAS unsigned gu32;
typedef GAS unsigned long long gu64;
#define RLX_AGENT __ATOMIC_RELAXED, __HIP_MEMORY_SCOPE_AGENT
#define LDS_WAIT() asm volatile("s_waitcnt lgkmcnt(0)" ::: "memory")
#define VM_WAIT() asm volatile("s_waitcnt vmcnt(0)" ::: "memory")
__device__ __forceinline__ unsigned long long rt() { return __builtin_amdgcn_s_memrealtime(); }
__device__ __forceinline__ unsigned f2bf(float f) { unsigned u = __builtin_bit_cast(unsigned, f); return (u + 0x7fffu + ((u >> 16) & 1u)) >> 16; }
__device__ __forceinline__ unsigned pk2(float lo, float hi) { return f2bf(lo) | (f2bf(hi) << 16); }

#define XB_TMO      128
#define XB_XCNT(j)  (256  + 64 * (j))
#define XB_XSUB(j)  (1280 + 64 * (j))
#define XB_XGEN(j)  (2304 + 64 * (j))
#define XB_TOP      3328
#define XB_TOPGEN   3392
#define XCD_BAR_WORDS 3456
#define XB_SPIN_CAP (1u << 18)

__device__ __forceinline__ unsigned xb_ld(unsigned* p)              { return __hip_atomic_load(p, __ATOMIC_RELAXED, __HIP_MEMORY_SCOPE_AGENT); }
__device__ __forceinline__ unsigned xb_add(unsigned* p, unsigned v) { return __hip_atomic_fetch_add(p, v, __ATOMIC_RELAXED, __HIP_MEMORY_SCOPE_AGENT); }
__device__ __forceinline__ unsigned xb_xcc_id() { return (unsigned)__builtin_amdgcn_s_getreg((3 << 11) | 20) & 0xFu; }
#define XB_SPIN(cond, bar) do { unsigned _sp = 0; while (cond) { __builtin_amdgcn_s_sleep(1); \
    if ((++_sp & 255u) == 0u) { if (xb_ld(&(bar)[XB_TMO])) break; if (_sp > XB_SPIN_CAP) { atomicAdd(&(bar)[XB_TMO], 1u); break; } } } } while (0)

struct XcdBarrier {
    unsigned* bar; unsigned x;
    volatile LAS unsigned* st;
};

__device__ __forceinline__ XcdBarrier xcd_barrier_post(unsigned* bar, volatile LAS unsigned* st) {
    XcdBarrier b; b.bar = bar; b.x = xb_xcc_id(); b.st = st;
    if (threadIdx.x == 0) (void)xb_add(&bar[XB_XCNT(b.x)], 1u);
    return b;
}
__device__ __forceinline__ void xcd_barrier_complete(unsigned* bar, unsigned x, unsigned& nloc, unsigned& nx) {
    const unsigned G = gridDim.x * gridDim.y * gridDim.z;
    unsigned sum, cnt, mine, sp = 0u;
    for (;;) {
        sum = 0u; cnt = 0u; mine = 0u;
#pragma unroll
        for (unsigned j = 0; j < 16; ++j) { const unsigned c = xb_ld(&bar[XB_XCNT(j)]); sum += c; cnt += (c > 0u) ? 1u : 0u; mine = (j == x) ? c : mine; }
        if (sum == G) break;
        __builtin_amdgcn_s_sleep(1);
        if ((++sp & 255u) == 0u) { if (xb_ld(&bar[XB_TMO])) break; if (sp > XB_SPIN_CAP) { atomicAdd(&bar[XB_TMO], 1u); break; } }
    }
    nloc = mine > 0u ? mine : 1u; nx = cnt > 0u ? cnt : 1u;
}

__device__ __forceinline__ void xcd_barrier(const XcdBarrier& b) {
    asm volatile("s_waitcnt vmcnt(0)" ::: "memory");
    __syncthreads();
    if (threadIdx.x == 0) {
        unsigned* bar = b.bar;
        __builtin_amdgcn_s_waitcnt(0);
        unsigned nloc = b.st[0], nx = b.st[1];
        if (nloc == 0u) { xcd_barrier_complete(bar, b.x, nloc, nx); b.st[0] = nloc; b.st[1] = nx; }
        const unsigned old = xb_add(&bar[XB_XSUB(b.x)], 1u);
        const unsigned gen = old / nloc;
        if (old + 1u == (gen + 1u) * nloc) {
            __builtin_amdgcn_fence(__ATOMIC_RELEASE, "agent");
            asm volatile("s_waitcnt vmcnt(0)" ::: "memory");
            const unsigned og = xb_add(&bar[XB_TOP], 1u);
            const unsigned tg = og / nx;
            if (og + 1u == (tg + 1u) * nx) xb_add(&bar[XB_TOPGEN], 1u);
            else XB_SPIN(xb_ld(&bar[XB_TOPGEN]) == tg, bar);
            __builtin_amdgcn_fence(__ATOMIC_ACQUIRE, "agent");
            xb_add(&bar[XB_XGEN(b.x)], 1u);
            asm volatile("s_waitcnt vmcnt(0)" ::: "memory");
        } else {
            XB_SPIN(xb_ld(&bar[XB_XGEN(b.x)]) == gen, bar);
            __builtin_amdgcn_fence(__ATOMIC_ACQUIRE, "agent");
            asm volatile("s_waitcnt vmcnt(0)" ::: "memory");
        }
    }
    __syncthreads();
}

using pg8::bf16_t; using pg8::Unit; using pg8::BM; using pg8::HALF;
typedef unsigned u32x2v __attribute__((ext_vector_type(2)));
constexpr int NB = 16, SEQ = 2048, M = NB * SEQ, D = 1024, NIN = 2304, NINV = 2072, DFF = 2816, NGU = 2 * DFF, NLAYER = 2;
constexpr int L5 = 32, NCH = SEQ / L5, NS5 = 16 * L5, KS5 = NS5 + 128;
constexpr float LOG2E = 1.4426950408889634f, QSCALE = 0.125f * LOG2E;
constexpr int NWAVES = 8, NTHREADS = 512;
constexpr size_t MiB = 1u << 20;
constexpr size_t WS_CTL = 0, CTL_ZERO_BYTES = 64 * 1024;
constexpr size_t WS_WIN  = 1 * MiB;                                   constexpr size_t SZ_WIN  = (size_t)NIN * D * 2;
constexpr size_t WS_WOUT = WS_WIN  + NLAYER * SZ_WIN;                 constexpr size_t SZ_WOUT = (size_t)D * D * 2;
constexpr size_t WS_WGU  = WS_WOUT + NLAYER * SZ_WOUT;                constexpr size_t SZ_WGU  = (size_t)NGU * D * 2;
constexpr size_t WS_WD   = WS_WGU  + NLAYER * SZ_WGU;                 constexpr size_t SZ_WD   = (size_t)D * DFF * 2;
constexpr size_t WS_WGLU = WS_WD   + NLAYER * SZ_WD;                  constexpr size_t SZ_WGLU = (size_t)512 * 256 * 2;
constexpr size_t WS_WLRU = WS_WGLU + NLAYER * SZ_WGLU;                constexpr size_t SZ_WLRU = (size_t)512 * 256 * 2;
constexpr size_t WS_W1   = WS_WLRU + NLAYER * SZ_WLRU;                constexpr size_t SZ_W1   = (size_t)2 * 256 * 2048 * 2;
constexpr size_t WS_TOP  = WS_W1   + NLAYER * SZ_W1;                  constexpr size_t SZ_TOP  = (size_t)16 * NS5 * KS5 * 2;
constexpr size_t WS_MOP  = WS_TOP  + NLAYER * SZ_TOP;                 constexpr size_t SZ_MOP  = (size_t)16 * 256 * NS5 * 2;
constexpr size_t WS_TAB  = WS_MOP  + NLAYER * SZ_MOP;                 constexpr size_t SZ_TAB  = 16384;
constexpr size_t WS_LUT  = WS_TAB  + NLAYER * SZ_TAB;
constexpr size_t WS_RS   = (WS_LUT + 8192 + 255) & ~(size_t)255;
constexpr size_t WS_XN   = (WS_RS + (size_t)M * 16 * 4 + MiB - 1) & ~(MiB - 1);
constexpr size_t WS_MIXR = WS_XN + (size_t)M * D * 2;
constexpr size_t WS_Q    = WS_MIXR;
constexpr size_t WS_KC   = WS_Q   + (size_t)M * 512 * 2;
constexpr size_t WS_VC   = WS_KC  + (size_t)M * 128 * 2;
constexpr size_t WS_KS   = WS_VC  + (size_t)M * 128 * 2 + 65536;
constexpr size_t WS_KW   = WS_KS  + (size_t)M * 128 * 2;
constexpr size_t WS_VST  = WS_KW  + (size_t)M * 128 * 2;
constexpr size_t WS_VWT  = WS_VST + (size_t)M * 128 * 2;
constexpr size_t WS_AS5  = WS_VWT + (size_t)M * 128 * 2;
constexpr size_t WS_SLOC = WS_AS5 + (size_t)16 * 1024 * KS5 * 2;
constexpr size_t WS_YS   = WS_SLOC + (size_t)16 * 1024 * 128 * 4;
constexpr size_t WS_LX   = WS_YS  + (size_t)M * 256 * 2;
constexpr size_t WS_LG   = WS_LX  + (size_t)M * 256 * 2;
constexpr size_t WS_XC   = WS_LG  + (size_t)M * 256 * 2;
constexpr size_t WS_LA   = WS_XC  + (size_t)M * 256 * 2;
constexpr size_t WS_LB   = WS_LA  + (size_t)M * 256 * 4;
constexpr size_t WS_GATES= WS_LB  + (size_t)M * 256 * 4;
constexpr size_t WS_H1C  = WS_GATES + (size_t)M * 32 * 4;
constexpr size_t WS_KCC  = WS_H1C + (size_t)2 * 32 * 128 * 64 * 4;
constexpr size_t WS_VCT  = WS_KCC + (size_t)32 * 128 * 64 * 2;
constexpr size_t WS_MIX  = WS_VCT + (size_t)32 * 128 * 64 * 2;
constexpr size_t WS_END  = WS_MIX + (size_t)M * D * 2;
constexpr size_t WS_HMID = WS_MIXR;
static_assert(WS_HMID + (size_t)M * DFF * 2 <= WS_MIX, "HMID overlay must end before MIX");
constexpr int TB_BIAS1 = 0;
constexpr int TB_SP    = 128;
constexpr int TB_A32   = 512;
constexpr int CW_BAR = 4096;
constexpr int CW_PANEL = 1024;
constexpr int CW_CNT = 2048;

constexpr int RING_BYTES = 131072, MISC_OFF = RING_BYTES + 320, LDS_BYTES = 147456;

__device__ __forceinline__ float bf2f(unsigned h) { return __uint_as_float(h << 16); }
__device__ __forceinline__ float sigmoidf_(float x) { return __builtin_amdgcn_rcpf(1.0f + __expf(-x)); }
__device__ __forceinline__ float gelu_tanh(float x) { const float u = 1.5957691216057308f * (x + 0.044715f * x * x * x); return x * __builtin_amdgcn_rcpf(1.0f + __expf(-u)); }
__device__ __forceinline__ v4u pack8(const float (&v)[8]) { v4u w; w.x = pg8::cvt_pk_bf16(v[0], v[1]); w.y = pg8::cvt_pk_bf16(v[2], v[3]); w.z = pg8::cvt_pk_bf16(v[4], v[5]); w.w = pg8::cvt_pk_bf16(v[6], v[7]); return w; }
__device__ __forceinline__ void unpack8(const v4u w, float (&v)[8]) { v[0] = bf2f(w.x & 0xffffu); v[1] = bf2f(w.x >> 16); v[2] = bf2f(w.y & 0xffffu); v[3] = bf2f(w.y >> 16); v[4] = bf2f(w.z & 0xffffu); v[5] = bf2f(w.z >> 16); v[6] = bf2f(w.w & 0xffffu); v[7] = bf2f(w.w >> 16); }
__device__ __forceinline__ float row_rstd(const float* RS, int row, int fq) {
    const f32x4 v = *(const f32x4*)(RS + (size_t)row * 16 + 4 * fq);
    float s = (v.x + v.y) + (v.z + v.w); s += __shfl_xor(s, 16); s += __shfl_xor(s, 32);
    return rsqrtf(s * (1.0f / 1024.0f) + 1e-6f);
}
typedef const pg8::f32x4 (&AccRef)[2][2][4][2];
constexpr int RSL_OFF = RING_BYTES + 1024, RSL_MAX_UNITS = 12;
static_assert(RSL_OFF + RSL_MAX_UNITS * 256 * 4 <= LDS_BYTES, "row-scale table fits the spare LDS");
template <class Sched>
__device__ __forceinline__ void rsl_fill(const float* RS, const Sched& S, LAS unsigned char* lds, int tid) {
    LAS float* RL = (LAS float*)(lds + RSL_OFF); const int r = tid >> 1, hf = tid & 1;
    Unit u; f32x4 a[RSL_MAX_UNITS], b[RSL_MAX_UNITS];
#pragma unroll
    for (int i = 0; i < RSL_MAX_UNITS; ++i) if (S.next(i, u)) { const float* p = RS + (size_t)(u.pm * BM + r) * 16 + 8 * hf; a[i] = *(const f32x4*)p; b[i] = *(const f32x4*)(p + 4); }
#pragma unroll
    for (int i = 0; i < RSL_MAX_UNITS; ++i) if (S.next(i, u)) { float s = ((a[i].x + a[i].y) + (a[i].z + a[i].w)) + ((b[i].x + b[i].y) + (b[i].z + b[i].w)); s += __shfl_xor(s, 1);
        if (hf == 0) RL[i * 256 + r] = rsqrtf(s * (1.0f / 1024.0f) + 1e-6f); }
    __syncthreads();
}
__device__ __forceinline__ void rsl_read8(const LAS unsigned char* lds, int ui, int wr, int fr, float (&rs)[2][4]) {
    const LAS float* RL = (const LAS float*)(lds + RSL_OFF) + ui * 256 + wr * 64 + fr;
#pragma unroll
    for (int ai = 0; ai < 2; ++ai)
#pragma unroll
        for (int m = 0; m < 4; ++m) rs[ai][m] = RL[ai * HALF + m * 16];
}
__device__ __forceinline__ void row_rstd8(const float* RS, int row0, int fq, float (&rs)[2][4]) {
    f32x4 v[2][4];
#pragma unroll
    for (int ai = 0; ai < 2; ++ai)
#pragma unroll
        for (int m = 0; m < 4; ++m) v[ai][m] = *(const f32x4*)(RS + (size_t)(row0 + ai * HALF + m * 16) * 16 + 4 * fq);
#pragma unroll
    for (int ai = 0; ai < 2; ++ai)
#pragma unroll
        for (int m = 0; m < 4; ++m) { float s = (v[ai][m].x + v[ai][m].y) + (v[ai][m].z + v[ai][m].w); s += __shfl_xor(s, 16); s += __shfl_xor(s, 32); rs[ai][m] = rsqrtf(s * (1.0f / 1024.0f) + 1e-6f); }
}

struct EpiInProj {
    static constexpr bool PERM = true, AFTER_DRAIN = false;
    unsigned char* w; const LAS unsigned char* lds; mutable int ui;
    __device__ __forceinline__ void operator()(AccRef acc, const Unit& u, int wr, int wc, int fr, int fq) const {
        const int pn = u.pn;
        float rs8[2][4]; rsl_read8(lds, ui, wr, fr, rs8); ++ui;
        const float* RS = (const float*)(w + WS_RS); (void)RS; bf16_t* Q = (bf16_t*)(w + WS_Q); bf16_t* KC = (bf16_t*)(w + WS_KC); bf16_t* VC = (bf16_t*)(w + WS_VC); bf16_t* KS = (bf16_t*)(w + WS_KS); bf16_t* KW = (bf16_t*)(w + WS_KW);
        bf16_t* VST = (bf16_t*)(w + WS_VST); bf16_t* VWT = (bf16_t*)(w + WS_VWT); bf16_t* AS5 = (bf16_t*)(w + WS_AS5); bf16_t* LX = (bf16_t*)(w + WS_LX); bf16_t* LG = (bf16_t*)(w + WS_LG); float* GATES = (float*)(w + WS_GATES);
#pragma unroll
        for (int ai = 0; ai < 2; ++ai)
#pragma unroll
            for (int m = 0; m < 4; ++m) {
                const int row = u.pm * BM + ai * HALF + wr * 64 + m * 16 + fr;
                const float rs = rs8[ai][m];
                const int b = row >> 11, t = row & 2047;
#pragma unroll
                for (int bj = 0; bj < 2; ++bj) {
                    const int c8 = bj * HALF + wc * 32 + 8 * fq;
                    float v[8];
#pragma unroll
                    for (int j = 0; j < 4; ++j) { v[j] = acc[ai][bj][m][0][j] * rs; v[4 + j] = acc[ai][bj][m][1][j] * rs; }
                    if (pn == 0) {
                        const int g = c8 >> 4, co = c8 & 15;
                        *(v4u*)(AS5 + ((size_t)(g * 1024 + b * 64 + (t >> 5)) * KS5 + (t & 31) * 16 + co)) = pack8(v);
                    } else if (pn <= 2) {
#pragma unroll
                        for (int j = 0; j < 8; ++j) v[j] *= QSCALE;
                        *(v4u*)(Q + (size_t)row * 512 + (pn - 1) * 256 + c8) = pack8(v);
                    } else if (pn <= 5) {
                        const int c = c8 & 127, h = c >> 6, d = c & 63;
                        const size_t kvrow = (size_t)(b * 2 + h) * 2048 + t;
                        if (bj == 0) { bf16_t* base = pn == 3 ? KC : (pn == 4 ? KS : KW); *(v4u*)(base + kvrow * 64 + d) = pack8(v); }
                        else if (pn == 3) { *(v4u*)(VC + kvrow * 64 + d) = pack8(v); }
                        else { bf16_t* base = pn == 4 ? VST : VWT;
#pragma unroll
                            for (int j = 0; j < 8; ++j) base[((size_t)(b * 2 + h) * 64 + d + j) * 2048 + t] = (bf16_t)f2bf(v[j]); }
                    } else if (pn == 6) {
                        *(v4u*)(LX + (size_t)row * 256 + c8) = pack8(v);
                    } else if (pn == 7) {
#pragma unroll
                        for (int j = 0; j < 8; ++j) v[j] = gelu_tanh(v[j]);
                        *(v4u*)(LG + (size_t)row * 256 + c8) = pack8(v);
                    } else {
                        if (bj == 0 && wc == 0 && fq < 3) {
                            f32x4 a, c; a.x = sigmoidf_(v[0]); a.y = sigmoidf_(v[1]); a.z = sigmoidf_(v[2]); a.w = sigmoidf_(v[3]);
                            c.x = sigmoidf_(v[4]); c.y = sigmoidf_(v[5]); c.z = sigmoidf_(v[6]); c.w = sigmoidf_(v[7]);
                            *(f32x4*)(GATES + (size_t)row * 32 + 8 * fq) = a; *(f32x4*)(GATES + (size_t)row * 32 + 8 * fq + 4) = c; }
                    }
                }
            }
    }
};
struct EpiGates {
    static constexpr bool PERM = true, AFTER_DRAIN = false;
    unsigned char* w;
    __device__ __forceinline__ void operator()(AccRef acc, const Unit& u, int wr, int wc, int fr, int fq) const {
        if (wc != 0) return;
        float* GATES = (float*)(w + WS_GATES);
        float rs8[2][4]; row_rstd8((const float*)(w + WS_RS), u.pm * BM + wr * 64 + fr, fq, rs8);
#pragma unroll
        for (int ai = 0; ai < 2; ++ai)
#pragma unroll
            for (int m = 0; m < 4; ++m) {
                const int row = u.pm * BM + ai * HALF + wr * 64 + m * 16 + fr;
                const float rs = rs8[ai][m];
                if (fq < 3) { f32x4 a, c;
#pragma unroll
                    for (int j = 0; j < 4; ++j) { a[j] = sigmoidf_(acc[ai][0][m][0][j] * rs); c[j] = sigmoidf_(acc[ai][0][m][1][j] * rs); }
                    *(f32x4*)(GATES + (size_t)row * 32 + 8 * fq) = a; *(f32x4*)(GATES + (size_t)row * 32 + 8 * fq + 4) = c; }
            }
    }
};
struct EpiResid {
    static constexpr bool PERM = true, AFTER_DRAIN = false;
    bf16_t* XN; float* RS;
    __device__ __forceinline__ void operator()(AccRef acc, const Unit& u, int wr, int wc, int fr, int fq) const {
        const int row0 = u.pm * BM + wr * 64 + fr, col0 = u.pn * BM + wc * 32 + 8 * fq;
        v4u hv[4][2];
#pragma unroll
        for (int g = 0; g < 4; ++g)
#pragma unroll
            for (int bj = 0; bj < 2; ++bj) hv[g][bj] = *(const v4u*)(XN + (size_t)(row0 + (g & 3) * 16) * D + col0 + bj * HALF);
#pragma unroll
        for (int g = 0; g < 8; ++g) { const int ai = g >> 2, m = g & 3; const int row = row0 + ai * HALF + m * 16; float ss = 0.f;
            v4u cur0 = hv[g & 3][0], cur1 = hv[g & 3][1];
            if (g < 4) {
#pragma unroll
                for (int bj = 0; bj < 2; ++bj) hv[g & 3][bj] = *(const v4u*)(XN + (size_t)(row0 + HALF + (g & 3) * 16) * D + col0 + bj * HALF); }
#pragma unroll
            for (int bj = 0; bj < 2; ++bj) { float h[8]; unpack8(bj == 0 ? cur0 : cur1, h);
#pragma unroll
                for (int j = 0; j < 4; ++j) { h[j] += acc[ai][bj][m][0][j]; h[4 + j] += acc[ai][bj][m][1][j]; }
#pragma unroll
                for (int j = 0; j < 8; ++j) ss += h[j] * h[j];
                __builtin_nontemporal_store(pack8(h), (v4u*)(XN + (size_t)row * D + col0 + bj * HALF)); }
            ss += __shfl_xor(ss, 16); ss += __shfl_xor(ss, 32);
            if (fq == 0) RS[(size_t)row * 16 + u.pn * 4 + wc] = ss; }
    }
};
struct EpiGateUp {
    static constexpr bool PERM = true, AFTER_DRAIN = false;
    const LAS unsigned char* lds; bf16_t* HM; mutable int ui;
    __device__ __forceinline__ void operator()(AccRef acc, const Unit& u, int wr, int wc, int fr, int fq) const {
        typedef float f32x2 __attribute__((ext_vector_type(2)));
        float rs8[2][4]; rsl_read8(lds, ui, wr, fr, rs8); ++ui;
#pragma unroll
        for (int ai = 0; ai < 2; ++ai)
#pragma unroll
            for (int m = 0; m < 4; ++m) {
                const int row = u.pm * BM + ai * HALF + wr * 64 + m * 16 + fr;
                const float rs = rs8[ai][m], k1 = -rs * LOG2E, k2 = rs * rs;
                float v[8];
#pragma unroll
                for (int n = 0; n < 2; ++n)
#pragma unroll
                    for (int jp = 0; jp < 2; ++jp) {
                        const f32x2 g = {acc[ai][0][m][n][2 * jp], acc[ai][0][m][n][2 * jp + 1]}, up = {acc[ai][1][m][n][2 * jp], acc[ai][1][m][n][2 * jp + 1]};
                        const f32x2 x = g * k1; f32x2 e; e.x = __builtin_amdgcn_exp2f(x.x); e.y = __builtin_amdgcn_exp2f(x.y);
                        const f32x2 d = e + 1.0f; f32x2 r; r.x = __builtin_amdgcn_rcpf(d.x); r.y = __builtin_amdgcn_rcpf(d.y);
                        const f32x2 o = ((g * up) * k2) * r; v[4 * n + 2 * jp] = o.x; v[4 * n + 2 * jp + 1] = o.y; }
                __builtin_nontemporal_store(pack8(v), (v4u*)(HM + (size_t)row * DFF + u.pn * 128 + wc * 32 + 8 * fq));
                asm volatile("" ::: "memory");
            }
    }
};
struct EpiProbeRaw {
    static constexpr bool PERM = true, AFTER_DRAIN = false;
    bf16_t* HM;
    __device__ __forceinline__ void operator()(AccRef acc, const Unit& u, int wr, int wc, int fr, int fq) const {
#pragma unroll
        for (int ai = 0; ai < 2; ++ai)
#pragma unroll
            for (int m = 0; m < 4; ++m) { const int row = u.pm * BM + ai * HALF + wr * 64 + m * 16 + fr; float v[8];
#pragma unroll
                for (int n = 0; n < 2; ++n)
#pragma unroll
                    for (int j = 0; j < 4; ++j) v[4 * n + j] = acc[ai][0][m][n][j] + acc[ai][1][m][n][j];
                *(v4u*)(HM + (size_t)row * DFF + u.pn * 128 + wc * 32 + 8 * fq) = pack8(v); }
    }
};
struct EpiS5StateScan {
    static constexpr bool PERM = false, AFTER_DRAIN = true;
    const float* a32; bf16_t* AS5;
    __device__ __forceinline__ void fused(AccRef acc, const Unit& u, int wr, int wc, int fr, int fq, PG8_LAS unsigned char* lds, int wid, int lane) const {
        LAS float* S = (LAS float*)lds;
#pragma unroll
        for (int ai = 0; ai < 2; ++ai)
#pragma unroll
            for (int m = 0; m < 4; ++m) { const int rowl = ai * HALF + wr * 64 + m * 16 + fr;
#pragma unroll
                for (int n = 0; n < 2; ++n) *(LAS f32x4*)(S + rowl * 128 + wc * 32 + 16 * n + 4 * fq) = acc[ai][0][m][n]; }
        asm volatile("s_waitcnt lgkmcnt(0)" ::: "memory"); __builtin_amdgcn_s_barrier(); asm volatile("" ::: "memory");
        const int tid = wid * 64 + lane;
        if (tid < 256) { const int bl = tid >> 6, p = tid & 63, g = u.pm >> 2;
            const float ar = a32[2 * (g * 64 + p)], aI = a32[2 * (g * 64 + p) + 1]; float hr = 0.f, hi = 0.f;
#pragma unroll 4
            for (int ch = 0; ch < NCH; ++ch) { const size_t R = (size_t)u.pm * BM + bl * 64 + ch;
                AS5[R * KS5 + NS5 + p] = (bf16_t)f2bf(hr); AS5[R * KS5 + NS5 + 64 + p] = (bf16_t)f2bf(hi);
                const float sr = S[(bl * 64 + ch) * 128 + p], si = S[(bl * 64 + ch) * 128 + 64 + p];
                const float nr = ar * hr - aI * hi + sr, ni = ar * hi + aI * hr + si; hr = nr; hi = ni; } }
        asm volatile("s_waitcnt lgkmcnt(0)" ::: "memory"); __builtin_amdgcn_s_barrier(); asm volatile("" ::: "memory");
    }
};
struct EpiS5Main {
    static constexpr bool PERM = true, AFTER_DRAIN = false;
    const bf16_t* AS5; const float* dskip; bf16_t* YS;
    __device__ __forceinline__ void operator()(AccRef acc, const Unit& u, int wr, int wc, int fr, int fq) const {
#pragma unroll
        for (int ai = 0; ai < 2; ++ai)
#pragma unroll
            for (int m = 0; m < 4; ++m) {
                const int R = u.pm * BM + ai * HALF + wr * 64 + m * 16 + fr;
                const int g = R >> 10, b = (R >> 6) & 15, ch = R & 63;
#pragma unroll
                for (int bj = 0; bj < 2; ++bj) {
                    const int cg = (u.pn & 1) * 256 + bj * HALF + wc * 32 + 8 * fq, t = cg >> 4, co = cg & 15;
                    float uu[8], v[8]; unpack8(*(const v4u*)(AS5 + (size_t)R * KS5 + cg), uu);
                    const f32x4 d0 = *(const f32x4*)(dskip + 16 * g + co), d1 = *(const f32x4*)(dskip + 16 * g + co + 4);
#pragma unroll
                    for (int j = 0; j < 4; ++j) { v[j] = gelu_tanh(acc[ai][bj][m][0][j] + d0[j] * uu[j]); v[4 + j] = gelu_tanh(acc[ai][bj][m][1][j] + d1[j] * uu[4 + j]); }
                    *(v4u*)(YS + (size_t)(b * 2048 + ch * 32 + t) * 256 + 16 * g + co) = pack8(v);
                }
            }
    }
};
struct EpiGlu {
    static constexpr bool PERM = true, AFTER_DRAIN = false;
    bf16_t* MIX;
    __device__ __forceinline__ void operator()(AccRef acc, const Unit& u, int wr, int wc, int fr, int fq) const {
#pragma unroll
        for (int ai = 0; ai < 2; ++ai)
#pragma unroll
            for (int m = 0; m < 4; ++m) {
                const int row = u.pm * BM + ai * HALF + wr * 64 + m * 16 + fr;
                float v[8];
#pragma unroll
                for (int n = 0; n < 2; ++n)
#pragma unroll
                    for (int j = 0; j < 4; ++j) v[4 * n + j] = acc[ai][0][m][n][j] * sigmoidf_(acc[ai][1][m][n][j]);
                *(v4u*)(MIX + (size_t)row * D + u.pn * 128 + wc * 32 + 8 * fq) = pack8(v);
                asm volatile("" ::: "memory");
            }
    }
};
struct EpiLruGates {
    static constexpr bool PERM = true, AFTER_DRAIN = false;
    const bf16_t* XC; const float *b_a, *b_x, *sp; bf16_t *LA, *LB;
    __device__ __forceinline__ void operator()(AccRef acc, const Unit& u, int wr, int wc, int fr, int fq) const {
        const int ch = u.pn * 128 + wc * 32 + 8 * fq;
        float ba[8], bx[8], s8[8];
#pragma unroll
        for (int j = 0; j < 8; ++j) { ba[j] = -LOG2E * b_a[ch + j]; bx[j] = -LOG2E * b_x[ch + j]; s8[j] = -8.0f * LOG2E * sp[ch + j]; }
#pragma unroll
        for (int ai = 0; ai < 2; ++ai)
#pragma unroll
            for (int m = 0; m < 4; ++m) {
                const int row = u.pm * BM + ai * HALF + wr * 64 + m * 16 + fr;
                float xc[8], oa[8], ob[8]; unpack8(*(const v4u*)(XC + (size_t)row * 256 + ch), xc);
#pragma unroll
                for (int j = 0; j < 8; ++j) { const float ar = acc[ai][0][m][j >> 2][j & 3], ai_ = acc[ai][1][m][j >> 2][j & 3];
                    const float d1 = 1.0f + __builtin_amdgcn_exp2f(ar * -LOG2E + ba[j]), d2 = 1.0f + __builtin_amdgcn_exp2f(ai_ * -LOG2E + bx[j]);
                    const float inv = __builtin_amdgcn_rcpf(d1 * d2), r = d2 * inv, ig = d1 * inv;
                    const float av = __builtin_amdgcn_exp2f(r * s8[j]);
                    oa[j] = 1.0f - av; ob[j] = __builtin_amdgcn_sqrtf(fmaxf(1.0f - av * av, 0.f)) * ig * xc[j]; }
                *(v4u*)(LA + (size_t)row * 256 + ch) = pack8(oa); *(v4u*)(LB + (size_t)row * 256 + ch) = pack8(ob);
                asm volatile("" ::: "memory");
            }
    }
};
struct EpiCompress2 {
    static constexpr bool PERM = false, AFTER_DRAIN = true;
    const float* bias1; const float* w2k; const float* w2v; bf16_t* KCC; bf16_t* VCT;
    __device__ __forceinline__ void fused(AccRef acc, const Unit& u, int wr, int wc, int fr, int fq, PG8_LAS unsigned char* lds, int wid, int lane) const {
        LAS bf16_t* Gb = (LAS bf16_t*)lds;
        LAS float* Hs = (LAS float*)(lds + 32768); LAS float* W2s = (LAS float*)(lds + 32768 + 256 * 65 * 4 + 64);
        const int kv = u.pn, tid = wid * 64 + lane; const float* w2 = kv ? w2v : w2k;
        for (int i = tid; i < 4096; i += NTHREADS) W2s[i] = w2[i];
        if (wc >= 2) {
#pragma unroll
            for (int n = 0; n < 2; ++n) { const int j0 = (wc - 2) * 32 + 16 * n + 4 * fq;
#pragma unroll
                for (int ai = 0; ai < 2; ++ai)
#pragma unroll
                    for (int m = 0; m < 4; ++m) { const int rowl = ai * HALF + wr * 64 + m * 16 + fr; const f32x4 v = acc[ai][0][m][n];
                        u32x2v wv; wv.x = pg8::cvt_pk_bf16(v.x, v.y); wv.y = pg8::cvt_pk_bf16(v.z, v.w); *(LAS u32x2v*)(Gb + rowl * 64 + j0) = wv; } } }
        asm volatile("s_waitcnt vmcnt(0) lgkmcnt(0)" ::: "memory"); __builtin_amdgcn_s_barrier(); asm volatile("" ::: "memory");
        if (wc < 2) {
#pragma unroll
            for (int n = 0; n < 2; ++n) { const int j0 = wc * 32 + 16 * n + 4 * fq; const f32x4 bv = *(const f32x4*)(bias1 + kv * 64 + j0);
#pragma unroll
                for (int ai = 0; ai < 2; ++ai)
#pragma unroll
                    for (int m = 0; m < 4; ++m) { const int rowl = ai * HALF + wr * 64 + m * 16 + fr; const int rn = rowl < 255 ? rowl + 1 : 255;
                        const u32x2v gw = *(const LAS u32x2v*)(Gb + rn * 64 + j0); const f32x4 h = acc[ai][0][m][n] + bv;
                        Hs[rowl * 65 + j0] = gelu_tanh(h.x + bf2f(gw.x & 0xffffu)); Hs[rowl * 65 + j0 + 1] = gelu_tanh(h.y + bf2f(gw.x >> 16));
                        Hs[rowl * 65 + j0 + 2] = gelu_tanh(h.z + bf2f(gw.y & 0xffffu)); Hs[rowl * 65 + j0 + 3] = gelu_tanh(h.w + bf2f(gw.y >> 16)); } } }
        asm volatile("s_waitcnt vmcnt(0) lgkmcnt(0)" ::: "memory"); __builtin_amdgcn_s_barrier(); asm volatile("" ::: "memory");
        const int rowl = tid >> 1, jh = tid & 1, rr = u.pm * BM + rowl - kv * 4096, bh = rr >> 7, n = rr & 127;
        float o[32];
#pragma unroll
        for (int j = 0; j < 32; ++j) o[j] = 0.f;
        if (n < 127) {
#pragma unroll 2
            for (int k = 0; k < 64; ++k) { const float hk = Hs[rowl * 65 + k];
#pragma unroll
                for (int j4 = 0; j4 < 8; ++j4) { const f32x4 wv = *(const LAS f32x4*)(W2s + k * 64 + jh * 32 + 4 * j4); o[4 * j4] += hk * wv.x; o[4 * j4 + 1] += hk * wv.y; o[4 * j4 + 2] += hk * wv.z; o[4 * j4 + 3] += hk * wv.w; } } }
        if (kv == 0) { bf16_t* dst = KCC + ((size_t)bh * 128 + n) * 64 + jh * 32;
#pragma unroll
            for (int j8 = 0; j8 < 4; ++j8) { float v8[8];
#pragma unroll
                for (int j = 0; j < 8; ++j) v8[j] = o[8 * j8 + j];
                *(v4u*)(dst + 8 * j8) = pack8(v8); } }
        else {
#pragma unroll
            for (int j = 0; j < 32; ++j) VCT[((size_t)bh * 64 + jh * 32 + j) * 128 + n] = (bf16_t)f2bf(o[j]); }
        asm volatile("s_waitcnt lgkmcnt(0)" ::: "memory"); __builtin_amdgcn_s_barrier(); asm volatile("" ::: "memory");
    }
};

__device__ __forceinline__ float wave_sum(float v) {
#pragma unroll
    for (int o = 1; o < 64; o <<= 1) v += __shfl_xor(v, o);
    return v;
}
struct RmIdent { __device__ __forceinline__ int operator()(int n) const { return n; } };
struct RmWin   { __device__ __forceinline__ int operator()(int n) const { return n < 1536 ? n : (n < 1560 ? 2048 + (n - 1536) : n - 24); } };
struct RmPair  { int half, split; __device__ __forceinline__ int operator()(int n) const { const int c = n - split; return 256 * (c >> 7) + half * 128 + (c & 127); } };
struct RmGlu   { __device__ __forceinline__ int operator()(int n) const { const int hf = n >= 256, c = n - 256 * hf; return 256 * (c >> 7) + hf * 128 + (c & 127); } };
template <class RowMap>
__device__ __forceinline__ void tr_item(const float* W, int ldw, int ncols, int K, const float* kscale, bf16_t* WT, const RowMap rm, LAS float* scr, int item, int lane) {
    const int nblk = (ncols + 31) >> 5, kb = item / nblk, nb = item - kb * nblk, k0 = 64 * kb, n0 = 32 * nb;
    const int nn = n0 + (lane & 31);
    float wv[32];
#pragma unroll
    for (int i = 0; i < 32; ++i) { const int kk = 2 * i + (lane >> 5); wv[i] = nn < ncols ? W[(size_t)(k0 + kk) * ldw + nn] : 0.f; }
#pragma unroll
    for (int i = 0; i < 32; ++i) { const int kk = 2 * i + (lane >> 5); float v = wv[i]; if (kscale) v *= kscale[k0 + kk]; scr[kk * 33 + (lane & 31)] = v; }
    LDS_WAIT(); asm volatile("" ::: "memory");
    const int c = lane & 7;
#pragma unroll
    for (int j = 0; j < 4; ++j) { const int nl = (lane >> 3) + 8 * j, n = n0 + nl; const LAS float* s = scr + (8 * c) * 33 + nl;
        v4u o; o.x = pk2(s[0 * 33], s[1 * 33]); o.y = pk2(s[2 * 33], s[3 * 33]); o.z = pk2(s[4 * 33], s[5 * 33]); o.w = pk2(s[6 * 33], s[7 * 33]);
        if (n < ncols) *(v4u*)(WT + (size_t)rm(n) * K + k0 + 8 * c) = o; }
    LDS_WAIT(); asm volatile("" ::: "memory");
}
template <class RowMap>
__device__ __forceinline__ void tr_job(const float* W, int ldw, int ncols, int K, const float* kscale, bf16_t* WT, const RowMap rm, LAS float* scr, int gw, int NGW, int lane, int rot) {
    const int nitems = (K >> 6) * ((ncols + 31) >> 5);
    for (int it = (gw + rot) % NGW; it < nitems; it += NGW) tr_item(W, ldw, ncols, K, kscale, WT, rm, scr, it, lane);
}
template <class RowMap>
__device__ __forceinline__ void trb_job(const float* W, int ldw, int ncols, int K, const float* kscale, bf16_t* WT, const RowMap rm, LAS unsigned char* lds, int bid, int G, int tid, int rot) {
    LAS bf16_t* T = (LAS bf16_t*)lds; constexpr int TP = 258;
    const int nblk = (ncols + 255) >> 8, nitems = (K >> 6) * nblk;
    for (int it = ((bid - rot) % G + G) % G; it < nitems; it += G) {
        const int kb = it / nblk, nb = it - kb * nblk, k0 = 64 * kb, n0 = 256 * nb, c4 = (tid & 63) * 4, kr = tid >> 6;
        f32x4 v[8];
#pragma unroll
        for (int p = 0; p < 8; ++p) { const f32x4 z = {0.f, 0.f, 0.f, 0.f}; v[p] = (n0 + c4 < ncols) ? __builtin_nontemporal_load((const GAS f32x4*)(W + (size_t)(k0 + p * 8 + kr) * ldw + n0 + c4)) : z; }
#pragma unroll
        for (int p = 0; p < 8; ++p) { const int kk = p * 8 + kr; const float sc = kscale ? kscale[k0 + kk] : 1.0f;
            LAS unsigned* d = (LAS unsigned*)(T + kk * TP + c4); d[0] = pk2(v[p].x * sc, v[p].y * sc); d[1] = pk2(v[p].z * sc, v[p].w * sc); }
        __syncthreads();
#pragma unroll
        for (int q = 0; q < 4; ++q) { const int idx = tid + q * NTHREADS, n = idx >> 3, c = idx & 7; const LAS bf16_t* src = T + (8 * c) * TP + n;
            v4u o; o.x = (unsigned)src[0] | ((unsigned)src[TP] << 16); o.y = (unsigned)src[2 * TP] | ((unsigned)src[3 * TP] << 16); o.z = (unsigned)src[4 * TP] | ((unsigned)src[5 * TP] << 16); o.w = (unsigned)src[6 * TP] | ((unsigned)src[7 * TP] << 16);
            if (n0 + n < ncols) *(v4u*)(WT + (size_t)rm(n0 + n) * K + k0 + 8 * c) = o; }
        __syncthreads();
    }
}
__device__ __forceinline__ void zero_job(void* p, size_t n16, int gtid, int NT) { v4u z = {0u, 0u, 0u, 0u}; for (size_t i = gtid; i < n16; i += NT) ((v4u*)p)[i] = z; }

struct S5Coef { float lr, li, dt; };
__device__ __forceinline__ S5Coef s5_coef(const float* lam_re, const float* lam_im, const float* log_dt, int l, int g, int p) {
    S5Coef c; c.lr = lam_re[(l * 16 + g) * 64 + p]; c.li = lam_im[(l * 16 + g) * 64 + p]; c.dt = expf(log_dt[l * 16 + g]); return c; }
__device__ __forceinline__ void s5_apow(const S5Coef& c, float tau, float& re, float& im) { const float mag = expf(c.lr * c.dt * tau), ang = c.li * c.dt * tau; re = mag * cosf(ang); im = mag * sinf(ang); }
__device__ __forceinline__ void s5_apow_fast(const S5Coef& c, float tau, float& re, float& im) { const float mag = __expf(c.lr * c.dt * tau), ang = c.li * c.dt * tau; re = mag * __cosf(ang); im = mag * __sinf(ang); }
__device__ __forceinline__ void s5_f_fast(const S5Coef& c, float& fre, float& fim) {
    float are, aim; s5_apow_fast(c, 1.0f, are, aim); const float rden = __builtin_amdgcn_rcpf(c.lr * c.lr + c.li * c.li);
    fre = ((are - 1.0f) * c.lr + aim * c.li) * rden; fim = (aim * c.lr - (are - 1.0f) * c.li) * rden; }
__device__ __forceinline__ void s5_f(const S5Coef& c, float& fre, float& fim) {
    float are, aim; s5_apow(c, 1.0f, are, aim); const float den = c.lr * c.lr + c.li * c.li;
    fre = ((are - 1.0f) * c.lr + aim * c.li) / den; fim = (aim * c.lr - (are - 1.0f) * c.li) / den; }

struct Args { const float* in[32]; float* out; unsigned char* ws; int ph_lo, ph_hi, li, pad; };

__device__ __forceinline__ int t5_bucket(int n) { if (n < 16) return n; const int lg = 16 + (int)(logf((float)n * (1.0f / 16.0f)) / 2.0794415416798357f * 16.0f); return lg < 31 ? lg : 31; }

__device__ __forceinline__ void p0_prologue(const Args& P, LAS unsigned char* lds, int tid, int lane, int wave, int bid_in, int G_in, const int which) {
    LAS float* scr = (LAS float*)(lds + wave * 16384);
    const int GS = (which == 3 && G_in >= 128) ? (G_in >> 2) : 0;
    const bool small_wg = bid_in < GS, do_big = GS == 0 || !small_wg, do_small = GS == 0 || small_wg;
    const int bid = (GS != 0 && !small_wg) ? bid_in - GS : bid_in, G = GS == 0 ? G_in : (small_wg ? GS : G_in - GS);
    const int gw = bid * NWAVES + wave, NGW = G * NWAVES, gtid = bid * NTHREADS + tid, NT = G * NTHREADS;
    unsigned char* ws = P.ws;
    if ((which & 1) && do_big) {
    { const float* x = P.in[0]; bf16_t* XN = (bf16_t*)(ws + WS_XN); float* RS = (float*)(ws + WS_RS);
      for (int m0 = gw * 8; m0 < M; m0 += NGW * 8) {
          f32x4 v[8][4]; float s[8];
#pragma unroll
          for (int q = 0; q < 8; ++q) { const f32x4* xr = (const f32x4*)(x + (size_t)(m0 + q) * D) + lane;
#pragma unroll
              for (int j = 0; j < 4; ++j) v[q][j] = __builtin_nontemporal_load(xr + 64 * j); }
#pragma unroll
          for (int q = 0; q < 8; ++q) { s[q] = 0.f;
#pragma unroll
              for (int j = 0; j < 4; ++j) s[q] += (v[q][j].x * v[q][j].x + v[q][j].y * v[q][j].y) + (v[q][j].z * v[q][j].z + v[q][j].w * v[q][j].w);
              s[q] = wave_sum(s[q]); }
#pragma unroll
          for (int q = 0; q < 8; ++q) { const int m = m0 + q;
#pragma unroll
              for (int j = 0; j < 4; ++j) { u32x2v w; w.x = pg8::cvt_pk_bf16(v[q][j].x, v[q][j].y); w.y = pg8::cvt_pk_bf16(v[q][j].z, v[q][j].w); *(u32x2v*)(XN + (size_t)m * D + (64 * j + lane) * 4) = w; }
              if (lane < 16) RS[(size_t)m * 16 + lane] = lane == 0 ? s[q] : 0.f; }
      } }
    }
    if (!(which & 2)) return;
    if (do_big)
    for (int l = 0; l < NLAYER; ++l) {
        bf16_t* WinT = (bf16_t*)(ws + WS_WIN + l * SZ_WIN); bf16_t* WoutT = (bf16_t*)(ws + WS_WOUT + l * SZ_WOUT); bf16_t* WguT = (bf16_t*)(ws + WS_WGU + l * SZ_WGU);
        bf16_t* WdT = (bf16_t*)(ws + WS_WD + l * SZ_WD); bf16_t* WgluT = (bf16_t*)(ws + WS_WGLU + l * SZ_WGLU); bf16_t* W1T = (bf16_t*)(ws + WS_W1 + l * SZ_W1);
        __syncthreads();
        trb_job(P.in[3] + (size_t)l * D * NINV, NINV, NINV, D, P.in[2] + l * D, WinT, RmWin(), lds, bid, G, tid, 736 * l + 0);
        trb_job(P.in[4] + (size_t)l * D * D, D, D, D, (const float*)nullptr, WoutT, RmIdent(), lds, bid, G, tid, 736 * l + 144);
        trb_job(P.in[28] + (size_t)l * D * DFF, DFF, DFF, D, P.in[27] + l * D, WguT, RmPair{0, 0}, lds, bid, G, tid, 736 * l + 208);
        trb_job(P.in[29] + (size_t)l * D * DFF, DFF, DFF, D, P.in[27] + l * D, WguT, RmPair{1, 0}, lds, bid, G, tid, 736 * l + 384);
        trb_job(P.in[30] + (size_t)l * DFF * D, D, D, DFF, (const float*)nullptr, WdT, RmIdent(), lds, bid, G, tid, 736 * l + 560);
    }
    if (!do_small) return;
    {
      const f32x4 z4 = {0.f, 0.f, 0.f, 0.f};
#define TOUCH(ptr, n4, k) ((gtid + (k) * NT) < (n4) ? ((const GAS f32x4*)(ptr))[gtid + (k) * NT] : z4)
      const f32x4 t0 = TOUCH(P.in[8], 8192, 0), t1 = TOUCH(P.in[9], 8192, 0), t2 = TOUCH(P.in[10], 8192, 0), t3 = TOUCH(P.in[11], 8192, 0);
      const f32x4 t4 = TOUCH(P.in[13], 65536, 0), t5 = TOUCH(P.in[13], 65536, 1), t6 = TOUCH(P.in[15], 65536, 0), t7 = TOUCH(P.in[15], 65536, 1);
      const f32x4 t8 = TOUCH(P.in[18], 65536, 0), t9 = TOUCH(P.in[18], 65536, 1), t10 = TOUCH(P.in[22], 8192, 0), t11 = TOUCH(P.in[24], 8192, 0);
#undef TOUCH
      asm volatile("" :: "v"(t0), "v"(t1), "v"(t2), "v"(t3), "v"(t4), "v"(t5), "v"(t6), "v"(t7), "v"(t8), "v"(t9), "v"(t10), "v"(t11)); }
    { const int l = gw & 1;
      const int gw_all = gw, NGW_all = NGW, gtid_all = gtid, NT_all = NT; (void)gw_all; (void)NGW_all; (void)gtid_all; (void)NT_all;
      const int gw2 = gw >> 1, NGW2 = NGW >> 1, gtid2 = gw2 * 64 + lane, NT2 = NT >> 1;
#define gw gw2
#define NGW NGW2
#define gtid gtid2
#define NT NT2
        bf16_t* WinT = (bf16_t*)(ws + WS_WIN + l * SZ_WIN); bf16_t* WoutT = (bf16_t*)(ws + WS_WOUT + l * SZ_WOUT); bf16_t* WguT = (bf16_t*)(ws + WS_WGU + l * SZ_WGU);
        bf16_t* WdT = (bf16_t*)(ws + WS_WD + l * SZ_WD); bf16_t* WgluT = (bf16_t*)(ws + WS_WGLU + l * SZ_WGLU); bf16_t* W1T = (bf16_t*)(ws + WS_W1 + l * SZ_W1);
        tr_job(P.in[13] + (size_t)l * 256 * 512, 512, 512, 256, (const float*)nullptr, WgluT, RmGlu(), scr, gw, NGW, lane, 544);
        tr_job(P.in[15] + (size_t)l * 2048 * 64, 64, 64, 1024, (const float*)nullptr, W1T, RmIdent(), scr, gw, NGW, lane, 480);
        tr_job(P.in[15] + (size_t)l * 2048 * 64 + 1024 * 64, 64, 64, 1024, (const float*)nullptr, W1T + 64 * 1024, RmIdent(), scr, gw, NGW, lane, 448);
        tr_job(P.in[18] + (size_t)l * 2048 * 64, 64, 64, 1024, (const float*)nullptr, W1T + 256 * 1024, RmIdent(), scr, gw, NGW, lane, 416);
        tr_job(P.in[18] + (size_t)l * 2048 * 64 + 1024 * 64, 64, 64, 1024, (const float*)nullptr, W1T + 256 * 1024 + 64 * 1024, RmIdent(), scr, gw, NGW, lane, 384);
        zero_job(WinT + (size_t)NINV * D, (size_t)(NIN - NINV) * D * 2 / 16, gtid, NT);
        zero_job(W1T + 128 * 1024, (size_t)128 * 1024 * 2 / 16, gtid, NT);
        zero_job(W1T + 256 * 1024 + 128 * 1024, (size_t)128 * 1024 * 2 / 16, gtid, NT);
        { bf16_t* WlT = (bf16_t*)(ws + WS_WLRU + l * SZ_WLRU); const float* wa = P.in[22] + (size_t)l * 4 * 64 * 64; const float* wx = P.in[24] + (size_t)l * 4 * 64 * 64;
#pragma unroll 4
          for (int i = gtid; i < 512 * 256; i += NT) { const int r = i >> 8, k = i & 255, pn = r >> 8, hf = (r >> 7) & 1, ch = pn * 128 + (r & 127), h = ch >> 6, j = ch & 63;
              float v = 0.f; if ((k >> 6) == h) v = (hf ? wx : wa)[(h * 64 + (k & 63)) * 64 + j]; WlT[i] = (bf16_t)f2bf(v); } }
        { float* TB = (float*)(ws + WS_TAB + l * SZ_TAB);
          for (int i = (gw + 352) % NGW; i < 128; i += NGW) { const int kv = i >> 6, j = i & 63; const float* pe = P.in[kv ? 17 : 14] + (size_t)l * 2048; const float* w1 = P.in[kv ? 18 : 15] + (size_t)l * 2048 * 64;
              float s = 0.f;
#pragma unroll
              for (int q = 0; q < 32; ++q) { const int k = lane + 64 * q; s += pe[k] * w1[(size_t)k * 64 + j]; }
              s = wave_sum(s); if (lane == 0) TB[TB_BIAS1 + i] = s; }
          for (int i = gtid; i < 256; i += NT) { const float lam = P.in[26][l * 256 + i]; TB[TB_SP + i] = lam > 15.f ? expf(-lam) : log1pf(expf(-lam)); }
          for (int i = gtid; i < 1024; i += NT) { const S5Coef c = s5_coef(P.in[5], P.in[6], P.in[7], l, i >> 6, i & 63); float re, im; s5_apow(c, (float)L5, re, im); TB[TB_A32 + 2 * i] = re; TB[TB_A32 + 2 * i + 1] = im; } }
        { bf16_t* TOP = (bf16_t*)(ws + WS_TOP + l * SZ_TOP); bf16_t* MOP = (bf16_t*)(ws + WS_MOP + l * SZ_MOP);
          const float *bre = P.in[8] + (size_t)l * 16384, *bim = P.in[9] + (size_t)l * 16384, *cre = P.in[10] + (size_t)l * 16384, *cim = P.in[11] + (size_t)l * 16384;
          for (int it = (gw + 64) % NGW; it < 16 * L5; it += NGW) {
              const int g = it >> 5, tau = it & 31, co = lane >> 2, ci0 = 4 * (lane & 3);
              float k4[4] = {0.f, 0.f, 0.f, 0.f};
              float pa_re, pa_im, pf_re, pf_im;
              LAS float* Cr = scr; LAS float* Ci = scr + 1024; LAS float* Br = scr + 2048; LAS float* Bi = scr + 3072;
              { f32x4 t4[16];
#pragma unroll
                for (int q = 0; q < 4; ++q) { t4[q] = ((const GAS f32x4*)(cre + g * 1024))[lane + 64 * q]; t4[4 + q] = ((const GAS f32x4*)(cim + g * 1024))[lane + 64 * q];
                                              t4[8 + q] = ((const GAS f32x4*)(bre + g * 1024))[lane + 64 * q]; t4[12 + q] = ((const GAS f32x4*)(bim + g * 1024))[lane + 64 * q]; }
                { const S5Coef c = s5_coef(P.in[5], P.in[6], P.in[7], l, g, lane); s5_apow_fast(c, (float)tau, pa_re, pa_im); s5_f_fast(c, pf_re, pf_im); }
#pragma unroll
                for (int q = 0; q < 4; ++q) { const int idx = lane + 64 * q, cc = idx >> 4, p0 = 4 * (idx & 15);
                    Cr[cc * 64 + ((p0 + 0) ^ cc)] = t4[q].x; Cr[cc * 64 + ((p0 + 1) ^ cc)] = t4[q].y; Cr[cc * 64 + ((p0 + 2) ^ cc)] = t4[q].z; Cr[cc * 64 + ((p0 + 3) ^ cc)] = t4[q].w;
                    Ci[cc * 64 + ((p0 + 0) ^ cc)] = t4[4 + q].x; Ci[cc * 64 + ((p0 + 1) ^ cc)] = t4[4 + q].y; Ci[cc * 64 + ((p0 + 2) ^ cc)] = t4[4 + q].z; Ci[cc * 64 + ((p0 + 3) ^ cc)] = t4[4 + q].w;
                    ((LAS f32x4*)Br)[idx] = t4[8 + q]; ((LAS f32x4*)Bi)[idx] = t4[12 + q]; } }
              LDS_WAIT(); asm volatile("" ::: "memory");
#pragma unroll 8
              for (int p = 0; p < 64; ++p) {
                  const float are = __shfl(pa_re, p), aim = __shfl(pa_im, p), fre = __shfl(pf_re, p), fim = __shfl(pf_im, p);
                  const float cr = Cr[co * 64 + (p ^ co)], cI = Ci[co * 64 + (p ^ co)];
                  const float wr_ = cr * are - cI * aim, wi_ = cr * aim + cI * are;
                  const f32x4 b4r = *(const LAS f32x4*)(Br + p * 16 + ci0), b4i = *(const LAS f32x4*)(Bi + p * 16 + ci0);
                  const float brv[4] = {b4r.x, b4r.y, b4r.z, b4r.w}, biv[4] = {b4i.x, b4i.y, b4i.z, b4i.w};
#pragma unroll
                  for (int j = 0; j < 4; ++j) { const float br = brv[j], bi = biv[j];
                      const float bbr = fre * br - fim * bi, bbi = fre * bi + fim * br; k4[j] += wr_ * bbr - wi_ * bbi; }
              }
              LDS_WAIT(); asm volatile("" ::: "memory");
              u32x2v kw; kw.x = pk2(k4[0], k4[1]); kw.y = pk2(k4[2], k4[3]); const u32x2v zw = {0u, 0u};
              bf16_t* Tg = TOP + (size_t)g * NS5 * KS5;
              for (int t = tau; t < L5; ++t) { const int s = t - tau;
                  *(u32x2v*)(Tg + (size_t)(t * 16 + co) * KS5 + s * 16 + ci0) = kw;
                  if (tau) *(u32x2v*)(Tg + (size_t)(s * 16 + co) * KS5 + t * 16 + ci0) = zw; }
          }
#pragma unroll 8
          for (int i = gtid; i < 16 * L5 * 16 * 64; i += NT) { const int p = i & 63, co = (i >> 6) & 15, t = (i >> 10) & 31, g = i >> 15;
              const S5Coef c = s5_coef(P.in[5], P.in[6], P.in[7], l, g, p); float are, aim; s5_apow_fast(c, (float)(t + 1), are, aim);
              const float cr = cre[(g * 16 + co) * 64 + p], cI = cim[(g * 16 + co) * 64 + p];
              bf16_t* row = TOP + ((size_t)g * NS5 + t * 16 + co) * KS5 + NS5;
              row[p] = (bf16_t)f2bf(cr * are - cI * aim); row[64 + p] = (bf16_t)f2bf(-(cr * aim + cI * are)); }
#pragma unroll 8
          for (int i = gtid; i < 16 * 64 * L5 * 16; i += NT) { const int ci = i & 15, s = (i >> 4) & 31, p = (i >> 9) & 63, g = i >> 15;
              const S5Coef c = s5_coef(P.in[5], P.in[6], P.in[7], l, g, p); float are, aim, fre, fim; s5_apow_fast(c, (float)(L5 - 1 - s), are, aim); s5_f_fast(c, fre, fim);
              const float br = bre[(g * 64 + p) * 16 + ci], bi = bim[(g * 64 + p) * 16 + ci]; const float bbr = fre * br - fim * bi, bbi = fre * bi + fim * br;
              bf16_t* base = MOP + (size_t)g * 256 * NS5 + s * 16 + ci;
              base[(size_t)p * NS5] = (bf16_t)f2bf(are * bbr - aim * bbi); base[(size_t)(64 + p) * NS5] = (bf16_t)f2bf(are * bbi + aim * bbr); }
          for (int g = 0; g < 16; ++g) zero_job(MOP + (size_t)g * 256 * NS5 + 128 * NS5, (size_t)128 * NS5 * 2 / 16, gtid, NT);
        }
#undef gw
#undef NGW
#undef gtid
#undef NT
    }
    { float* LUT = (float*)(ws + WS_LUT); const float* tab = P.in[1];
      for (int i = gtid; i < 8 * 132; i += NT) { const int hq = i / 132, dd = i - hq * 132; LUT[i] = tab[t5_bucket(dd < 128 ? dd : 128) * 8 + hq] * LOG2E; } }
}

__device__ __forceinline__ void lru_conv_job(const bf16_t* LX, const float* cw, const float* cb, bf16_t* XC, int gtid, int NT) {
    for (int i = gtid; i < M * 32; i += NT) { const int row = i >> 5, c8 = (i & 31) * 8, t = row & 2047;
        float acc[8];
#pragma unroll
        for (int j = 0; j < 8; ++j) acc[j] = cb[c8 + j];
#pragma unroll
        for (int k = 0; k < 4; ++k) { const int dt = k - 3; if (t + dt >= 0) { float xv[8]; unpack8(*(const v4u*)(LX + (size_t)(row + dt) * 256 + c8), xv);
#pragma unroll
            for (int j = 0; j < 8; ++j) acc[j] += cw[k * 256 + c8 + j] * xv[j]; } }
        *(v4u*)(XC + (size_t)row * 256 + c8) = pack8(acc); }
}
__device__ __forceinline__ void lru_conv_tile(const bf16_t* LX, const float* cw, const float* cb, bf16_t* XC, int row0, int tid) {
    const int c8 = (tid & 31) * 8, r0 = row0 + (tid >> 5) * 16; const bool halo = (r0 & 2047) != 0;
    v4u xr[19];
#pragma unroll
    for (int i = 0; i < 19; ++i) { const v4u z = {0u, 0u, 0u, 0u}; xr[i] = (i >= 3 || halo) ? *(const GAS v4u*)(LX + (size_t)(r0 + i - 3) * 256 + c8) : z; }
    float w[4][8], bias[8];
#pragma unroll
    for (int k = 0; k < 4; ++k)
#pragma unroll
        for (int j = 0; j < 8; ++j) w[k][j] = cw[k * 256 + c8 + j];
#pragma unroll
    for (int j = 0; j < 8; ++j) bias[j] = cb[c8 + j];
#pragma unroll
    for (int i = 0; i < 16; ++i) { float acc[8];
#pragma unroll
        for (int j = 0; j < 8; ++j) acc[j] = bias[j];
#pragma unroll
        for (int k = 0; k < 4; ++k) { float xv[8]; unpack8(xr[i + k], xv);
#pragma unroll
            for (int j = 0; j < 8; ++j) acc[j] += w[k][j] * xv[j]; }
        *(v4u*)(XC + (size_t)(r0 + i) * 256 + c8) = pack8(acc); }
}
__device__ __forceinline__ void s5_scan_job(const float* SLOC, const float* a32, bf16_t* AS5, int gtid, int NT) {
    for (int i = gtid; i < 16 * 16 * 64; i += NT) { const int p = i & 63, gb = i >> 6, g = gb >> 4;
        const float ar = a32[2 * (g * 64 + p)], aI = a32[2 * (g * 64 + p) + 1]; float hr = 0.f, hi = 0.f;
#pragma unroll 1
        for (int c0 = 0; c0 < NCH; c0 += 16) { float sr[16], si[16];
#pragma unroll
            for (int k = 0; k < 16; ++k) { const size_t R = (size_t)gb * 64 + c0 + k; sr[k] = SLOC[R * 128 + p]; si[k] = SLOC[R * 128 + 64 + p]; }
#pragma unroll
            for (int k = 0; k < 16; ++k) { const size_t R = (size_t)gb * 64 + c0 + k;
                AS5[R * KS5 + NS5 + p] = (bf16_t)f2bf(hr); AS5[R * KS5 + NS5 + 64 + p] = (bf16_t)f2bf(hi);
                const float nr = ar * hr - aI * hi + sr[k], ni = ar * hi + aI * hr + si[k]; hr = nr; hi = ni; } } }
}
__device__ __forceinline__ void compress2_job(const float* H1C, const float* w2k, const float* w2v, bf16_t* KCC, bf16_t* VCT, int gtid, int NT) {
    for (int i = gtid; i < 2 * 32 * 128 * 64; i += NT) { const int j = i & 63, n = (i >> 6) & 127, bh = (i >> 13) & 31, kv = i >> 18;
        const float* h = H1C + ((size_t)(kv * 32 + bh) * 128 + n) * 64; const float* w2 = kv ? w2v : w2k; float s = 0.f;
        if (n < 127) {
#pragma unroll 32
            for (int k = 0; k < 64; ++k) s += h[k] * w2[k * 64 + j]; }
        if (kv == 0) KCC[((size_t)bh * 128 + n) * 64 + j] = (bf16_t)f2bf(s); else VCT[((size_t)bh * 64 + j) * 128 + n] = (bf16_t)f2bf(s); }
}
__device__ __forceinline__ void lru_scan_job(const bf16_t* LA, const bf16_t* LB, const bf16_t* LG, bf16_t* MIX, LAS unsigned char* lds, int tid, int vb, int nvb) {
    LAS float* sP = (LAS float*)lds; LAS float* sH = sP + 128 * 32; LAS float* sC = sH + 128 * 32; LAS float* gP = sC + 128 * 32; LAS float* gH = gP + 256; LAS float* gC = gH + 256;
    const int k = tid >> 2, q = tid & 3;
    for (int it = vb; it < NB * 8; it += nvb) { const int b = it >> 3, ch0 = (it & 7) * 32 + q * 8;
        const size_t base = ((size_t)b * 2048 + k * 16) * 256 + ch0;
        float Pp[8], Hh[8];
#pragma unroll
        for (int j = 0; j < 8; ++j) { Pp[j] = 1.f; Hh[j] = 0.f; }
#pragma unroll 1
        for (int hfp = 0; hfp < 2; ++hfp) {
            v4u la[8], lb[8];
#pragma unroll
            for (int i = 0; i < 8; ++i) { la[i] = *(const GAS v4u*)(LA + base + (size_t)(8 * hfp + i) * 256); lb[i] = *(const GAS v4u*)(LB + base + (size_t)(8 * hfp + i) * 256); }
#pragma unroll
            for (int i = 0; i < 8; ++i) { float av[8], bv[8]; unpack8(la[i], av); unpack8(lb[i], bv);
#pragma unroll
                for (int j = 0; j < 8; ++j) { const float a = 1.0f - av[j]; Hh[j] = a * Hh[j] + bv[j]; Pp[j] *= a; } } }
#pragma unroll
        for (int j = 0; j < 8; ++j) { sP[k * 32 + q * 8 + j] = Pp[j]; sH[k * 32 + q * 8 + j] = Hh[j]; }
        __syncthreads();
        if (tid < 256) { const int c = tid & 31, sg = tid >> 5; float p = 1.f, h = 0.f;
#pragma unroll
            for (int kk = 0; kk < 16; ++kk) { const float pp = sP[(sg * 16 + kk) * 32 + c], hh = sH[(sg * 16 + kk) * 32 + c]; h = pp * h + hh; p *= pp; }
            gP[sg * 32 + c] = p; gH[sg * 32 + c] = h; }
        __syncthreads();
        if (tid < 32) { float h = 0.f;
#pragma unroll
            for (int sg = 0; sg < 8; ++sg) { gC[sg * 32 + tid] = h; h = gP[sg * 32 + tid] * h + gH[sg * 32 + tid]; } }
        __syncthreads();
        if (tid < 256) { const int c = tid & 31, sg = tid >> 5; float h = gC[sg * 32 + c];
#pragma unroll
            for (int kk = 0; kk < 16; ++kk) { sC[(sg * 16 + kk) * 32 + c] = h; h = sP[(sg * 16 + kk) * 32 + c] * h + sH[(sg * 16 + kk) * 32 + c]; } }
        __syncthreads();
#pragma unroll
        for (int j = 0; j < 8; ++j) Hh[j] = sC[k * 32 + q * 8 + j];
#pragma unroll 1
        for (int hfp = 0; hfp < 2; ++hfp) {
            v4u la[8], lb[8], lg[8];
#pragma unroll
            for (int i = 0; i < 8; ++i) { const size_t o = base + (size_t)(8 * hfp + i) * 256; la[i] = *(const GAS v4u*)(LA + o); lb[i] = *(const GAS v4u*)(LB + o); lg[i] = *(const GAS v4u*)(LG + o); }
#pragma unroll
            for (int i = 0; i < 8; ++i) { float av[8], bv[8], gv[8], y[8]; unpack8(la[i], av); unpack8(lb[i], bv); unpack8(lg[i], gv);
#pragma unroll
                for (int j = 0; j < 8; ++j) { Hh[j] = (1.0f - av[j]) * Hh[j] + bv[j]; y[j] = Hh[j] * gv[j]; }
                *(v4u*)(MIX + ((size_t)b * 2048 + k * 16 + 8 * hfp + i) * D + 768 + ch0) = pack8(y); } }
        __syncthreads(); }
}
__device__ __forceinline__ void final_norm_job(const bf16_t* XN, float* OUT, const float* RS, const float* gain, int gw, int NGW, int lane) {
    f32x4 gv[4];
#pragma unroll
    for (int j = 0; j < 4; ++j) gv[j] = ((const f32x4*)gain)[64 * j + lane];
    for (int m0 = gw * 8; m0 < M; m0 += NGW * 8) { u32x2v v[8][4]; float s[8];
#pragma unroll
        for (int q = 0; q < 8; ++q) { s[q] = lane < 16 ? RS[(size_t)(m0 + q) * 16 + lane] : 0.f; const u32x2v* hr = (const u32x2v*)(XN + (size_t)(m0 + q) * D) + lane;
#pragma unroll
            for (int j = 0; j < 4; ++j) v[q][j] = hr[64 * j]; }
#pragma unroll
        for (int q = 0; q < 8; ++q) { const float rs = rsqrtf(wave_sum(s[q]) * (1.0f / 1024.0f) + 1e-6f); f32x4* orow = (f32x4*)(OUT + (size_t)(m0 + q) * D) + lane;
#pragma unroll
            for (int j = 0; j < 4; ++j) { f32x4 o; o.x = bf2f(v[q][j].x & 0xffffu); o.y = bf2f(v[q][j].x >> 16); o.z = bf2f(v[q][j].y & 0xffffu); o.w = bf2f(v[q][j].y >> 16); o = o * rs; o = o * gv[j]; __builtin_nontemporal_store(o, orow + 64 * j); } } }
}

__device__ __forceinline__ void final_norm_panel(const bf16_t* XN, float* OUT, const float* RS, const float* gain, int m_lo, int wave, int lane) {
    f32x4 gv[4];
#pragma unroll
    for (int j = 0; j < 4; ++j) gv[j] = ((const f32x4*)gain)[64 * j + lane];
    for (int m0 = m_lo + wave * 4; m0 < m_lo + 256; m0 += NWAVES * 4) { u32x2v v[4][4]; float s[4];
#pragma unroll
        for (int q = 0; q < 4; ++q) { s[q] = lane < 16 ? RS[(size_t)(m0 + q) * 16 + lane] : 0.f; const u32x2v* hr = (const u32x2v*)(XN + (size_t)(m0 + q) * D) + lane;
#pragma unroll
            for (int j = 0; j < 4; ++j) v[q][j] = hr[64 * j]; }
#pragma unroll
        for (int q = 0; q < 4; ++q) { const float rs = rsqrtf(wave_sum(s[q]) * (1.0f / 1024.0f) + 1e-6f); f32x4* orow = (f32x4*)(OUT + (size_t)(m0 + q) * D) + lane;
#pragma unroll
            for (int j = 0; j < 4; ++j) { f32x4 o; o.x = bf2f(v[q][j].x & 0xffffu); o.y = bf2f(v[q][j].x >> 16); o.z = bf2f(v[q][j].y & 0xffffu); o.w = bf2f(v[q][j].y >> 16); o = o * rs; o = o * gv[j]; orow[64 * j] = o; } } }
}

__device__ __forceinline__ float wave_max(float v) {
#pragma unroll
    for (int o = 1; o < 64; o <<= 1) v = fmaxf(v, __shfl_xor(v, o));
    return v;
}
struct MbCmp { int t; __device__ __forceinline__ int operator()(int, int n) const { return t - (16 * n + 31); }
               __device__ __forceinline__ int tp(int i) const { return 64 * i; } };
struct MbSel { int t; unsigned ok; unsigned long long selp;
               __device__ __forceinline__ int operator()(int i, int pos) const { return ((ok >> i) & 1u) ? t - pos : -1; }
               __device__ __forceinline__ int tp(int i) const { return 64 * (int)((selp >> (5 * i)) & 31ull); } };
struct MbWin { int t, first; __device__ __forceinline__ int operator()(int, int pos) const { const int d = t - pos; return d < 256 ? d : -1; }
               __device__ __forceinline__ int tp(int i) const { return 64 * (first + i); } };
template <class MB>
__device__ __forceinline__ void nsa_branch(const int ntiles, const bf16_t* Kb, const bf16_t* VTb, const int vpitch, const MB mb, const int hq0,
                                           const LAS float* q_lds, LAS float* P_lds, const LAS float* lut, const int lane, float (&o)[4], float (&inv)[4]) {
    float mx[4] = {-1e30f, -1e30f, -1e30f, -1e30f};
#pragma unroll 1
    for (int i = 0; i < ntiles; ++i) {
        const int pos = mb.tp(i) + lane; const int dist = mb(i, pos);
        const bf16_t* kp = Kb + (size_t)pos * 64; float a0 = 0.f, a1 = 0.f, a2 = 0.f, a3 = 0.f;
#pragma unroll 1
        for (int c = 0; c < 8; ++c) { float kd[8]; unpack8(*(const v4u*)(kp + 8 * c), kd);
#pragma unroll
            for (int j = 0; j < 8; ++j) { const f32x4 q4 = *(const LAS f32x4*)(q_lds + (8 * c + j) * 4); a0 += q4.x * kd[j]; a1 += q4.y * kd[j]; a2 += q4.z * kd[j]; a3 += q4.w * kd[j]; } }
        f32x4 sv = {-1e30f, -1e30f, -1e30f, -1e30f};
        if (dist >= 0) { const int dd = dist < 128 ? dist : 128;
            sv.x = a0 + lut[(hq0 + 0) * 132 + dd]; sv.y = a1 + lut[(hq0 + 1) * 132 + dd]; sv.z = a2 + lut[(hq0 + 2) * 132 + dd]; sv.w = a3 + lut[(hq0 + 3) * 132 + dd];
            mx[0] = fmaxf(mx[0], sv.x); mx[1] = fmaxf(mx[1], sv.y); mx[2] = fmaxf(mx[2], sv.z); mx[3] = fmaxf(mx[3], sv.w); }
        *(LAS f32x4*)(P_lds + (i * 64 + lane) * 4) = sv;
    }
    float sum[4] = {0.f, 0.f, 0.f, 0.f};
#pragma unroll
    for (int g = 0; g < 4; ++g) mx[g] = wave_max(mx[g]);
    asm volatile("s_waitcnt lgkmcnt(0)" ::: "memory");
#pragma unroll 1
    for (int i = 0; i < ntiles; ++i) { f32x4 sv = *(LAS f32x4*)(P_lds + (i * 64 + lane) * 4);
        sv.x = sv.x > -1e29f ? exp2f(sv.x - mx[0]) : 0.f; sv.y = sv.y > -1e29f ? exp2f(sv.y - mx[1]) : 0.f; sv.z = sv.z > -1e29f ? exp2f(sv.z - mx[2]) : 0.f; sv.w = sv.w > -1e29f ? exp2f(sv.w - mx[3]) : 0.f;
        sum[0] += sv.x; sum[1] += sv.y; sum[2] += sv.z; sum[3] += sv.w; *(LAS f32x4*)(P_lds + (i * 64 + lane) * 4) = sv; }
#pragma unroll
    for (int g = 0; g < 4; ++g) { sum[g] = wave_sum(sum[g]); inv[g] = sum[g] > 0.f ? 1.0f / sum[g] : 0.f; }
    asm volatile("s_waitcnt lgkmcnt(0)" ::: "memory");
    const bf16_t* vp = VTb + (size_t)lane * vpitch; float t0 = 0.f, t1 = 0.f, t2 = 0.f, t3 = 0.f;
#pragma unroll 1
    for (int i = 0; i < ntiles; ++i) { const int tp = mb.tp(i);
#pragma unroll 1
        for (int kk = 0; kk < 8; ++kk) { float vv[8]; unpack8(*(const v4u*)(vp + tp + 8 * kk), vv);
#pragma unroll
            for (int j = 0; j < 8; ++j) { const f32x4 p4 = *(const LAS f32x4*)(P_lds + (i * 64 + 8 * kk + j) * 4); t0 += p4.x * vv[j]; t1 += p4.y * vv[j]; t2 += p4.z * vv[j]; t3 += p4.w * vv[j]; } } }
    o[0] += t0 * inv[0]; o[1] += t1 * inv[1]; o[2] += t2 * inv[2]; o[3] += t3 * inv[3];
    asm volatile("s_waitcnt lgkmcnt(0)" ::: "memory");
}
__device__ __forceinline__ void nsa_ref_job(const bf16_t* Q, const bf16_t* KCC, const bf16_t* VCT, const bf16_t* KS, const bf16_t* VST, const bf16_t* KW, const bf16_t* VWT,
                                            const float* GATES, const float* LUT, bf16_t* MIX, LAS unsigned char* lds, int lane, int wave, int gw, int NGW) {
    LAS float* q_lds = (LAS float*)(lds + wave * 16384); LAS float* P_lds = q_lds + 256; LAS float* lut = P_lds + 2048;
    for (int i = lane; i < 8 * 132; i += 64) lut[i] = LUT[i];
    asm volatile("s_waitcnt vmcnt(0) lgkmcnt(0)" ::: "memory");
#pragma unroll 1
    for (int it = gw; it < NB * 2 * SEQ; it += NGW) {
        const int t = it & 2047, bh = it >> 11, b = bh >> 1, h = bh & 1, cur = t >> 6; const size_t m = (size_t)b * 2048 + t;
        { const u32x2v qw = *(const u32x2v*)(Q + m * 512 + h * 256 + lane * 4); const int g = lane >> 4, d0 = (lane & 15) * 4;
          q_lds[(d0 + 0) * 4 + g] = bf2f(qw.x & 0xffffu); q_lds[(d0 + 1) * 4 + g] = bf2f(qw.x >> 16); q_lds[(d0 + 2) * 4 + g] = bf2f(qw.y & 0xffffu); q_lds[(d0 + 3) * 4 + g] = bf2f(qw.y >> 16); }
        const float gate = lane < 12 ? GATES[m * 32 + h * 12 + lane] : 0.f;
        asm volatile("s_waitcnt lgkmcnt(0)" ::: "memory");
        float oc[4] = {0.f, 0.f, 0.f, 0.f}, os[4] = {0.f, 0.f, 0.f, 0.f}, ow[4] = {0.f, 0.f, 0.f, 0.f}, inv[4];
        nsa_branch(2, KCC + (size_t)bh * 128 * 64, VCT + (size_t)bh * 64 * 128, 128, MbCmp{t}, h * 4, q_lds, P_lds, lut, lane, oc, inv);
        float sc = -3e38f;
        if (lane < 32) { float imp = 0.f;
#pragma unroll
            for (int k = -1; k <= 3; ++k) { const int n = 4 * lane + k; if (n >= 0) { const f32x4 p4 = *(const LAS f32x4*)(P_lds + n * 4); imp += (p4.x * inv[0] + p4.y * inv[1]) + (p4.z * inv[2] + p4.w * inv[3]); } }
            const bool avail = 64 * lane <= t, forced = (lane == 0) | (lane == cur) | (lane == cur - 1);
            sc = avail ? imp + (forced ? 1e4f : 0.f) : -1e9f; }
        unsigned long long selp = 0ull; unsigned okm = 0u;
#pragma unroll
        for (int r = 0; r < 8; ++r) { const float mv = wave_max(sc); const unsigned long long bal = __ballot(sc == mv); const int idx = __builtin_amdgcn_readfirstlane(__ffsll((long long)bal) - 1);
            selp |= (unsigned long long)(idx & 31) << (5 * r); if (mv > -5e8f) okm |= 1u << r; if (lane == idx) sc = -3e38f; }
        asm volatile("s_waitcnt lgkmcnt(0)" ::: "memory");
        nsa_branch(8, KS + (size_t)bh * 2048 * 64, VST + (size_t)bh * 64 * 2048, 2048, MbSel{t, okm, selp}, h * 4, q_lds, P_lds, lut, lane, os, inv);
        { const int first = (t > 255 ? t - 255 : 0) >> 6;
          nsa_branch(cur - first + 1, KW + (size_t)bh * 2048 * 64, VWT + (size_t)bh * 64 * 2048, 2048, MbWin{t, first}, h * 4, q_lds, P_lds, lut, lane, ow, inv); }
#pragma unroll
        for (int g = 0; g < 4; ++g) { const float r = __shfl(gate, 3 * g) * oc[g] + __shfl(gate, 3 * g + 1) * os[g] + __shfl(gate, 3 * g + 2) * ow[g];
            MIX[m * D + 256 + (h * 4 + g) * 64 + lane] = (bf16_t)f2bf(r); }
    }
}

namespace nsa {
typedef short bf16x8 __attribute__((ext_vector_type(8)));
typedef float f32x16 __attribute__((ext_vector_type(16)));
constexpr int KROW = 144, VROW = 144, VROWC = 272;
constexpr int L_K = 0, L_V = 2 * 64 * KROW, L_CK = L_V + 2 * 64 * VROW, L_CV = L_CK + 128 * KROW, L_WK = L_CV + 64 * VROWC, L_WV = L_WK + 64 * KROW, L_LUT = L_WV + 64 * VROW, L_IMP = L_LUT + 8 * 132 * 4, L_END = L_IMP + 4 * 64 * 33 * 4;
constexpr int L_SEL = RING_BYTES + 1024, L_GATE = L_SEL + 256, L_EXT = L_GATE + 2 * 64 * 12 * 4, L_END2 = L_EXT + 8 * 256 * 4;
static_assert(8 * 4096 <= 4 * 64 * 33 * 4 && L_END <= RING_BYTES && L_END2 <= LDS_BYTES && (L_LUT % 16) == 0 && (L_IMP % 16) == 0 && (L_CK % 16) == 0 && (L_CV % 16) == 0 && (L_WK % 16) == 0 && (L_WV % 16) == 0 && (L_EXT % 16) == 0, "nsa LDS map");
__device__ __forceinline__ bf16x8 pk8(const f32x16& p, int o) {
    v4u w; w.x = pg8::cvt_pk_bf16(p[o], p[o + 1]); w.y = pg8::cvt_pk_bf16(p[o + 2], p[o + 3]); w.z = pg8::cvt_pk_bf16(p[o + 4], p[o + 5]); w.w = pg8::cvt_pk_bf16(p[o + 6], p[o + 7]);
    return __builtin_bit_cast(bf16x8, w); }
__device__ __forceinline__ void halves(float v, float& lo, float& hi) { auto r = __builtin_amdgcn_permlane32_swap(__float_as_uint(v), __float_as_uint(v), false, false); lo = __uint_as_float(r[0]); hi = __uint_as_float(r[1]); }
__device__ __forceinline__ float max_x32(float v) { float a, b; halves(v, a, b); return fmaxf(a, b); }
__device__ __forceinline__ float sum_x32(float v) { float a, b; halves(v, a, b); return a + b; }
template <int CTRL> __device__ __forceinline__ float dppf(float v) { return __builtin_bit_cast(float, __builtin_amdgcn_update_dpp(0, __builtin_bit_cast(int, v), CTRL, 0xf, 0xf, true)); }
template <int CTRL> __device__ __forceinline__ int dppi(int v) { return __builtin_amdgcn_update_dpp(0, v, CTRL, 0xf, 0xf, true); }
__device__ __forceinline__ bf16x8 ld_b128(const LAS unsigned char* p) { return *(const LAS bf16x8*)p; }
__device__ __forceinline__ bf16x8 ld_2b64(const LAS unsigned char* p) { u32x2v a = *(const LAS u32x2v*)p, b = *(const LAS u32x2v*)(p + 16); v4u w; w.x = a.x; w.y = a.y; w.z = b.x; w.w = b.y; return __builtin_bit_cast(bf16x8, w); }

__device__ __forceinline__ void step(const int MODE, const LAS unsigned char* KL, const LAS unsigned char* VL, const LAS float* lut_h, const bf16x8 (&qf)[4], const int lane, const int t, const int pos0, const bool selbit, const float bias_far,
                                     const bool first, float& mrun, float& lrun, f32x16 (&O)[2]) {
    const int r32 = lane & 31, hh = lane >> 5;
    const float c0 = (MODE != 3 && !selbit) ? -1e30f : ((MODE == 0 || MODE == 3) ? bias_far - mrun : -mrun);
    f32x16 sc[2];
    { bf16x8 kf[2][4];
#pragma unroll
      for (int kt = 0; kt < 2; ++kt)
#pragma unroll
          for (int s = 0; s < 4; ++s) kf[kt][s] = ld_b128(KL + (32 * kt + r32) * KROW + (16 * s + 8 * hh) * 2);
#ifdef PROBE_NSA_LDS2
      { bf16x8 k2[2][4];
#pragma unroll
        for (int kt = 0; kt < 2; ++kt)
#pragma unroll
            for (int s = 0; s < 4; ++s) { k2[kt][s] = ld_b128(KL + (32 * kt + (r32 ^ 1)) * KROW + (16 * s + 8 * hh) * 2); asm volatile("" :: "v"(k2[kt][s])); } }
#endif
#pragma unroll
      for (int kt = 0; kt < 2; ++kt) {
#pragma unroll
          for (int r = 0; r < 16; ++r) sc[kt][r] = c0; }
      __builtin_amdgcn_s_setprio(1);
#pragma unroll
      for (int kt = 0; kt < 2; ++kt) {
#pragma unroll
          for (int s = 0; s < 4; ++s) sc[kt] = __builtin_amdgcn_mfma_f32_32x32x16_bf16(kf[kt][s], qf[s], sc[kt], 0, 0, 0);
      }
      __builtin_amdgcn_s_setprio(0);
#ifdef PROBE_NSA_MFMA2
      { f32x16 d2[2];
#pragma unroll
        for (int kt = 0; kt < 2; ++kt) {
#pragma unroll
            for (int r = 0; r < 16; ++r) d2[kt][r] = c0;
#pragma unroll
            for (int s = 0; s < 4; ++s) d2[kt] = __builtin_amdgcn_mfma_f32_32x32x16_bf16(kf[kt][s], qf[3 - s], d2[kt], 0, 0, 0);
            asm volatile("" :: "v"(d2[kt][0])); } }
#endif
    }
    bf16x8 vf0[2][2], vf1[2][2];
#pragma unroll
    for (int s2 = 0; s2 < 2; ++s2)
#pragma unroll
        for (int dt = 0; dt < 2; ++dt) vf0[s2][dt] = ld_b128(VL + (32 * dt + r32) * VROW + 32 * s2 + 16 * hh);
    __builtin_amdgcn_sched_barrier(0);
    if (MODE == 1 || MODE == 4) {
        const LAS float* pl = lut_h + (t - pos0 - 4 * hh + 1);
        asm volatile("" : "+v"(pl));
        f32x16 lv[2];
#pragma unroll
        for (int kt = 0; kt < 2; ++kt)
#pragma unroll
            for (int r = 0; r < 16; ++r) lv[kt][r] = pl[63 - (32 * kt + (r & 3) + 8 * (r >> 2))];
        asm volatile("" : "+v"(lv[0]), "+v"(lv[1]));
#pragma unroll
        for (int kt = 0; kt < 2; ++kt)
#pragma unroll
            for (int r = 0; r < 16; ++r) sc[kt][r] += lv[kt][r];
    } else if (MODE == 3) {
#pragma unroll
        for (int kt = 0; kt < 2; ++kt)
#pragma unroll
            for (int r = 0; r < 16; ++r) { const int dist = t - (pos0 + 32 * kt + (r & 3) + 8 * (r >> 2) + 4 * hh); sc[kt][r] = dist < 256 ? sc[kt][r] : -1e30f; }
    }
    float tm = -1e30f, tm1 = -1e30f;
#pragma unroll
    for (int r = 0; r < 16; ++r) { tm = fmaxf(tm, sc[0][r]); tm1 = fmaxf(tm1, sc[1][r]); }
    tm = max_x32(fmaxf(tm, tm1));
    const float delta = (tm > 8.0f || (first && tm > -1e29f)) ? tm : 0.f;
    if (__any(delta != 0.f)) {
#pragma unroll
        for (int kt = 0; kt < 2; ++kt)
#pragma unroll
            for (int r = 0; r < 16; ++r) sc[kt][r] -= delta;
        const float alpha = __builtin_amdgcn_exp2f(-delta); mrun += delta; lrun *= alpha;
#pragma unroll
        for (int dt = 0; dt < 2; ++dt)
#pragma unroll
            for (int r = 0; r < 16; ++r) O[dt][r] *= alpha; }
#pragma unroll
    for (int r = 0; r < 16; ++r) { sc[0][r] = __builtin_amdgcn_exp2f(sc[0][r]); }
    __builtin_amdgcn_sched_barrier(0);
#pragma unroll
    for (int s2 = 0; s2 < 2; ++s2)
#pragma unroll
        for (int dt = 0; dt < 2; ++dt) vf1[s2][dt] = ld_b128(VL + (32 * dt + r32) * VROW + 64 + 32 * s2 + 16 * hh);
    __builtin_amdgcn_sched_barrier(0);
#pragma unroll
    for (int r = 0; r < 16; ++r) { sc[1][r] = __builtin_amdgcn_exp2f(sc[1][r]); }
#ifdef PROBE_NSA_EXP2
#pragma unroll
    for (int r = 0; r < 16; ++r) { float e0 = __builtin_amdgcn_exp2f(sc[0][r] * 0.5f), e1 = __builtin_amdgcn_exp2f(sc[1][r] * 0.5f); asm volatile("" :: "v"(e0), "v"(e1)); }
#endif
    { float sacc = sc[0][0];
#pragma unroll
      for (int r = 1; r < 16; ++r) sacc += sc[0][r];
#pragma unroll
      for (int r = 0; r < 16; ++r) sacc += sc[1][r];
      lrun += sacc; }
#pragma unroll
    for (int s2 = 0; s2 < 2; ++s2) { const bf16x8 pf = pk8(sc[0], 8 * s2);
#pragma unroll
        for (int dt = 0; dt < 2; ++dt) O[dt] = __builtin_amdgcn_mfma_f32_32x32x16_bf16(vf0[s2][dt], pf, O[dt], 0, 0, 0); }
#pragma unroll
    for (int s2 = 0; s2 < 2; ++s2) { const bf16x8 pf = pk8(sc[1], 8 * s2);
#pragma unroll
        for (int dt = 0; dt < 2; ++dt) O[dt] = __builtin_amdgcn_mfma_f32_32x32x16_bf16(vf1[s2][dt], pf, O[dt], 0, 0, 0); }
}
struct Stage { v4u k, v; };
__device__ __forceinline__ Stage stage_load(const bf16_t* Ksrc, const bf16_t* VTsrc, int vpitch, int tid) { Stage s; const int r = tid >> 3, c = tid & 7;
    s.k = *(const GAS v4u*)(Ksrc + r * 64 + c * 8); s.v = *(const GAS v4u*)(VTsrc + (size_t)r * vpitch + c * 8); return s; }
__device__ __forceinline__ void stage_store(LAS unsigned char* KL, LAS unsigned char* VL, const Stage& s, int tid) { const int r = tid >> 3, c = tid & 7;
    *(LAS v4u*)(KL + r * KROW + c * 16) = s.k; u32x2v a, b; a.x = s.v.x; a.y = s.v.y; b.x = s.v.z; b.y = s.v.w; *(LAS u32x2v*)(VL + r * VROW + (c >> 1) * 32 + (c & 1) * 8) = a; *(LAS u32x2v*)(VL + r * VROW + (c >> 1) * 32 + (c & 1) * 8 + 16) = b; }

__device__ __forceinline__ void job(unsigned char* w, LAS unsigned char* lds, const int tid0, const int wave, const int bid, const int G) {
#define NSA_P(T, off) ((T*)(w + (off)))
    const int g = wave & 3, qh = wave >> 2;
    LAS float* lut = (LAS float*)(lds + L_LUT); LAS float* IMP = (LAS float*)(lds + L_IMP); LAS unsigned* SELM = (LAS unsigned*)(lds + L_SEL);
    for (int i = tid0; i < 8 * 132; i += NTHREADS) lut[i] = NSA_P(const float, WS_LUT)[i];
    { LAS float* lext = (LAS float*)(lds + L_EXT);
      for (int i = tid0; i < 8 * 256; i += NTHREADS) { const int d = (i & 255) - 64; lext[i] = d < 0 ? -1e30f : NSA_P(const float, WS_LUT)[(i >> 8) * 132 + (d < 128 ? d : 128)]; } }
    __syncthreads();
#pragma unroll 1
    for (int rnd = 0; rnd * G + bid < NB * 2 * 32; ++rnd) {
        const int tid = wave * 64 + pg8::lane_id();
        const int lane = tid & 63, r32 = lane & 31, hh = lane >> 5;
        const int vcu = (G & 7) == 0 ? (bid & 7) * (G >> 3) + (bid >> 3) : bid;
        const int itr = rnd * G + vcu, bh = itr >> 5, qb0 = itr & 31, qb = (rnd & 1) ? 31 - qb0 : qb0, b = bh >> 1, h = bh & 1, hq = h * 4 + g;
        const int t = 64 * qb + 32 * qh + r32; const size_t m = (size_t)b * 2048 + t;
        const LAS float* lut_h = lut + hq * 132;
        const LAS float* lext_h = (const LAS float*)(lds + L_EXT) + hq * 256;
        LAS float* GL = (LAS float*)(lds + L_GATE + (rnd & 1) * 64 * 12 * 4);
        if (tid < 192) { const int qq = tid / 3, w3 = tid - 3 * qq; *(LAS f32x4*)(GL + qq * 12 + 4 * w3) = *(const GAS f32x4*)(NSA_P(const float, WS_GATES) + ((size_t)b * 2048 + 64 * qb + qq) * 32 + h * 12 + 4 * w3); }
        bf16x8 qf[4];
#pragma unroll
        for (int s = 0; s < 4; ++s) qf[s] = *(const GAS bf16x8*)(NSA_P(const bf16_t, WS_Q) + m * 512 + hq * 64 + 16 * s + 8 * hh);
        f32x16 OT[2];
        const bf16_t* Ksb = NSA_P(const bf16_t, WS_KS) + (size_t)bh * 2048 * 64; const bf16_t* Vsb = NSA_P(const bf16_t, WS_VST) + (size_t)bh * 64 * 2048;
        const bf16_t* Kwb = NSA_P(const bf16_t, WS_KW) + (size_t)bh * 2048 * 64; const bf16_t* Vwb = NSA_P(const bf16_t, WS_VWT) + (size_t)bh * 64 * 2048;
        { const bf16_t* Kc = NSA_P(const bf16_t, WS_KCC) + (size_t)bh * 128 * 64; const bf16_t* Vc = NSA_P(const bf16_t, WS_VCT) + (size_t)bh * 64 * 128;
          v4u ck[2], cv[2];
#pragma unroll
          for (int u = 0; u < 2; ++u) { const int idx = tid + u * NTHREADS; ck[u] = *(const GAS v4u*)(Kc + (idx >> 3) * 64 + (idx & 7) * 8); cv[u] = *(const GAS v4u*)(Vc + (idx >> 4) * 128 + (idx & 15) * 8); }
          const Stage s0 = stage_load(Ksb, Vsb, 2048, tid); const Stage w0 = stage_load(Kwb + (size_t)qb * 64 * 64, Vwb + qb * 64, 2048, tid);
#pragma unroll
          for (int u = 0; u < 2; ++u) { const int idx = tid + u * NTHREADS, r = idx >> 3, c = idx & 7, rv = idx >> 4, cvv = idx & 15; *(LAS v4u*)(lds + L_CK + r * KROW + c * 16) = ck[u];
              u32x2v a, bq; a.x = cv[u].x; a.y = cv[u].y; bq.x = cv[u].z; bq.y = cv[u].w; *(LAS u32x2v*)(lds + L_CV + rv * VROWC + (cvv >> 1) * 32 + (cvv & 1) * 8) = a; *(LAS u32x2v*)(lds + L_CV + rv * VROWC + (cvv >> 1) * 32 + (cvv & 1) * 8 + 16) = bq; }
          stage_store(lds + L_K, lds + L_V, s0, tid); stage_store(lds + L_WK, lds + L_WV, w0, tid);
          __syncthreads();
          f32x16 sc[4]; float mx = -1e30f;
#pragma unroll
          for (int kt = 0; kt < 4; ++kt) {
#pragma unroll
              for (int r = 0; r < 16; ++r) sc[kt][r] = -1e30f;
              if (512 * kt + 31 <= 64 * qb + 63) {
#pragma unroll
              for (int r = 0; r < 16; ++r) sc[kt][r] = 0.f;
#pragma unroll
              for (int s = 0; s < 4; ++s) sc[kt] = __builtin_amdgcn_mfma_f32_32x32x16_bf16(ld_b128(lds + L_CK + (32 * kt + r32) * KROW + (16 * s + 8 * hh) * 2), qf[s], sc[kt], 0, 0, 0);
              f32x16 lv;
#pragma unroll
              for (int r = 0; r < 16; ++r) { const int n = 32 * kt + (r & 3) + 8 * (r >> 2) + 4 * hh, dist = t - (16 * n + 31); lv[r] = lut_h[dist < 128 ? (dist < 0 ? 0 : dist) : 128]; }
              asm volatile("" : "+v"(lv));
#pragma unroll
              for (int r = 0; r < 16; ++r) { const int n = 32 * kt + (r & 3) + 8 * (r >> 2) + 4 * hh, dist = t - (16 * n + 31);
                  sc[kt][r] = dist >= 0 ? sc[kt][r] + lv[r] : -1e30f; mx = fmaxf(mx, sc[kt][r]); } } }
          mx = max_x32(mx); const float meff = mx < -1e29f ? 1e30f : mx; float ps = 0.f;
#pragma unroll
          for (int kt = 0; kt < 4; ++kt)
#pragma unroll
              for (int r = 0; r < 16; ++r) { const float p = __builtin_amdgcn_exp2f(sc[kt][r] - meff); sc[kt][r] = p; ps += p; }
          ps = sum_x32(ps); const float inv = ps > 0.f ? 1.0f / ps : 0.f;
#pragma unroll
          for (int kt = 0; kt < 4; ++kt)
#pragma unroll
              for (int r = 0; r < 16; ++r) sc[kt][r] *= inv;
          { float eprev = 0.f;
#pragma unroll
            for (int i = 0; i < 16; ++i) { const int kt = i >> 2, a = i & 3; const float Gs = (sc[kt][4 * a] + sc[kt][4 * a + 1]) + (sc[kt][4 * a + 2] + sc[kt][4 * a + 3]); float e_lo, e_hi; halves(sc[kt][4 * a + 3], e_lo, e_hi); const float e = hh ? e_lo : e_hi;
                IMP[(g * 64 + 32 * qh + r32) * 33 + 2 * i + hh] = Gs + (hh ? e : eprev); eprev = e; asm volatile("" ::: "memory"); } }
#pragma unroll
          for (int dt = 0; dt < 2; ++dt)
#pragma unroll
              for (int r = 0; r < 16; ++r) OT[dt][r] = 0.f;
#pragma unroll
          for (int kt = 0; kt < 4; ++kt) if (512 * kt + 31 <= 64 * qb + 63)
#pragma unroll
              for (int s2 = 0; s2 < 2; ++s2) { const bf16x8 pf = pk8(sc[kt], 8 * s2);
#pragma unroll
                  for (int dt = 0; dt < 2; ++dt) OT[dt] = __builtin_amdgcn_mfma_f32_32x32x16_bf16(ld_b128(lds + L_CV + (32 * dt + r32) * VROWC + 64 * kt + 32 * s2 + 16 * hh), pf, OT[dt], 0, 0, 0); }
          const float gate_c = GL[(32 * qh + r32) * 12 + g * 3];
#pragma unroll
          for (int dt = 0; dt < 2; ++dt)
#pragma unroll
              for (int r = 0; r < 16; ++r) OT[dt][r] *= gate_c;
        }
        __syncthreads();
        {
          const int ql = 8 * wave + (lane >> 3), cg4 = 4 * (lane & 7), tq = 64 * qb + ql, cur = qb; float sv[4];
#pragma unroll
          for (int c = 0; c < 4; ++c) { const int j = cg4 + c; const float imp = (IMP[(0 * 64 + ql) * 33 + j] + IMP[(1 * 64 + ql) * 33 + j]) + (IMP[(2 * 64 + ql) * 33 + j] + IMP[(3 * 64 + ql) * 33 + j]);
              const bool avail = 64 * j <= tq, forced = (j == 0) | (j == cur) | (j == cur - 1); sv[c] = avail ? imp + (forced ? 1e4f : 0.f) : -1e9f; }
          unsigned msk = 0u;
#pragma unroll
          for (int rr = 0; rr < 8; ++rr) { float best = sv[0]; int bi = cg4;
#pragma unroll
              for (int c = 1; c < 4; ++c) if (sv[c] > best) { best = sv[c]; bi = cg4 + c; }
#pragma unroll
              for (int o = 0; o < 3; ++o) {
                  const float ov = o == 0 ? dppf<0xB1>(best) : (o == 1 ? dppf<0x4E>(best) : dppf<0x141>(best)); const int oi = o == 0 ? dppi<0xB1>(bi) : (o == 1 ? dppi<0x4E>(bi) : dppi<0x141>(bi));
                  const bool take = ov > best || (ov == best && oi < bi); best = take ? ov : best; bi = take ? oi : bi; }
              if (best > -5e8f) msk |= 1u << bi;
#pragma unroll
              for (int c = 0; c < 4; ++c) sv[c] = (cg4 + c == bi) ? -3e38f : sv[c]; }
          if ((lane & 7) == 0) SELM[ql] = msk; }
        __syncthreads();
        const unsigned selm = SELM[32 * qh + r32];
        { float mrun = 0.f, lrun = 0.f; f32x16 O[2];
#pragma unroll
          for (int dt = 0; dt < 2; ++dt)
#pragma unroll
              for (int r = 0; r < 16; ++r) O[dt][r] = 0.f;
          const float bias_far = lut_h[128]; int cur = 0;
          Stage nA = stage_load(Ksb + (size_t)(qb >= 1 ? 1 : 0) * 64 * 64, Vsb + (qb >= 1 ? 1 : 0) * 64, 2048, tid), nB;
#pragma unroll 1
          for (int j = 0; j <= qb; j += 2) {
              { const int jn = j + 2 <= qb ? j + 2 : qb; nB = stage_load(Ksb + (size_t)jn * 64 * 64, Vsb + jn * 64, 2048, tid); }
              { const LAS unsigned char* KL = lds + L_K + cur * 64 * KROW; const LAS unsigned char* VL = lds + L_V + cur * 64 * VROW; const bool sb = (selm >> j) & 1u;
                step(j + 3 <= qb ? 0 : (j < qb ? 4 : 1), KL, VL, lext_h, qf, lane, t, 64 * j, sb, bias_far, j == 0, mrun, lrun, O); }
              if (j < qb) stage_store(lds + L_K + (cur ^ 1) * 64 * KROW, lds + L_V + (cur ^ 1) * 64 * VROW, nA, tid);
              __syncthreads(); cur ^= 1;
              if (j >= qb) break;
              { const int jn = j + 3 <= qb ? j + 3 : qb; nA = stage_load(Ksb + (size_t)jn * 64 * 64, Vsb + jn * 64, 2048, tid); }
              { const int j1 = j + 1; const LAS unsigned char* KL = lds + L_K + cur * 64 * KROW; const LAS unsigned char* VL = lds + L_V + cur * 64 * VROW; const bool sb = (selm >> j1) & 1u;
                step(j1 + 3 <= qb ? 0 : (j1 < qb ? 4 : 1), KL, VL, lext_h, qf, lane, t, 64 * j1, sb, bias_far, false, mrun, lrun, O); }
              if (j + 2 <= qb) stage_store(lds + L_K + (cur ^ 1) * 64 * KROW, lds + L_V + (cur ^ 1) * 64 * VROW, nB, tid);
              __syncthreads(); cur ^= 1; }
          lrun = sum_x32(lrun); const float sc_ = lrun > 0.f ? GL[(32 * qh + (pg8::lane_id() & 31)) * 12 + g * 3 + 1] / lrun : 0.f;
#pragma unroll
          for (int dt = 0; dt < 2; ++dt)
#pragma unroll
              for (int r = 0; r < 16; ++r) OT[dt][r] += O[dt][r] * sc_; }
        { const int jlo = qb > 4 ? qb - 4 : 0;
          float mrun = 0.f, lrun = 0.f; f32x16 O[2];
#pragma unroll
          for (int dt = 0; dt < 2; ++dt)
#pragma unroll
              for (int r = 0; r < 16; ++r) O[dt][r] = 0.f;
          int cur = 0;
#pragma unroll 1
          for (int j = qb; j >= jlo; --j) {
              Stage nx; const bool more = j > jlo; if (more) nx = stage_load(Kwb + (size_t)(j - 1) * 64 * 64, Vwb + (j - 1) * 64, 2048, tid);
              { const int dl = qb - j; const LAS unsigned char* KL = dl == 0 ? lds + L_WK : lds + L_K + (cur ^ 1) * 64 * KROW; const LAS unsigned char* VL = dl == 0 ? lds + L_WV : lds + L_V + (cur ^ 1) * 64 * VROW;
                step(dl == 0 ? 1 : (dl <= 2 ? 4 : (dl == 3 ? 0 : 3)), KL, VL, lext_h, qf, lane, t, 64 * j, true, lut_h[128], dl == 0, mrun, lrun, O); }
              if (more) stage_store(lds + L_K + cur * 64 * KROW, lds + L_V + cur * 64 * VROW, nx, tid);
              __syncthreads(); cur ^= 1; }
          lrun = sum_x32(lrun); const float sc_ = lrun > 0.f ? GL[(32 * qh + (pg8::lane_id() & 31)) * 12 + g * 3 + 2] / lrun : 0.f;
#pragma unroll
          for (int dt = 0; dt < 2; ++dt)
#pragma unroll
              for (int r = 0; r < 16; ++r) OT[dt][r] += O[dt][r] * sc_; }
        { LAS unsigned char* ost = lds + L_IMP + wave * 4096;
          const int l2 = pg8::lane_id(), q2 = l2 & 31, h2 = l2 >> 5;
#pragma unroll
          for (int dt = 0; dt < 2; ++dt)
#pragma unroll
              for (int r = 0; r < 16; r += 2) *(LAS unsigned*)(ost + q2 * 128 + (((32 * dt + 8 * (r >> 2) + 4 * h2 + (r & 3)) * 2) ^ ((q2 & 7) << 4))) = pg8::cvt_pk_bf16(OT[dt][r], OT[dt][r + 1]);
          asm volatile("s_waitcnt lgkmcnt(0)" ::: "memory");
          bf16_t* obase = NSA_P(bf16_t, WS_MIX) + ((size_t)b * 2048 + 64 * qb + 32 * qh) * D + 256 + hq * 64;
#pragma unroll
          for (int i = 0; i < 4; ++i) { const int idx = l2 + 64 * i, qq = idx >> 3, cc = idx & 7; *(v4u*)(obase + (size_t)qq * D + cc * 8) = *(const LAS v4u*)(ost + qq * 128 + ((cc ^ (qq & 7)) << 4)); }
        }
    }
}
#undef NSA_P
}

#ifndef MK_N_LAUNCHES
#define MK_N_LAUNCHES 1
#endif
#ifndef NSA_PAIRED
#define NSA_PAIRED 0
#endif
#ifndef FINAL_FUSED
#define FINAL_FUSED 0
#endif
#ifndef GLU_TAIL
#define GLU_TAIL 1
#endif
#ifndef EN_MASK
#define EN_MASK 0xffff
#endif
#ifdef PROBE_RT_MASK
#define EN(b) (((EN_MASK >> (b)) & 1) && ((args.pad >> (b)) & 1))
#else
#define EN(b) ((EN_MASK >> (b)) & 1)
#endif
#ifndef DUP_MASK
#define DUP_MASK 0
#endif
#define REP(b) for (int rep_ = 0; rep_ < 1 + ((DUP_MASK >> (b)) & 1); ++rep_)
#ifndef NSA_REF
#define NSA_REF 0
#endif
#ifndef PG8_ALIGN_
#define PG8_ALIGN_ true
#endif
#ifndef PG8_SP2_RES_
#define PG8_SP2_RES_ true
#endif
#ifndef PG8_SP2_
#define PG8_SP2_ true
#endif
constexpr int N_PHASES = 18;
__global__ void __launch_bounds__(NTHREADS, 2) mk_fwd(Args args) {
    extern __shared__ __attribute__((aligned(16))) unsigned char lds_raw[];
    LAS unsigned char* lds = (LAS unsigned char*)lds_raw;
    volatile LAS unsigned* MISC = (volatile LAS unsigned*)(lds + MISC_OFF);
    const int wave = __builtin_amdgcn_readfirstlane((int)threadIdx.x >> 6), bid = blockIdx.x, G = gridDim.x;
#define tid (wave * 64 + pg8::lane_id())
#define gw (bid * NWAVES + wave)
#define NGW (G * NWAVES)
#define NT (G * NTHREADS)
    const int lo = (MK_N_LAUNCHES == 1) ? 0 : args.ph_lo, hi_all = (MK_N_LAUNCHES == 1) ? N_PHASES : args.ph_hi;
    unsigned char* ws = args.ws;
    for (int u = tid; u < (LDS_BYTES - RING_BYTES) / 4; u += NTHREADS) ((LAS unsigned*)(lds + RING_BYTES))[u] = 0u;
    __syncthreads();
    const int bli = (MK_N_LAUNCHES == 1) ? 0 : args.li;
    XcdBarrier bar; bar.bar = (unsigned*)(ws + WS_CTL) + CW_BAR + bli * XCD_BAR_WORDS; bar.x = 0; bar.st = nullptr;
    if (hi_all - lo > 1) bar = xcd_barrier_post((unsigned*)(ws + WS_CTL) + CW_BAR + bli * XCD_BAR_WORDS, MISC + 8);
#define PH(k) (lo <= (k) && (k) < hi)
#define SEAM(k) do { if (PH(k) && PH((k) + 1)) xcd_barrier(bar); } while (0)
    typedef const float* kptr_t; typedef const __attribute__((address_space(4))) kptr_t* kargs_t;
#define OPQ_WS() unsigned char* w = ws; int bid_p = bid; asm volatile("" : "+s"(w), "+s"(bid_p))
#define OPQ_IN() kargs_t inp = (kargs_t)__builtin_amdgcn_kernarg_segment_ptr(); asm volatile("" : "+s"(inp))
#define WP(T, off) ((T*)(w + (off)))
#define OPQ_TID() int tid_p = tid; asm volatile("" : "+v"(tid_p)); const int lane_p = tid_p & 63, gtid_p = bid * NTHREADS + tid_p; (void)lane_p; (void)gtid_p

#ifndef PREFIX_DUP
#define PREFIX_DUP 0
#endif
#pragma unroll 1
    for (int pass_ = (PREFIX_DUP > 0 && lo == 0 && hi_all == N_PHASES) ? 0 : 1; pass_ < 2; ++pass_) {
    const int hi = pass_ == 0 ? PREFIX_DUP : hi_all;
    if (PH(0) && EN(0)) REP(0) { OPQ_TID(); p0_prologue(args, lds, tid_p, lane_p, wave, bid, G, 3); VM_WAIT(); __syncthreads(); }
    if (PH(0) && ((DUP_MASK >> 16) & 1)) { OPQ_TID(); p0_prologue(args, lds, tid_p, lane_p, wave, bid, G, 1); VM_WAIT(); __syncthreads(); }
    if (PH(0) && ((DUP_MASK >> 17) & 1)) { OPQ_TID(); p0_prologue(args, lds, tid_p, lane_p, wave, bid, G, 2); VM_WAIT(); __syncthreads(); }
    SEAM(0);
#pragma unroll 1
    for (int l = 0; l < NLAYER; ++l) {
        const int pb = 1 + 8 * l;
        if (PH(pb + 0) && EN(1)) REP(1) {
            OPQ_WS();
            pg8::Gemm g{WP(bf16_t, WS_XN), WP(bf16_t, WS_WIN + l * SZ_WIN), D, D}; pg8::StaticOrder S; S.init(M, 2048, G, bid_p);
            { OPQ_TID(); rsl_fill(WP(float, WS_RS), S, lds, tid_p); }
            EpiInProj E{w, lds, 0};
            pg8::gemm_phase<EpiInProj, pg8::StaticOrder, PG8_ALIGN_, PG8_SP2_>(lds, g, S, E, wave);
        }
        SEAM(pb + 0);
#ifdef EXTRA_BARS
        for (int xb_ = 0; xb_ < EXTRA_BARS; ++xb_) xcd_barrier(bar);
#endif
        if (PH(pb + 1)) {
            if (EN(5)) REP(5) { OPQ_WS(); OPQ_IN(); OPQ_TID();
              pg8::Gemm g{WP(bf16_t, WS_XC), WP(bf16_t, WS_WLRU + l * SZ_WLRU), 256, 256}; pg8::StaticOrder S; S.init(M, 512, G > 64 ? G - 32 : G, G > 64 ? (bid_p >= 32 ? bid_p - 32 : 1 << 20) : bid_p);
              { Unit u0; for (int i = 0; S.next(i, u0); ++i) lru_conv_tile(WP(bf16_t, WS_LX), inp[20] + l * 4 * 256, inp[21] + l * 256, WP(bf16_t, WS_XC), u0.pm * BM, tid_p); }
              VM_WAIT(); __syncthreads();
              EpiLruGates E{WP(bf16_t, WS_XC), inp[23] + l * 256, inp[25] + l * 256, WP(float, WS_TAB + l * SZ_TAB) + TB_SP, WP(bf16_t, WS_LA), WP(bf16_t, WS_LB)}; pg8::gemm_phase<EpiLruGates, pg8::StaticOrder, PG8_ALIGN_, PG8_SP2_>(lds, g, S, E, wave); }
            if (EN(2)) REP(2) { OPQ_WS(); OPQ_IN(); pg8::Gemm g{WP(bf16_t, WS_KC), WP(bf16_t, WS_W1 + l * SZ_W1), 1024, 1024}; pg8::GroupOrder S; S.init(2, 16, 1, 1, G, bid_p, 0);
              EpiCompress2 E{WP(float, WS_TAB + l * SZ_TAB) + TB_BIAS1, inp[16] + l * 4096, inp[19] + l * 4096, WP(bf16_t, WS_KCC), WP(bf16_t, WS_VCT)}; pg8::gemm_phase<EpiCompress2, pg8::GroupOrder, false, PG8_SP2_>(lds, g, S, E, wave); }
            if (EN(3)) REP(3) { OPQ_WS(); pg8::Gemm g{WP(bf16_t, WS_AS5), WP(bf16_t, WS_MOP + l * SZ_MOP), KS5, NS5}; pg8::GroupOrder S; S.init(16, 4, 1, 1, G, bid_p, 32);
              EpiS5StateScan E{WP(float, WS_TAB + l * SZ_TAB) + TB_A32, WP(bf16_t, WS_AS5)}; pg8::gemm_phase<EpiS5StateScan, pg8::GroupOrder, false, PG8_SP2_>(lds, g, S, E, wave); }
            if (EN(1)) REP(1) { OPQ_WS(); pg8::Gemm g{WP(bf16_t, WS_XN), WP(bf16_t, WS_WIN + l * SZ_WIN) + (size_t)2048 * D, D, D}; pg8::GroupOrder S; S.init(1, 128, 1, 1, G, bid_p, 96);
              EpiGates E{w}; pg8::gemm_phase<EpiGates, pg8::GroupOrder, true, PG8_SP2_>(lds, g, S, E, wave); }
        }
        SEAM(pb + 1);
        if (PH(pb + 3)) {
            if (EN(8)) REP(8) { OPQ_WS(); OPQ_IN(); OPQ_TID(); pg8::Gemm g{WP(bf16_t, WS_AS5), WP(bf16_t, WS_TOP + l * SZ_TOP), KS5, KS5}; pg8::GroupOrder S; S.init(16, 4, 2, 2, G, bid_p, 0);
              EpiS5Main E{WP(bf16_t, WS_AS5), inp[12] + l * 256, WP(bf16_t, WS_YS)}; pg8::gemm_phase<EpiS5Main, pg8::GroupOrder, true, PG8_SP2_>(lds, g, S, E, wave);
              int nun = 0; { Unit uu; while (S.next(nun, uu)) ++nun; }
              VM_WAIT(); __syncthreads();
              if (tid_p == 0) { __builtin_amdgcn_fence(__ATOMIC_RELEASE, "agent"); VM_WAIT(); __hip_atomic_fetch_add((unsigned*)(w + WS_CTL) + CW_CNT + 64 * l, (unsigned)nun, __ATOMIC_RELAXED, __HIP_MEMORY_SCOPE_AGENT); } }
            __syncthreads();
            if (EN(9)) REP(9) { OPQ_WS(); OPQ_TID(); lru_scan_job(WP(bf16_t, WS_LA), WP(bf16_t, WS_LB), WP(bf16_t, WS_LG), WP(bf16_t, WS_MIX), lds, tid_p, bid >= G / 2 ? bid - G / 2 : NB * 8, G - G / 2); }
            __syncthreads();
#if NSA_REF
            if (EN(10)) REP(10) { OPQ_WS(); OPQ_TID(); nsa_ref_job(WP(bf16_t, WS_Q), WP(bf16_t, WS_KCC), WP(bf16_t, WS_VCT), WP(bf16_t, WS_KS), WP(bf16_t, WS_VST), WP(bf16_t, WS_KW), WP(bf16_t, WS_VWT), WP(float, WS_GATES), WP(float, WS_LUT), WP(bf16_t, WS_MIX), lds, lane_p, wave, gw, NGW); }
#else
#if NSA_PAIRED
            if (EN(10)) REP(10) { OPQ_WS(); OPQ_TID(); nsa2::job(w, lds, tid_p, wave, bid, G); }
#else
            if (EN(10)) REP(10) { OPQ_WS(); OPQ_TID(); nsa::job(w, lds, tid_p, wave, bid, G); }
#endif
#endif
#if GLU_TAIL
            if (EN(11)) REP(11) {
                OPQ_WS(); OPQ_TID();
                if (tid_p == 0) { unsigned sp = 0; while (__hip_atomic_load((unsigned*)(w + WS_CTL) + CW_CNT + 64 * l, __ATOMIC_RELAXED, __HIP_MEMORY_SCOPE_AGENT) < 128u * (1u + rep_)) { __builtin_amdgcn_s_sleep(2); if (++sp > (1u << 22)) break; }
                                  __builtin_amdgcn_fence(__ATOMIC_ACQUIRE, "agent"); VM_WAIT(); }
                __syncthreads();
                pg8::Gemm g{WP(bf16_t, WS_YS), WP(bf16_t, WS_WGLU + l * SZ_WGLU), 256, 256}; pg8::StaticOrder S; S.init(M, 512, G, bid_p);
                EpiGlu E{WP(bf16_t, WS_MIX)}; pg8::gemm_phase<EpiGlu, pg8::StaticOrder, PG8_ALIGN_, PG8_SP2_>(lds, g, S, E, wave); }
#endif
        }
        SEAM(pb + 3);
#if !GLU_TAIL
        if (PH(pb + 4) && EN(11)) REP(11) {
            OPQ_WS(); pg8::Gemm g{WP(bf16_t, WS_YS), WP(bf16_t, WS_WGLU + l * SZ_WGLU), 256, 256}; pg8::StaticOrder S; S.init(M, 512, G, bid_p);
            EpiGlu E{WP(bf16_t, WS_MIX)}; pg8::gemm_phase<EpiGlu, pg8::StaticOrder, PG8_ALIGN_, PG8_SP2_>(lds, g, S, E, wave);
        }
        SEAM(pb + 4);
#endif
        if (PH(pb + 5) && EN(12)) {
            OPQ_WS();
            pg8::Gemm g{WP(bf16_t, WS_MIX), WP(bf16_t, WS_WOUT + l * SZ_WOUT), D, D}; pg8::StaticOrder S; S.init(M, D, G, bid_p);
            EpiResid E{WP(bf16_t, WS_XN), WP(float, WS_RS)}; pg8::gemm_phase<EpiResid, pg8::StaticOrder, PG8_ALIGN_, PG8_SP2_RES_>(lds, g, S, E, wave);
        }
        SEAM(pb + 5);
        if (PH(pb + 6) && EN(13)) REP(13) {
            OPQ_WS(); pg8::Gemm g{WP(bf16_t, WS_XN), WP(bf16_t, WS_WGU + l * SZ_WGU), D, D}; pg8::StaticOrder S; S.init(M, NGU, G, bid_p);
            { OPQ_TID(); rsl_fill(WP(float, WS_RS), S, lds, tid_p); }
            EpiGateUp E{lds, WP(bf16_t, WS_HMID), 0}; pg8::gemm_phase<EpiGateUp, pg8::StaticOrder, PG8_ALIGN_, PG8_SP2_>(lds, g, S, E, wave);
        }
#ifdef PROBE_GU_RAW
        if (PH(pb + 6)) {
            OPQ_WS(); pg8::Gemm g{WP(bf16_t, WS_XN), WP(bf16_t, WS_WGU + l * SZ_WGU), D, D}; pg8::StaticOrder S; S.init(M, NGU, G, bid_p);
            EpiProbeRaw E{WP(bf16_t, WS_MIXR + 180 * MiB)}; pg8::gemm_phase<EpiProbeRaw, pg8::StaticOrder, PG8_ALIGN_, PG8_SP2_>(lds, g, S, E, wave);
        }
#endif
        SEAM(pb + 6);
        if (PH(pb + 7) && EN(14)) {
            OPQ_WS();
            pg8::Gemm g{WP(bf16_t, WS_HMID), WP(bf16_t, WS_WD + l * SZ_WD), DFF, DFF}; pg8::StaticOrder S; S.init(M, D, G, bid_p);
            EpiResid E{WP(bf16_t, WS_XN), WP(float, WS_RS)}; pg8::gemm_phase<EpiResid, pg8::StaticOrder, PG8_ALIGN_, PG8_SP2_RES_>(lds, g, S, E, wave);
#if FINAL_FUSED
            if (l == NLAYER - 1) {
                OPQ_IN(); OPQ_TID(); float* Hres = args.out; asm volatile("" : "+s"(Hres));
                Unit uu;
#pragma unroll 1
                for (int i = 0; S.next(i, uu); ++i) {
                    VM_WAIT(); __syncthreads();
                    if (tid_p == 0) { __builtin_amdgcn_fence(__ATOMIC_RELEASE, "agent"); VM_WAIT();
                                      MISC[16] = __hip_atomic_fetch_add((unsigned*)(w + WS_CTL) + CW_PANEL + uu.pm, 1u, __ATOMIC_RELAXED, __HIP_MEMORY_SCOPE_AGENT); }
                    __syncthreads();
                    const bool last = MISC[16] == 3u;
                    if (last) { if (tid_p == 0) { __builtin_amdgcn_fence(__ATOMIC_ACQUIRE, "agent"); VM_WAIT(); }
                                __syncthreads();
                                final_norm_panel(WP(bf16_t, WS_XN), Hres, WP(float, WS_RS), inp[31], uu.pm * BM, wave, lane_p); }
                    __syncthreads(); }
            }
#endif
        }
        SEAM(pb + 7);
    }
    if (PH(17) && EN(15) && !FINAL_FUSED) { OPQ_WS(); OPQ_IN(); float* Hres = args.out; asm volatile("" : "+s"(Hres)); OPQ_TID(); final_norm_job(WP(bf16_t, WS_XN), Hres, WP(float, WS_RS), inp[31], gw, NGW, lane_p); }
    if (pass_ == 0) xcd_barrier(bar);
    }
#undef PH
#undef tid
#undef gw
#undef NGW
#undef NT
#undef SEAM
}

extern "C" void kernel_launch(void* const* d_in, const int* in_sizes, int n_in, void* d_out, int out_size, void* d_ws, size_t ws_size, hipStream_t stream) {
    static int grid = 0;
    if (grid == 0) {
        if (n_in != 32 || in_sizes[0] != M * D || out_size != M * D || ws_size < WS_END) { fprintf(stderr, "kernel_launch: shape/workspace mismatch (n_in %d, in0 %d, out %d, ws %zu, need %zu)\n", n_in, n_in > 0 ? in_sizes[0] : -1, out_size, ws_size, (size_t)WS_END); grid = -1; return; }
        int dev = 0, cus = 0, per_cu = 0;
        if (hipGetDevice(&dev) != hipSuccess || hipDeviceGetAttribute(&cus, hipDeviceAttributeMultiprocessorCount, dev) != hipSuccess) { grid = -1; return; }
        if (hipFuncSetAttribute((const void*)mk_fwd, hipFuncAttributeMaxDynamicSharedMemorySize, LDS_BYTES) != hipSuccess) { fprintf(stderr, "kernel_launch: hipFuncSetAttribute failed\n"); grid = -1; return; }
        if (hipOccupancyMaxActiveBlocksPerMultiprocessor(&per_cu, (const void*)mk_fwd, NTHREADS, LDS_BYTES) != hipSuccess || per_cu < 1) { fprintf(stderr, "kernel_launch: occupancy query says %d blocks per CU\n", per_cu); (void)hipGetLastError(); grid = -1; return; }
        grid = cus;
    }
    if (grid < 0) return;
    (void)hipMemsetAsync((char*)d_ws + WS_CTL, 0, CTL_ZERO_BYTES, stream);
    Args a{};
    for (int i = 0; i < 32; ++i) a.in[i] = (const float*)d_in[i];
    a.out = (float*)d_out; a.ws = (unsigned char*)d_ws;
    if (MK_N_LAUNCHES == 1) { a.ph_lo = 0; a.ph_hi = N_PHASES; hipLaunchKernelGGL(mk_fwd, dim3(grid), dim3(NTHREADS), LDS_BYTES, stream, a); }
#ifdef HOST_EXTRA_LO
    else if (MK_N_LAUNCHES == 2) {
        a.ph_lo = 0; a.ph_hi = N_PHASES; a.li = 0; a.pad = 0xffff; hipLaunchKernelGGL(mk_fwd, dim3(grid), dim3(NTHREADS), LDS_BYTES, stream, a);
        a.ph_lo = HOST_EXTRA_LO; a.ph_hi = HOST_EXTRA_HI; a.li = 1; a.pad = HOST_EXTRA_MASK; hipLaunchKernelGGL(mk_fwd, dim3(grid), dim3(NTHREADS), LDS_BYTES, stream, a); }
#endif
#ifdef HOST_PREFIX_DUP
    else if (MK_N_LAUNCHES == 2) {
        a.ph_lo = 0; a.ph_hi = HOST_PREFIX_DUP; a.li = 0; hipLaunchKernelGGL(mk_fwd, dim3(grid), dim3(NTHREADS), LDS_BYTES, stream, a);
        a.ph_lo = 0; a.ph_hi = N_PHASES; a.li = 1; hipLaunchKernelGGL(mk_fwd, dim3(grid), dim3(NTHREADS), LDS_BYTES, stream, a); }
#endif
    else for (int p = 0; p < N_PHASES; ++p) { a.ph_lo = p; a.ph_hi = p + 1; hipLaunchKernelGGL(mk_fwd, dim3(grid), dim3(NTHREADS), LDS_BYTES, stream, a); }
}
```
